# Optimizing an MI355X kernel written in HIP

```python
import jax, jax.numpy as jnp
from jax import lax
import numpy as np

D_MODEL = 1024
BATCH = 32
SEQ = 2048
DEPTH = 4

HEAD_DIM = 64
MIX_WIDTH = D_MODEL
SB_WIDTH = MIX_WIDTH // 2
SB_HEADS = SB_WIDTH // HEAD_DIM
SWA_WIDTH = MIX_WIDTH - SB_WIDTH
SWA_Q_HEADS = SWA_WIDTH // HEAD_DIM
SWA_GROUP = 4
SWA_KV_HEADS = SWA_Q_HEADS // SWA_GROUP
SWA_KV_WIDTH = SWA_KV_HEADS * HEAD_DIM
IN_COLS = 3 * SB_WIDTH + SWA_WIDTH + 2 * SWA_KV_WIDTH
WINDOW = 128
QBLK = 128
N_BUCKETS = 32
MAX_DISTANCE = 128
N_MEM = 256
MEM_HEADS = 4
MEM_HEAD_DIM = 128
MEM_WIDTH = MEM_HEADS * MEM_HEAD_DIM
D_FF = (7 * D_MODEL) // 2
N_EXPERTS = 8
TOP_K = 2
MOE_BLK = 256
EPS = 1e-6
N_DENSE = (DEPTH + 1) // 2
N_MOE = DEPTH // 2

kernel_name = "hymba_stickbreak_swa_sink_memxattn_moe"


def rms_norm(x, g):
    xf = x.astype(jnp.float32)
    y = xf * lax.rsqrt(jnp.mean(xf * xf, axis=-1, keepdims=True) + EPS)
    return (y * g.astype(jnp.float32)).astype(x.dtype)


def t5_buckets(dist):
    n = np.maximum(dist, 0)
    max_exact = N_BUCKETS // 2
    large = max_exact + (np.log(np.maximum(n, 1) / max_exact) / np.log(MAX_DISTANCE / max_exact)
                         * (N_BUCKETS - max_exact)).astype(np.int32)
    large = np.minimum(large, N_BUCKETS - 1)
    return np.where(n < max_exact, n, large).astype(np.int32)


def stick_breaking_attention(q, k, v):
    S, d = q.shape[2], q.shape[3]
    scale = d ** -0.5
    outs = []
    for i in range(S // QBLK):
        t0, t1 = i * QBLK, (i + 1) * QBLK
        qb, kp, vp = q[:, :, t0:t1], k[:, :, :t1], v[:, :, :t1]
        z = jnp.einsum('bhqd,bhkd->bhqk', qb, kp).astype(jnp.float32) * scale
        strict = (jnp.arange(t1)[None, :] < (t0 + jnp.arange(QBLK))[:, None])
        log_beta = jax.nn.log_sigmoid(z)
        log_one_minus = jnp.where(strict, jax.nn.log_sigmoid(-z), 0.0)
        tail = lax.cumsum(log_one_minus, axis=3, reverse=True) - log_one_minus
        a = jnp.where(strict, jnp.exp(log_beta + tail), 0.0)
        outs.append(jnp.einsum('bhqk,bhkd->bhqd', a.astype(v.dtype), vp))
    return jnp.concatenate(outs, axis=2)


def sliding_window_sink_attention(q, k, v, sinks, bias):
    B, S, _, d = q.shape
    nb = S // WINDOW
    qb = q.reshape(B, nb, WINDOW, SWA_KV_HEADS, SWA_GROUP, d)

    def band(t):
        tb = t.reshape(B, nb, WINDOW, SWA_KV_HEADS, d)
        prev = jnp.pad(tb, ((0, 0), (1, 0), (0, 0), (0, 0), (0, 0)))[:, :-1]
        return jnp.concatenate([prev, tb], axis=2)

    kw, vw = band(k), band(v)
    s = jnp.einsum('bnqhgd,bnkhd->bnhgqk', qb, kw).astype(jnp.float32) * (d ** -0.5)
    s = s + bias.astype(jnp.float32).reshape(SWA_KV_HEADS, SWA_GROUP, WINDOW, 2 * WINDOW)
    blk = jnp.arange(nb)[:, None, None]
    tpos = blk * WINDOW + jnp.arange(WINDOW)[None, :, None]
    spos = (blk - 1) * WINDOW + jnp.arange(2 * WINDOW)[None, None, :]
    valid = (spos <= tpos) & (tpos - spos < WINDOW) & (spos >= 0)
    s = jnp.where(valid[None, :, None, None], s, -jnp.inf)
    sink = sinks.astype(jnp.float32).reshape(1, 1, SWA_KV_HEADS, SWA_GROUP, 1, 1)
    m = jnp.maximum(jnp.max(s, axis=-1, keepdims=True), sink)
    p = jnp.exp(s - m)
    p = p / (jnp.sum(p, axis=-1, keepdims=True) + jnp.exp(sink - m))
    o = jnp.einsum('bnhgqk,bnkhd->bnqhgd', p.astype(v.dtype), vw)
    return o.reshape(B, S, SWA_Q_HEADS * d)


def memory_cross_attention(h, m, wq, wkv, q_gain, k_gain):
    B, S, _ = h.shape
    N = m.shape[1]
    q = (h @ wq).reshape(B, S, MEM_HEADS, MEM_HEAD_DIM)
    kv = m @ wkv
    k = kv[..., :MEM_WIDTH].reshape(B, N, MEM_HEADS, MEM_HEAD_DIM)
    v = kv[..., MEM_WIDTH:].reshape(B, N, MEM_HEADS, MEM_HEAD_DIM)
    q, k = rms_norm(q, q_gain), rms_norm(k, k_gain)
    s = jnp.einsum('bshd,bnhd->bhsn', q, k).astype(jnp.float32) * (MEM_HEAD_DIM ** -0.5)
    p = jax.nn.softmax(s, axis=-1)
    o = jnp.einsum('bhsn,bnhd->bshd', p.astype(v.dtype), v)
    return o.reshape(B, S, MEM_WIDTH)


def swiglu(h, w_gate, w_up, w_down):
    return (jax.nn.silu(h @ w_gate) * (h @ w_up)) @ w_down


def moe_swiglu(h, router_w, router_b, w_gate, w_up, w_down):
    T, D = h.shape
    logits = (h @ router_w).astype(jnp.float32) + router_b.astype(jnp.float32)
    top_val, top_idx = lax.top_k(logits, TOP_K)
    gates = jax.nn.softmax(top_val, axis=-1)
    flat_e = top_idx.reshape(-1)
    flat_t = jnp.repeat(jnp.arange(T, dtype=jnp.int32), TOP_K)
    flat_g = gates.reshape(-1).astype(h.dtype)
    onehot = jax.nn.one_hot(flat_e, N_EXPERTS, dtype=jnp.int32)
    rank = jnp.sum(jnp.cumsum(onehot, axis=0) * onehot, axis=-1) - 1
    counts = jnp.sum(onehot, axis=0)
    pcounts = (counts + MOE_BLK - 1) // MOE_BLK * MOE_BLK
    pends = jnp.cumsum(pcounts)
    pstarts = pends - pcounts
    dest = pstarts[flat_e] + rank
    P = T * TOP_K + N_EXPERTS * MOE_BLK
    nb = P // MOE_BLK
    row_tok = jnp.zeros((P,), jnp.int32).at[dest].set(flat_t)
    row_gate = jnp.zeros((P,), h.dtype).at[dest].set(flat_g)
    blk_e = jnp.minimum(jnp.searchsorted(pends, jnp.arange(nb) * MOE_BLK, side='right'), N_EXPERTS - 1)

    def one_block(args):
        tok, e = args
        return swiglu(h[tok], w_gate[e], w_up[e], w_down[e])

    ys = lax.map(one_block, (row_tok.reshape(nb, MOE_BLK), blk_e)).reshape(P, D)
    return jax.ops.segment_sum(ys * row_gate[:, None], row_tok, num_segments=T)


def setup_inputs(seed: int = 0) -> dict:
    key = jax.random.key(seed)
    ks = iter(jax.random.split(key, 40))
    f32 = jnp.float32
    res_scale = (2 * DEPTH) ** -0.5

    def w(shape, fan_in, extra=1.0):
        return jax.random.normal(next(ks), shape, f32) * (fan_in ** -0.5) * extra

    def gain(shape):
        return 1.0 + 0.02 * jax.random.normal(next(ks), shape, f32)

    return {
        "x": jax.random.normal(next(ks), (BATCH, SEQ, D_MODEL), f32),
        "mem": jax.random.normal(next(ks), (BATCH, N_MEM, D_MODEL), f32),
        "norm_mix": gain((DEPTH, D_MODEL)),
        "w_in": w((DEPTH, D_MODEL, IN_COLS), D_MODEL),
        "sb_out_gain": gain((DEPTH, SB_WIDTH)),
        "swa_q_gain": gain((DEPTH, HEAD_DIM)),
        "swa_k_gain": gain((DEPTH, HEAD_DIM)),
        "swa_sinks": 0.5 * jax.random.normal(next(ks), (DEPTH, SWA_Q_HEADS), f32),
        "swa_out_gain": gain((DEPTH, SWA_WIDTH)),
        "rel_bias": 0.5 * jax.random.normal(next(ks), (N_BUCKETS, SWA_Q_HEADS), f32),
        "w_out": w((DEPTH, MIX_WIDTH, D_MODEL), MIX_WIDTH, res_scale),
        "norm_xattn": gain((DEPTH, D_MODEL)),
        "norm_mem": gain((DEPTH, D_MODEL)),
        "xattn_wq": w((DEPTH, D_MODEL, MEM_WIDTH), D_MODEL),
        "xattn_wkv": w((DEPTH, D_MODEL, 2 * MEM_WIDTH), D_MODEL),
        "xattn_q_gain": gain((DEPTH, MEM_HEAD_DIM)),
        "xattn_k_gain": gain((DEPTH, MEM_HEAD_DIM)),
        "xattn_wo": w((DEPTH, MEM_WIDTH, D_MODEL), MEM_WIDTH, res_scale),
        "norm_ffn": gain((DEPTH, D_MODEL)),
        "dense_w_gate": w((N_DENSE, D_MODEL, D_FF), D_MODEL),
        "dense_w_up": w((N_DENSE, D_MODEL, D_FF), D_MODEL),
        "dense_w_down": w((N_DENSE, D_FF, D_MODEL), D_FF, res_scale),
        "router_w": w((N_MOE, D_MODEL, N_EXPERTS), D_MODEL),
        "router_b": 0.01 * jax.random.normal(next(ks), (N_MOE, N_EXPERTS), f32),
        "exp_w_gate": w((N_MOE, N_EXPERTS, D_MODEL, D_FF), D_MODEL),
        "exp_w_up": w((N_MOE, N_EXPERTS, D_MODEL, D_FF), D_MODEL),
        "exp_w_down": w((N_MOE, N_EXPERTS, D_FF, D_MODEL), D_FF, res_scale),
    }


def reference(x, mem, norm_mix, w_in, sb_out_gain, swa_q_gain, swa_k_gain, swa_sinks,
              swa_out_gain, rel_bias, w_out, norm_xattn, norm_mem, xattn_wq, xattn_wkv,
              xattn_q_gain, xattn_k_gain, xattn_wo, norm_ffn, dense_w_gate, dense_w_up,
              dense_w_down, router_w, router_b, exp_w_gate, exp_w_up, exp_w_down):
    B, S, D = x.shape
    dist = WINDOW + np.arange(WINDOW)[:, None] - np.arange(2 * WINDOW)[None, :]
    swa_bias = jnp.transpose(rel_bias[t5_buckets(dist)], (2, 0, 1))
    o1 = 3 * SB_WIDTH
    o2 = o1 + SWA_WIDTH
    o3 = o2 + SWA_KV_WIDTH
    for l in range(DEPTH):
        h = rms_norm(x, norm_mix[l])
        proj = h @ w_in[l]
        sb_q = proj[..., 0:SB_WIDTH].reshape(B, S, SB_HEADS, HEAD_DIM).transpose(0, 2, 1, 3)
        sb_k = proj[..., SB_WIDTH:2 * SB_WIDTH].reshape(B, S, SB_HEADS, HEAD_DIM).transpose(0, 2, 1, 3)
        sb_v = proj[..., 2 * SB_WIDTH:o1].reshape(B, S, SB_HEADS, HEAD_DIM).transpose(0, 2, 1, 3)
        sb_o = stick_breaking_attention(sb_q, sb_k, sb_v).transpose(0, 2, 1, 3).reshape(B, S, SB_WIDTH)
        sw_q = rms_norm(proj[..., o1:o2].reshape(B, S, SWA_Q_HEADS, HEAD_DIM), swa_q_gain[l])
        sw_k = rms_norm(proj[..., o2:o3].reshape(B, S, SWA_KV_HEADS, HEAD_DIM), swa_k_gain[l])
        sw_v = proj[..., o3:].reshape(B, S, SWA_KV_HEADS, HEAD_DIM)
        sw_o = sliding_window_sink_attention(sw_q, sw_k, sw_v, swa_sinks[l], swa_bias)
        mixed = jnp.concatenate([rms_norm(sb_o, sb_out_gain[l]), rms_norm(sw_o, swa_out_gain[l])], axis=-1)
        x = x + mixed @ w_out[l]
        hx = rms_norm(x, norm_xattn[l])
        hm = rms_norm(mem, norm_mem[l])
        x = x + memory_cross_attention(hx, hm, xattn_wq[l], xattn_wkv[l],
                                       xattn_q_gain[l], xattn_k_gain[l]) @ xattn_wo[l]
        hf = rms_norm(x, norm_ffn[l])
        i = l // 2
        if l % 2 == 0:
            x = x + swiglu(hf, dense_w_gate[i], dense_w_up[i], dense_w_down[i])
        else:
            y = moe_swiglu(hf.reshape(B * S, D), router_w[i], router_b[i],
                           exp_w_gate[i], exp_w_up[i], exp_w_down[i])
            x = x + y.reshape(B, S, D)
    return x
```

```cpp
#include <hip/hip_runtime.h>
#include <cstdio>
#include <cstdint>

#define GAS __attribute__((address_space(1)))
#define LAS __attribute__((address_space(3)))
typedef unsigned short bf16_t;
typedef short bf16x8 __attribute__((ext_vector_type(8)));
typedef float f32x4 __attribute__((ext_vector_type(4)));
typedef float f32x16 __attribute__((ext_vector_type(16)));
typedef unsigned u32x4 __attribute__((ext_vector_type(4)));
typedef unsigned u32x2 __attribute__((ext_vector_type(2)));
typedef int i32x4 __attribute__((ext_vector_type(4)));
typedef int i32x8 __attribute__((ext_vector_type(8)));

constexpr int D = 1024, NB = 32, SEQ = 2048, T = NB * SEQ, DEPTH = 4, FF = 3584, NE = 8, NMEM = 256;
constexpr float EPS = 1e-6f;
constexpr int NWAVES = 8, NTHR = 512;

constexpr size_t MiB = 1u << 20;
constexpr size_t WS_CTL = 0, CTL_BYTES = 1 * MiB;
constexpr size_t WS_WIN = 1 * MiB;
constexpr size_t WS_WOUT = 19 * MiB;
constexpr size_t WS_WQ = 27 * MiB;
constexpr size_t WS_WKV = 31 * MiB;
constexpr size_t WS_WO = 39 * MiB;
constexpr size_t WS_WGU = 43 * MiB;
constexpr size_t WS_WDN = 71 * MiB;
constexpr size_t WS_EGU = 85 * MiB;
constexpr size_t WS_EDN = 197 * MiB;
constexpr size_t WS_KN = 253 * MiB;
constexpr size_t WS_VT = 285 * MiB;
constexpr size_t WS_XB = 317 * MiB;
constexpr size_t WS_PROJ = 445 * MiB;
constexpr size_t WS_YS = 733 * MiB;
constexpr size_t WS_MOE = 993 * MiB;
constexpr size_t WS_SSQ = 1001 * MiB;
constexpr size_t WS_WSC = 1013 * MiB;
constexpr size_t WS_XQW = 1015 * MiB;
constexpr size_t WS_END = 1079 * MiB;
constexpr size_t SC_WD = 0, SC_WE = 64 * 1024, SC_ROW = 512 * 1024, SC_SROW = 1024 * 1024, SC_ROWW = 1568 * 1024, SC_WIN = 1856 * 1024;
constexpr size_t PJ_SBQ = 0, PJ_SBK = 64 * MiB, PJ_SBVT = 128 * MiB, PJ_SWQ = 192 * MiB, PJ_SWKV = 256 * MiB;
constexpr size_t PJ_XQ = 0, PJ_XO = 64 * MiB;
constexpr size_t PJ_H = 0;
constexpr size_t PJ_GB = 224 * MiB;
constexpr size_t PJ_XQ8 = 224 * MiB;
constexpr size_t PJ_HM = 0;
constexpr size_t MO_LIST = 0;
constexpr size_t MO_INFO = 2 * MiB;
constexpr size_t MO_GATE = 3 * MiB;
constexpr int CHUNK_BLK = 128;
constexpr size_t H_BUF = (size_t)CHUNK_BLK * 256 * FF, GB_BUF = (size_t)CHUNK_BLK * 256 * 1024;
constexpr int CW_BAR = 1024;
constexpr int CW_CNT = 8192;

__device__ __forceinline__ unsigned cvt_pk_bf16(float lo, float hi) { unsigned r; asm volatile("v_cvt_pk_bf16_f32 %0, %1, %2" : "=v"(r) : "v"(lo), "v"(hi)); return r; }
__device__ __forceinline__ float bf_lo(unsigned w) { return __uint_as_float(w << 16); }
__device__ __forceinline__ float bf_hi(unsigned w) { return __uint_as_float(w & 0xffff0000u); }
template <int K> __device__ __forceinline__ float lane_xor(float v) { return __int_as_float(__builtin_amdgcn_ds_swizzle(__float_as_int(v), (K << 10) | 0x1F)); }
__device__ __forceinline__ float xor32_add(float v) { const auto rr = __builtin_amdgcn_permlane32_swap(__float_as_uint(v), __float_as_uint(v), false, false); return __uint_as_float(rr[0]) + __uint_as_float(rr[1]); }
__device__ __forceinline__ float xor32_max(float v) { const auto rr = __builtin_amdgcn_permlane32_swap(__float_as_uint(v), __float_as_uint(v), false, false); return fmaxf(__uint_as_float(rr[0]), __uint_as_float(rr[1])); }
__device__ __forceinline__ float xor32_get(float v, int hi) { const auto rr = __builtin_amdgcn_permlane32_swap(__float_as_uint(v), __float_as_uint(v), false, false); return hi ? __uint_as_float(rr[0]) : __uint_as_float(rr[1]); }
__device__ __forceinline__ float wave_sum(float v) {
    v += lane_xor<1>(v); v += lane_xor<2>(v); v += lane_xor<4>(v); v += lane_xor<8>(v); v += lane_xor<16>(v); return xor32_add(v);
}
#define LDS_WAIT() asm volatile("s_waitcnt lgkmcnt(0)" ::: "memory")
__device__ __forceinline__ unsigned pk4_fp8(float a, float b, float c, float d) { int p = __builtin_amdgcn_cvt_pk_fp8_f32(a, b, 0, false); p = __builtin_amdgcn_cvt_pk_fp8_f32(c, d, p, true); return (unsigned)p; }
constexpr float WDN_SCALE = 256.f;

namespace pg8 {
constexpr int BM = 256, BK = 64, HALF = 128, HTB = HALF * BK * 2, STAGE_BYTES = 8 * HTB, NXCD = 8, WGM = 8;
constexpr int XL_OFF = STAGE_BYTES;
__host__ __device__ __forceinline__ int lds_byte(int r, int c) { const int st = (r >> 4) * 2 + (c >> 5), rr = r & 15, cc = c & 31, ob = rr * 64 + cc * 2; return st * 1024 + (ob ^ (((ob >> 9) & 1) << 5)); }
__host__ __device__ __forceinline__ void stage_rc(int b, int& R, int& C) { const int st = b / 1024, sb = b % 1024, swz = sb ^ (((sb >> 9) & 1) << 5); R = (st >> 1) * 16 + swz / 64; C = (st & 1) * 32 + (swz % 64) / 2; }
__host__ __device__ __forceinline__ int perm32(int rho) { const int n = rho >> 4, i = rho & 15; return 8 * (i >> 2) + 4 * n + (i & 3); }

struct Unit { const char* a; const char* b; const float* sc; const float* sc2; int pm, pn; };
__device__ __forceinline__ void tile_of(int L, int nM, int nN, int& pm, int& pn) {
    const int nwg = nM * nN; int wgid = L;
    { const int q = nwg / NXCD, r = nwg % NXCD, xcd = wgid % NXCD, off = wgid / NXCD; wgid = (xcd < r ? xcd * (q + 1) : r * (q + 1) + (xcd - r) * q) + off; }
    const int nig = WGM * nN, gid = wgid / nig, fm = gid * WGM, gsz = (nM - fm) < WGM ? (nM - fm) : WGM;
    pm = fm + ((wgid % nig) % gsz); pn = (wgid % nig) / gsz;
}
struct Out { char* o; const char* r; int ldo; bf16_t* xb; float* ssq; int scmode; };
__device__ __forceinline__ float rs_of(const float* p4) { const f32x4 q = *(const f32x4*)p4; return 1.0f / sqrtf(((q.x + q.y) + (q.z + q.w)) * (1.f / 1024.f) + 1e-6f); }
__device__ __forceinline__ float rs_lds(const LAS float* p4) { const f32x4 q = *(const LAS f32x4*)p4; return 1.0f / sqrtf(((q.x + q.y) + (q.z + q.w)) * (1.f / 1024.f) + 1e-6f); }

template <int MD> struct EpiStoreBf16T {
    static constexpr bool PERM = true; static constexpr int MODE = MD; typedef f32x4 acc_t; static constexpr float OSC = (MD == 2) ? 1.0f / WDN_SCALE : 1.0f;
    __device__ __forceinline__ void operator()(const f32x4 (&acc)[2][2][4][2], const Out& u, int wr, int wc, int fr, int fq, const LAS float* xl, LAS float* xr) const {
        asm volatile("" : "+v"(fr), "+v"(fq));
        bf16_t* base = (bf16_t*)u.o + wc * 32 + 8 * fq;
        float cs[2][8];
        if (u.scmode == 2) {
#pragma unroll
            for (int bj = 0; bj < 2; ++bj)
#pragma unroll
                for (int j = 0; j < 8; ++j) cs[bj][j] = rs_lds(xl + (bj * HALF + wc * 32 + 8 * fq + j) * 4);
        }
#pragma unroll
        for (int ai = 0; ai < 2; ++ai)
#pragma unroll
            for (int m = 0; m < 4; ++m) { const int row = ai * HALF + wr * 64 + m * 16 + fr; bf16_t* rowp = base + (size_t)row * u.ldo;
                float rsc = OSC; if (u.scmode == 1) rsc = rs_lds(xl + row * 4);
#pragma unroll
                for (int bj = 0; bj < 2; ++bj) { f32x4 v0 = acc[ai][bj][m][0] * rsc, v1 = acc[ai][bj][m][1] * rsc;
                    if (u.scmode == 2) { v0.x *= cs[bj][0]; v0.y *= cs[bj][1]; v0.z *= cs[bj][2]; v0.w *= cs[bj][3]; v1.x *= cs[bj][4]; v1.y *= cs[bj][5]; v1.z *= cs[bj][6]; v1.w *= cs[bj][7]; }
                    u32x4 w; w.x = cvt_pk_bf16(v0[0], v0[1]); w.y = cvt_pk_bf16(v0[2], v0[3]); w.z = cvt_pk_bf16(v1[0], v1[1]); w.w = cvt_pk_bf16(v1[2], v1[3]);
                    *(u32x4*)(rowp + bj * HALF) = w; } }
    }
};
typedef EpiStoreBf16T<0> EpiStoreBf16;
struct EpiStoreI8 {
    static constexpr bool PERM = true; static constexpr int MODE = 1; typedef i32x4 acc_t;
    __device__ __forceinline__ void operator()(const i32x4 (&acc)[2][2][4][2], const Out& u, int wr, int wc, int fr, int fq, const LAS float* xl, LAS float* xr) const {
        asm volatile("" : "+v"(fr), "+v"(fq));
        bf16_t* base = (bf16_t*)u.o + wc * 32 + 8 * fq;
        float cs[2][8];
#pragma unroll
        for (int bj = 0; bj < 2; ++bj) { const f32x4 c0 = *(const LAS f32x4*)(xl + 256 + bj * HALF + wc * 32 + 8 * fq), c1 = *(const LAS f32x4*)(xl + 256 + bj * HALF + wc * 32 + 8 * fq + 4);
            cs[bj][0] = c0.x; cs[bj][1] = c0.y; cs[bj][2] = c0.z; cs[bj][3] = c0.w; cs[bj][4] = c1.x; cs[bj][5] = c1.y; cs[bj][6] = c1.z; cs[bj][7] = c1.w; }
#pragma unroll
        for (int ai = 0; ai < 2; ++ai)
#pragma unroll
            for (int m = 0; m < 4; ++m) { const int row = ai * HALF + wr * 64 + m * 16 + fr; bf16_t* rowp = base + (size_t)row * u.ldo; const float rsc = xl[row];
#pragma unroll
                for (int bj = 0; bj < 2; ++bj) { float v[8];
#pragma unroll
                    for (int n = 0; n < 2; ++n)
#pragma unroll
                        for (int j = 0; j < 4; ++j) v[n * 4 + j] = (float)acc[ai][bj][m][n][j] * (rsc * cs[bj][n * 4 + j]);
                    u32x4 w; w.x = cvt_pk_bf16(v[0], v[1]); w.y = cvt_pk_bf16(v[2], v[3]); w.z = cvt_pk_bf16(v[4], v[5]); w.w = cvt_pk_bf16(v[6], v[7]);
                    *(u32x4*)(rowp + bj * HALF) = w; } }
    }
};
struct EpiSwiGLU8 {
    static constexpr bool PERM = true; static constexpr int MODE = 1; typedef i32x4 acc_t;
    __device__ __forceinline__ void operator()(const i32x4 (&acc)[2][2][4][2], const Out& u, int wr, int wc, int fr, int fq, const LAS float* xl, LAS float* xr) const {
        asm volatile("" : "+v"(fr), "+v"(fq));
        unsigned char* base = (unsigned char*)u.o + wc * 32 + 8 * fq;
        const f32x4 cg0 = *(const LAS f32x4*)(xl + 256 + wc * 32 + 8 * fq), cg1 = *(const LAS f32x4*)(xl + 256 + wc * 32 + 8 * fq + 4);
        const f32x4 cu0 = *(const LAS f32x4*)(xl + 256 + HALF + wc * 32 + 8 * fq), cu1 = *(const LAS f32x4*)(xl + 256 + HALF + wc * 32 + 8 * fq + 4);
        const float cg[8] = {cg0.x, cg0.y, cg0.z, cg0.w, cg1.x, cg1.y, cg1.z, cg1.w}, cu[8] = {cu0.x, cu0.y, cu0.z, cu0.w, cu1.x, cu1.y, cu1.z, cu1.w};
#pragma unroll
        for (int ai = 0; ai < 2; ++ai)
#pragma unroll
            for (int m = 0; m < 4; ++m) { const int row = ai * HALF + wr * 64 + m * 16 + fr; unsigned char* rowp = base + (size_t)row * u.ldo;
                float nl2e = -1.4426950408889634f; asm volatile("" : "+s"(nl2e));
                const float rsc = xl[row], r2 = rsc * nl2e, rs2 = rsc * rsc;
                float h[8];
                typedef float f32x2_ __attribute__((ext_vector_type(2)));
#pragma unroll
                for (int n = 0; n < 2; ++n) { f32x2_ p[2], q[2], e[2];
#pragma unroll
                    for (int j = 0; j < 2; ++j) { p[j] = (f32x2_){(float)acc[ai][0][m][n][2 * j], (float)acc[ai][0][m][n][2 * j + 1]} * (f32x2_){cg[n * 4 + 2 * j], cg[n * 4 + 2 * j + 1]};
                                                  q[j] = (f32x2_){(float)acc[ai][1][m][n][2 * j], (float)acc[ai][1][m][n][2 * j + 1]} * (f32x2_){cu[n * 4 + 2 * j], cu[n * 4 + 2 * j + 1]}; }
#pragma unroll
                    for (int j = 0; j < 2; ++j) { const f32x2_ t = p[j] * r2; e[j].x = __builtin_amdgcn_exp2f(t.x); e[j].y = __builtin_amdgcn_exp2f(t.y); }
#pragma unroll
                    for (int j = 0; j < 2; ++j) { e[j] = e[j] + 1.0f; q[j] = p[j] * q[j]; }
#pragma unroll
                    for (int j = 0; j < 2; ++j) { e[j].x = __builtin_amdgcn_rcpf(e[j].x); e[j].y = __builtin_amdgcn_rcpf(e[j].y); }
#pragma unroll
                    for (int j = 0; j < 2; ++j) { const f32x2_ hh = q[j] * (e[j] * rs2); h[n * 4 + 2 * j] = hh.x; h[n * 4 + 2 * j + 1] = hh.y; } }
                u32x2 w; w.x = pk4_fp8(h[0], h[1], h[2], h[3]); w.y = pk4_fp8(h[4], h[5], h[6], h[7]);
                *(u32x2*)rowp = w; }
    }
};
template <int MD> struct EpiResidT {
    static constexpr bool PERM = true; static constexpr int MODE = MD; typedef f32x4 acc_t; static constexpr float OSC = (MD == 2) ? 1.0f / WDN_SCALE : 1.0f;
    __device__ __forceinline__ void operator()(const f32x4 (&acc)[2][2][4][2], const Out& u, int wr, int wc, int fr, int fq, const LAS float* xl_unused, LAS float* xl) const {
        asm volatile("" : "+v"(fr), "+v"(fq));
        bf16_t* base = u.xb + wc * 32 + 8 * fq;
        float ps[8];
        u32x4 rv[2][4][2];
#pragma unroll
        for (int ai = 0; ai < 2; ++ai)
#pragma unroll
            for (int m = 0; m < 4; ++m)
#pragma unroll
                for (int bj = 0; bj < 2; ++bj) rv[ai][m][bj] = *(const u32x4*)(base + (size_t)(ai * HALF + wr * 64 + m * 16 + fr) * 1024 + bj * HALF);
#pragma unroll
        for (int ai = 0; ai < 2; ++ai)
#pragma unroll
            for (int m = 0; m < 4; ++m) { bf16_t* rowp = base + (size_t)(ai * HALF + wr * 64 + m * 16 + fr) * 1024; float q = 0.f;
#pragma unroll
                for (int bj = 0; bj < 2; ++bj) { const u32x4 r = rv[ai][m][bj]; const f32x4 a0 = acc[ai][bj][m][0] * OSC, a1 = acc[ai][bj][m][1] * OSC;
                    const float x0 = bf_lo(r.x) + a0.x, x1 = bf_hi(r.x) + a0.y, x2 = bf_lo(r.y) + a0.z, x3 = bf_hi(r.y) + a0.w, x4 = bf_lo(r.z) + a1.x, x5 = bf_hi(r.z) + a1.y, x6 = bf_lo(r.w) + a1.z, x7 = bf_hi(r.w) + a1.w;
                    q += ((x0 * x0 + x1 * x1) + (x2 * x2 + x3 * x3)) + ((x4 * x4 + x5 * x5) + (x6 * x6 + x7 * x7));
                    u32x4 w; w.x = cvt_pk_bf16(x0, x1); w.y = cvt_pk_bf16(x2, x3); w.z = cvt_pk_bf16(x4, x5); w.w = cvt_pk_bf16(x6, x7);
                    *(u32x4*)(rowp + bj * HALF) = w; }
                q += lane_xor<16>(q); q = xor32_add(q); ps[ai * 4 + m] = q; }
        if (fq == 0) {
#pragma unroll
            for (int ai = 0; ai < 2; ++ai)
#pragma unroll
                for (int m = 0; m < 4; ++m) xl[(ai * HALF + wr * 64 + m * 16 + fr) * 4 + wc] = ps[ai * 4 + m]; }
        asm volatile("s_waitcnt lgkmcnt(0)" ::: "memory"); __builtin_amdgcn_s_barrier(); asm volatile("" ::: "memory");
        const int t = wr * 256 + wc * 64 + fq * 16 + fr;
        if (t < 256) { const f32x4 q4 = *(const LAS f32x4*)(xl + t * 4); u.ssq[(size_t)t * 4] = (q4.x + q4.y) + (q4.z + q4.w); }
        asm volatile("s_waitcnt lgkmcnt(0)" ::: "memory"); __builtin_amdgcn_s_barrier(); asm volatile("" ::: "memory");
    }
};

typedef EpiResidT<0> EpiResid;
template <class Epi, class Sched>
__device__ __forceinline__ void gemm_phase(LAS unsigned char* lds, const int KB, const Sched& S, const Epi& E) {
    int tid = threadIdx.x; asm volatile("" : "+v"(tid));
    const int wid = __builtin_amdgcn_readfirstlane(tid >> 6), lane = tid & 63, wr = wid >> 2, wc = wid & 3, fr = lane & 15, fq = lane >> 4;
    const int nt = KB / 128;
    unsigned voffA[2], voffB[2];
#pragma unroll
    for (int i = 0; i < 2; ++i) { int R, C; stage_rc(tid * 16 + i * 8192, R, C); const int Rb = Epi::PERM ? ((R & ~31) + perm32(R & 31)) : R;
        voffA[i] = (unsigned)(R * KB + C * 2); voffB[i] = (unsigned)(Rb * KB + C * 2); }
    const size_t kstep = (size_t)(BK * 2);
    const size_t hstep = (size_t)HALF * KB;
    const unsigned ldsw = (unsigned)wid * 1024u;
    const unsigned ldsb_ = (unsigned)(size_t)lds;
    const int aoff = lds_byte(wr * 64 + fr, fq * 8), boff = lds_byte(wc * 32 + fr, fq * 8);
#define PG8_SA(b, h) (((b) * 2 + (h)) * HTB)
#define PG8_SB(b, h) ((4 + (b) * 2 + (h)) * HTB)
#define PG8_STAGE(bufoff, gbase, voff) do { const unsigned so_ = (unsigned)(size_t)(gbase) - (unsigned)(size_t)S.ws; \
        const __amdgpu_buffer_rsrc_t srd_ = __builtin_amdgcn_make_buffer_rsrc((void*)S.ws, (short)0, 0x7FFFFFFF, 0x00020000); \
        _Pragma("unroll") for (int _i = 0; _i < 2; ++_i) \
        asm volatile("s_mov_b32 m0, %0\n\ts_nop 0\n\tbuffer_load_dwordx4 %1, %2, %3 offen lds" :: "s"(ldsb_ + (unsigned)(bufoff) + ldsw + (unsigned)(_i * 8192)), "v"((voff)[_i]), "s"(srd_), "s"(so_) : "m0", "memory"); } while (0)
#define PG8_LDA(dst, b, h) do { _Pragma("unroll") for (int m = 0; m < 4; ++m) { if constexpr (Epi::MODE == 2) { const i32x4 lo_ = *(const LAS i32x4*)(lds + PG8_SA(b, h) + aoff + m * 2048), hi_ = *(const LAS i32x4*)(lds + PG8_SA(b, h) + aoff + m * 2048 + 1024); \
            dst##8[m] = __builtin_shufflevector(lo_, hi_, 0, 1, 2, 3, 4, 5, 6, 7); } else { _Pragma("unroll") for (int k = 0; k < 2; ++k) dst[m][k] = *(const LAS bf16x8*)(lds + PG8_SA(b, h) + aoff + m * 2048 + k * 1024); } } } while (0)
#define PG8_LDB(dst, b, h) do { _Pragma("unroll") for (int n = 0; n < 2; ++n) { if constexpr (Epi::MODE == 2) { const i32x4 lo_ = *(const LAS i32x4*)(lds + PG8_SB(b, h) + boff + n * 2048), hi_ = *(const LAS i32x4*)(lds + PG8_SB(b, h) + boff + n * 2048 + 1024); \
            dst##8[n] = __builtin_shufflevector(lo_, hi_, 0, 1, 2, 3, 4, 5, 6, 7); } else { _Pragma("unroll") for (int k = 0; k < 2; ++k) dst[n][k] = *(const LAS bf16x8*)(lds + PG8_SB(b, h) + boff + n * 2048 + k * 1024); } } } while (0)
#define PG8_MMA(ai, bj, At, Bt, Z) do { __builtin_amdgcn_s_setprio(1); _Pragma("unroll") for (int m = 0; m < 4; ++m) _Pragma("unroll") for (int n = 0; n < 2; ++n) { \
        if constexpr (Epi::MODE == 2) { \
            if constexpr ((Z) != 0) asm volatile("s_nop 1\n\tv_mfma_scale_f32_16x16x128_f8f6f4 %0, %1, %2, 0, %3, %3 op_sel_hi:[0,0,0]" : "=&v"(acc[ai][bj][m][n]) : "v"(Bt##8[n]), "v"(At##8[m]), "v"(f8one)); \
            else asm volatile("s_nop 1\n\tv_mfma_scale_f32_16x16x128_f8f6f4 %0, %1, %2, %0, %3, %3 op_sel_hi:[0,0,0]" : "+v"(acc[ai][bj][m][n]) : "v"(Bt##8[n]), "v"(At##8[m]), "v"(f8one)); } \
        else { _Pragma("unroll") for (int k = 0; k < 2; ++k) { const typename Epi::acc_t c_ = ((Z) != 0 && k == 0 && Epi::MODE == 1) ? (typename Epi::acc_t){0, 0, 0, 0} : acc[ai][bj][m][n]; \
            if constexpr (Epi::MODE == 1) acc[ai][bj][m][n] = __builtin_amdgcn_mfma_i32_16x16x64_i8(__builtin_bit_cast(i32x4, Bt[n][k]), __builtin_bit_cast(i32x4, At[m][k]), c_, 0, 0, 0); \
            else acc[ai][bj][m][n] = __builtin_amdgcn_mfma_f32_16x16x32_bf16(Bt[n][k], At[m][k], c_, 0, 0, 0); } } } __builtin_amdgcn_s_setprio(0); } while (0)
#define PG8_WAIT_V(n) asm volatile("s_waitcnt vmcnt(" #n ")" ::: "memory")
#define PG8_WAIT_L(n) asm volatile("s_waitcnt lgkmcnt(" #n ")" ::: "memory")
#define PG8_BAR __builtin_amdgcn_s_barrier()
#define PG8_SCHED __builtin_amdgcn_sched_barrier(0)
    Unit cur, nxt; int ui = 0;
    if (!__builtin_amdgcn_readfirstlane((int)S.next(0, cur))) return;
    typename Epi::acc_t acc[2][2][4][2];
#define PG8_ZERO_ACC do { if constexpr (Epi::MODE == 0) { _Pragma("unroll") for (int a = 0; a < 2; ++a) _Pragma("unroll") for (int b = 0; b < 2; ++b) _Pragma("unroll") for (int m = 0; m < 4; ++m) _Pragma("unroll") for (int n = 0; n < 2; ++n) \
        acc[a][b][m][n] = (typename Epi::acc_t){0, 0, 0, 0}; } } while (0)
    PG8_ZERO_ACC;
    bf16x8 At[4][2], B0[2][2], B1[2][2];
    i32x8 At8[4], B08[2], B18[2];
    const int f8one = 0x7F7F7F7F;
    const char* cA = cur.a; const char* cB = cur.b;
#define PG8_SCALES(un, buf) do { if ((un).sc != nullptr && wid < 4) { unsigned lane; asm volatile("v_mbcnt_lo_u32_b32 %0, -1, 0\n\tv_mbcnt_hi_u32_b32 %0, -1, %0" : "=v"(lane));        \
        if constexpr (Epi::MODE == 1) { __builtin_amdgcn_global_load_lds((const unsigned*)((un).sc + wid * 64 + lane), (LAS unsigned*)(lds + XL_OFF + (buf) * 4096 + wid * 256), 4, 0, 0); \
                                 __builtin_amdgcn_global_load_lds((const unsigned*)((un).sc2 + wid * 64 + lane), (LAS unsigned*)(lds + XL_OFF + (buf) * 4096 + 1024 + wid * 256), 4, 0, 0); } \
        else __builtin_amdgcn_global_load_lds((const unsigned*)((un).sc + (wid * 64 + lane) * 4), (LAS unsigned*)(lds + XL_OFF + (buf) * 4096 + wid * 1024), 16, 0, 0); } } while (0)
    PG8_SCALES(cur, 0);
    PG8_STAGE(PG8_SB(0, 0), cB, voffB); PG8_STAGE(PG8_SB(0, 1), cB + hstep, voffB); PG8_STAGE(PG8_SA(0, 0), cA, voffA); PG8_STAGE(PG8_SA(0, 1), cA + hstep, voffA);
    if (wr == 1) PG8_BAR;
    PG8_WAIT_V(2); PG8_BAR;
    PG8_STAGE(PG8_SB(1, 0), cB + kstep, voffB); PG8_STAGE(PG8_SA(1, 0), cA + kstep, voffA); PG8_STAGE(PG8_SB(1, 1), cB + hstep + kstep, voffB);
    PG8_WAIT_V(6); PG8_BAR;
    for (;;) {
        const bool has_next = S.next(ui + 1, nxt);
        const char* nA = has_next ? nxt.a : cA; const char* nB = has_next ? nxt.b : cB;
#define PG8_ITER(Z) do { \
            const bool last = (t == nt - 2); \
            const char* a1 = cA + (size_t)(t + 1) * kstep; \
            const char* a2 = last ? nA : cA + (size_t)(t + 2) * kstep; const char* b2 = last ? nB : cB + (size_t)(t + 2) * kstep; \
            const char* a3 = a2 + kstep; const char* b3 = b2 + kstep; \
            PG8_LDB(B0, 0, 0); PG8_LDB(B1, 0, 1); PG8_SCHED; PG8_LDA(At, 0, 0); PG8_STAGE(PG8_SA(1, 1), a1 + hstep, voffA); \
            PG8_WAIT_V(8); PG8_WAIT_L(0); PG8_BAR; PG8_MMA(0, 0, At, B0, Z); PG8_MMA(0, 1, At, B1, Z); PG8_BAR; PG8_SCHED; \
            PG8_LDA(At, 0, 1); PG8_STAGE(PG8_SB(0, 0), b2, voffB); PG8_STAGE(PG8_SB(0, 1), b2 + hstep, voffB); PG8_STAGE(PG8_SA(0, 0), a2, voffA); \
            PG8_WAIT_V(8); PG8_WAIT_L(0); PG8_BAR; PG8_MMA(1, 0, At, B0, Z); PG8_MMA(1, 1, At, B1, Z); PG8_BAR; PG8_SCHED; \
            PG8_LDB(B0, 1, 0); PG8_LDB(B1, 1, 1); PG8_SCHED; PG8_LDA(At, 1, 0); PG8_STAGE(PG8_SA(0, 1), a2 + hstep, voffA); \
            PG8_WAIT_V(8); PG8_WAIT_L(0); PG8_BAR; PG8_MMA(0, 0, At, B0, 0); PG8_MMA(0, 1, At, B1, 0); PG8_BAR; PG8_SCHED; \
            PG8_LDA(At, 1, 1); PG8_STAGE(PG8_SB(1, 0), b3, voffB); PG8_STAGE(PG8_SB(1, 1), b3 + hstep, voffB); PG8_STAGE(PG8_SA(1, 0), a3, voffA); \
            PG8_WAIT_V(8); PG8_WAIT_L(0); PG8_BAR; PG8_MMA(1, 0, At, B0, 0); PG8_MMA(1, 1, At, B1, 0); PG8_BAR; PG8_SCHED; } while (0)
        if constexpr (Epi::MODE == 0) { for (int t = 0; t < nt; t += 2) PG8_ITER(0); }
        else { { const int t = 0; PG8_ITER(1); }
               for (int t = 2; t < nt; t += 2) PG8_ITER(0); }
#undef PG8_ITER
        if (has_next) PG8_SCALES(nxt, (ui + 1) & 1);
        if (wr == 0) PG8_BAR;
        if constexpr (Epi::MODE == 2) asm volatile("s_nop 15\n\ts_nop 15\n\ts_nop 15" ::: "memory");
        { Out eo; S.out(cur, eo); unsigned le_; asm volatile("v_mbcnt_lo_u32_b32 %0, -1, 0\n\tv_mbcnt_hi_u32_b32 %0, -1, %0" : "=v"(le_));
          E(acc, eo, wr, wc, (int)(le_ & 15u), (int)(le_ >> 4), (LAS float*)(lds + XL_OFF + (ui & 1) * 4096), (LAS float*)(lds + XL_OFF + 8192)); }
        if (!has_next) break;
        PG8_ZERO_ACC;
        cur = nxt; cA = nA; cB = nB; ++ui;
        if (wr == 1) PG8_BAR;
    }
    PG8_WAIT_V(0);
    PG8_BAR;
#undef PG8_SCALES
#undef PG8_SA
#undef PG8_SB
#undef PG8_STAGE
#undef PG8_LDA
#undef PG8_LDB
#undef PG8_MMA
#undef PG8_WAIT_V
#undef PG8_WAIT_L
#undef PG8_BAR
#undef PG8_SCHED
}
}

#define XB_TMO      128
#define XB_XCNT(j)  (256  + 64 * (j))
#define XB_XSUB(j)  (1280 + 64 * (j))
#define XB_XGEN(j)  (2304 + 64 * (j))
#define XB_TOP      3328
#define XB_TOPGEN   3392
#define XCD_BAR_WORDS 3456
#define XB_SPIN_CAP (1u << 18)
__device__ __forceinline__ unsigned xb_ld(unsigned* p)              { return __hip_atomic_load(p, __ATOMIC_RELAXED, __HIP_MEMORY_SCOPE_AGENT); }
__device__ __forceinline__ unsigned xb_add(unsigned* p, unsigned v) { return __hip_atomic_fetch_add(p, v, __ATOMIC_RELAXED, __HIP_MEMORY_SCOPE_AGENT); }
__device__ __forceinline__ unsigned xb_xcc_id() { return (unsigned)__builtin_amdgcn_s_getreg((3 << 11) | 20) & 0xFu; }
#define XB_SPIN(cond, bar) do { unsigned _sp = 0; while (cond) { __builtin_amdgcn_s_sleep(1); \
    if ((++_sp & 255u) == 0u) { if (xb_ld(&(bar)[XB_TMO])) break; if (_sp > XB_SPIN_CAP) { atomicAdd(&(bar)[XB_TMO], 1u); break; } } } } while (0)
struct XcdBarrier { unsigned* bar; unsigned x; volatile LAS unsigned* st; };
__device__ __forceinline__ XcdBarrier xcd_barrier_post(unsigned* bar, volatile LAS unsigned* st) {
    XcdBarrier b; b.bar = bar; b.x = xb_xcc_id(); b.st = st;
    if (threadIdx.x == 0) (void)xb_add(&bar[XB_XCNT(b.x)], 1u);
    return b;
}
__device__ __forceinline__ void xcd_barrier_complete(unsigned* bar, unsigned x, unsigned& nloc, unsigned& nx) {
    const unsigned G = gridDim.x * gridDim.y * gridDim.z;
    unsigned sum, cnt, mine, sp = 0u;
    for (;;) {
        sum = 0u; cnt = 0u; mine = 0u;
#pragma unroll
        for (unsigned j = 0; j < 16; ++j) { const unsigned c = xb_ld(&bar[XB_XCNT(j)]); sum += c; cnt += (c > 0u) ? 1u : 0u; mine = (j == x) ? c : mine; }
        if (sum == G) break;
        __builtin_amdgcn_s_sleep(1);
        if ((++sp & 255u) == 0u) { if (xb_ld(&bar[XB_TMO])) break; if (sp > XB_SPIN_CAP) { atomicAdd(&bar[XB_TMO], 1u); break; } }
    }
    nloc = mine > 0u ? mine : 1u; nx = cnt > 0u ? cnt : 1u;
}
__device__ __forceinline__ void xcd_barrier(const XcdBarrier& b) {
    asm volatile("s_waitcnt vmcnt(0)" ::: "memory");
    __syncthreads();
    if (threadIdx.x == 0) {
        unsigned* bar = b.bar; asm volatile("" : "+s"(bar)); unsigned bx_ = b.x; asm volatile("" : "+s"(bx_));
        __builtin_amdgcn_s_waitcnt(0);
        unsigned nloc = b.st[0], nx = b.st[1];
        if (nloc == 0u) { xcd_barrier_complete(bar, bx_, nloc, nx); b.st[0] = nloc; b.st[1] = nx; }
        const unsigned old = xb_add(&bar[XB_XSUB(bx_)], 1u);
        const unsigned gen = old / nloc;
        if (old + 1u == (gen + 1u) * nloc) {
            __builtin_amdgcn_fence(__ATOMIC_RELEASE, "agent");
            asm volatile("s_waitcnt vmcnt(0)" ::: "memory");
            const unsigned og = xb_add(&bar[XB_TOP], 1u);
            const unsigned tg = og / nx;
            if (og + 1u == (tg + 1u) * nx) xb_add(&bar[XB_TOPGEN], 1u);
            else XB_SPIN(xb_ld(&bar[XB_TOPGEN]) == tg, bar);
            __builtin_amdgcn_fence(__ATOMIC_ACQUIRE, "agent");
            xb_add(&bar[XB_XGEN(bx_)], 1u);
            asm volatile("s_waitcnt vmcnt(0)" ::: "memory");
        } else {
            XB_SPIN(xb_ld(&bar[XB_XGEN(bx_)]) == gen, bar);
            __builtin_amdgcn_fence(__ATOMIC_ACQUIRE, "agent");
            asm volatile("s_waitcnt vmcnt(0)" ::: "memory");
        }
    }
    __syncthreads();
}

constexpr int RING_BYTES = 131072;
constexpr int MISC_OFF = RING_BYTES + 12288;
constexpr int LDS_BYTES = RING_BYTES + 4096 + 12288;

struct Params {
    const float* in[27];
    float* out;
    unsigned char* ws;
    int ph_lo, ph_hi;
};
enum { I_X = 0, I_MEM, I_NORM_MIX, I_W_IN, I_SB_OUT_GAIN, I_SWA_Q_GAIN, I_SWA_K_GAIN, I_SWA_SINKS, I_SWA_OUT_GAIN, I_REL_BIAS, I_W_OUT, I_NORM_XATTN, I_NORM_MEM,
       I_XWQ, I_XWKV, I_XQ_GAIN, I_XK_GAIN, I_XWO, I_NORM_FFN, I_DGATE, I_DUP, I_DDOWN, I_ROUTER_W, I_ROUTER_B, I_EGATE, I_EUP, I_EDOWN };

struct Frame {
    LAS unsigned char* lds;
    int tid, lane, wave;
    int G, bx;
};

template <class RowMap>
__device__ __forceinline__ void transpose_item(const float* W, int K, int N, bf16_t* WT, const RowMap& rm, LAS float* scr, int item, int lane) {
    const int nblk = N / 32, kb = item / nblk, nb = item % nblk, k0 = 64 * kb, n0 = 32 * nb;
    { f32x4 wv[8]; const int n4 = (lane & 7) * 4;
#pragma unroll
      for (int i = 0; i < 8; ++i) wv[i] = *(const f32x4*)(W + (size_t)(k0 + 8 * i + (lane >> 3)) * N + n0 + n4);
#pragma unroll
      for (int i = 0; i < 8; ++i) { const int kk = 8 * i + (lane >> 3); const float gk = rm.gain ? rm.gain[k0 + kk] : 1.0f; LAS float* d = scr + kk * 33 + n4; d[0] = wv[i].x * gk; d[1] = wv[i].y * gk; d[2] = wv[i].z * gk; d[3] = wv[i].w * gk; } }
    LDS_WAIT(); asm volatile("" ::: "memory");
    const int c = lane & 7; const int r0 = rm(n0);
#pragma unroll
    for (int j = 0; j < 4; ++j) { const int n = (lane >> 3) + 8 * j; const LAS float* s = scr + (8 * c) * 33 + n;
        u32x4 o; o.x = cvt_pk_bf16(s[0 * 33], s[1 * 33]); o.y = cvt_pk_bf16(s[2 * 33], s[3 * 33]); o.z = cvt_pk_bf16(s[4 * 33], s[5 * 33]); o.w = cvt_pk_bf16(s[6 * 33], s[7 * 33]);
        *(u32x4*)(WT + (size_t)(r0 + n) * K + k0 + 8 * c) = o; }
    LDS_WAIT(); asm volatile("" ::: "memory");
}
template <class RowMap>
__device__ __forceinline__ void transpose_item_f8(const float* W, int K, int N, unsigned char* WT, const RowMap& rm, LAS float* scr, int item, int lane) {
    const int nblk = N / 32, kb = item / nblk, nb = item % nblk, k0 = 64 * kb, n0 = 32 * nb;
    { f32x4 wv[8]; const int n4 = (lane & 7) * 4;
#pragma unroll
      for (int i = 0; i < 8; ++i) wv[i] = *(const f32x4*)(W + (size_t)(k0 + 8 * i + (lane >> 3)) * N + n0 + n4);
#pragma unroll
      for (int i = 0; i < 8; ++i) { LAS float* d = scr + (8 * i + (lane >> 3)) * 33 + n4; d[0] = wv[i].x * WDN_SCALE; d[1] = wv[i].y * WDN_SCALE; d[2] = wv[i].z * WDN_SCALE; d[3] = wv[i].w * WDN_SCALE; } }
    LDS_WAIT(); asm volatile("" ::: "memory");
    const int c = lane & 7; const int r0 = rm(n0);
#pragma unroll
    for (int j = 0; j < 4; ++j) { const int n = (lane >> 3) + 8 * j; const LAS float* sp = scr + (8 * c) * 33 + n;
        u32x2 o; o.x = pk4_fp8(sp[0 * 33], sp[1 * 33], sp[2 * 33], sp[3 * 33]); o.y = pk4_fp8(sp[4 * 33], sp[5 * 33], sp[6 * 33], sp[7 * 33]);
        *(u32x2*)(WT + (size_t)(r0 + n) * K + k0 + 8 * c) = o; }
    LDS_WAIT(); asm volatile("" ::: "memory");
}
struct RowIdent { const float* gain = nullptr; __device__ __forceinline__ int operator()(int n0) const { return n0; } };
struct RowGate { const float* gain = nullptr; __device__ __forceinline__ int operator()(int n0) const { return (n0 >> 7) * 256 + (n0 & 127); } };
struct RowUp { const float* gain = nullptr; __device__ __forceinline__ int operator()(int n0) const { return (n0 >> 7) * 256 + 128 + (n0 & 127); } };

__device__ __forceinline__ void norm_row(const float* xrow, bf16_t* orow, const f32x4 (&g)[4], f32x4 (&v)[4], int lane) {
    const f32x4* xr = (const f32x4*)xrow + lane; float s = 0.f;
#pragma unroll
    for (int j = 0; j < 4; ++j) { v[j] = xr[64 * j]; s += (v[j].x * v[j].x + v[j].y * v[j].y) + (v[j].z * v[j].z + v[j].w * v[j].w); }
    const float rs = 1.0f / sqrtf(wave_sum(s) * (1.f / D) + EPS);
    u32x2* o8 = (u32x2*)orow + lane;
#pragma unroll
    for (int j = 0; j < 4; ++j) { v[j] = v[j] * rs * g[j]; u32x2 w; w.x = cvt_pk_bf16(v[j].x, v[j].y); w.y = cvt_pk_bf16(v[j].z, v[j].w); o8[64 * j] = w; }
}

__device__ __forceinline__ int pi32(int i) { return 16 * ((i >> 2) & 1) + 4 * (i >> 3) + (i & 3); }
__device__ __forceinline__ bf16x8 pack8(const float* p) {
    u32x4 w; w.x = cvt_pk_bf16(p[0], p[1]); w.y = cvt_pk_bf16(p[2], p[3]); w.z = cvt_pk_bf16(p[4], p[5]); w.w = cvt_pk_bf16(p[6], p[7]);
    return __builtin_bit_cast(bf16x8, w);
}
__device__ __forceinline__ void unpack8(bf16x8 v, float* f) {
    const u32x4 w = __builtin_bit_cast(u32x4, v);
    f[0] = bf_lo(w.x); f[1] = bf_hi(w.x); f[2] = bf_lo(w.y); f[3] = bf_hi(w.y); f[4] = bf_lo(w.z); f[5] = bf_hi(w.z); f[6] = bf_lo(w.w); f[7] = bf_hi(w.w);
}
#define MFMA32(a, b, c) __builtin_amdgcn_mfma_f32_32x32x16_bf16((a), (b), (c), 0, 0, 0)
__device__ __forceinline__ u32x4 pair_halves(u32x2 even, u32x2 odd) {
    const auto x = __builtin_amdgcn_permlane32_swap(even.x, odd.x, false, false), y = __builtin_amdgcn_permlane32_swap(even.y, odd.y, false, false);
    return (u32x4){x[0], y[0], x[1], y[1]};
}

__device__ __forceinline__ void group_norm_store(const f32x16 (&o)[2], int h, int r32, int hi, const LAS float* gain, bf16_t* outrow0, LAS float* part  ) {
    float a = 0.f;
#pragma unroll
    for (int dd = 0; dd < 2; ++dd)
#pragma unroll
        for (int r = 0; r < 16; ++r) a += o[dd][r] * o[dd][r];
    a = xor32_add(a);
    if (hi == 0) part[h * 32 + r32] = a;
    __syncthreads();
    float tot = 0.f;
#pragma unroll
    for (int hh = 0; hh < 8; ++hh) tot += part[hh * 32 + r32];
    const float rs = 1.0f / sqrtf(tot * (1.f / 512.f) + EPS);
    bf16_t* orow = outrow0 + (size_t)r32 * 1024 + h * 64 + 8 * hi;
#pragma unroll
    for (int dd = 0; dd < 2; ++dd)
#pragma unroll
        for (int k = 0; k < 2; ++k) { u32x2 w[2];
#pragma unroll
            for (int e = 0; e < 2; ++e) { const int gq = 2 * k + e; const f32x4 gv = *(const LAS f32x4*)(gain + h * 64 + 32 * dd + 8 * gq + 4 * hi);
                w[e].x = cvt_pk_bf16(o[dd][4 * gq] * rs * gv.x, o[dd][4 * gq + 1] * rs * gv.y); w[e].y = cvt_pk_bf16(o[dd][4 * gq + 2] * rs * gv.z, o[dd][4 * gq + 3] * rs * gv.w); }
            *(u32x4*)(orow + 32 * dd + 16 * k) = pair_halves(w[0], w[1]); }
}

constexpr float SB_THR = -40.f * 1.4426950408889634f;
__device__ __forceinline__ void sb_block(const bf16x8 (&kf)[4], const bf16x8 (&vf)[2][2], const LAS bf16x8* qp  , f32x16 (&o)[2], float& C, int key0, int tq0  , int r32, int hi) {
    f32x16 s;
#pragma unroll
    for (int r = 0; r < 16; ++r) s[r] = 0.f;
#pragma unroll
    for (int d0 = 0; d0 < 4; ++d0) s = MFMA32(kf[d0], qp[64 * d0], s);
    const int tqr = tq0 + r32, kk0 = key0 + 16 * hi;
    float pre[16]; float run = 0.f; float p[16];
    if (key0 + 31 >= tq0) {
#pragma unroll
        for (int r = 15; r >= 0; --r) {
            const float z = s[r] * (0.125f * 1.4426950408889634f);
            const float sp = fmaxf(z, 0.f) + __builtin_amdgcn_logf(1.0f + __builtin_amdgcn_exp2f(-fabsf(z)));
            pre[r] = (z - sp) + run;
            run += ((kk0 + r) < tqr) ? -sp : 0.f;
        }
        const float other = xor32_get(run, hi);
        const float base = C + (hi == 0 ? other : 0.f);
#pragma unroll
        for (int r = 0; r < 16; ++r) p[r] = ((kk0 + r) < tqr) ? __builtin_amdgcn_exp2f(pre[r] + base) : 0.f;
        C += run + other;
    } else {
#pragma unroll
        for (int r = 15; r >= 0; --r) {
            const float z = s[r] * (0.125f * 1.4426950408889634f);
            const float sp = fmaxf(z, 0.f) + __builtin_amdgcn_logf(1.0f + __builtin_amdgcn_exp2f(-fabsf(z)));
            pre[r] = (z - sp) + run;
            run -= sp;
        }
        const float other = xor32_get(run, hi);
        const float base = C + (hi == 0 ? other : 0.f);
#pragma unroll
        for (int r = 0; r < 16; ++r) p[r] = __builtin_amdgcn_exp2f(pre[r] + base);
        C += run + other;
    }
    const bf16x8 pa0 = pack8(p), pa1 = pack8(p + 8);
#pragma unroll
    for (int dd = 0; dd < 2; ++dd) { o[dd] = MFMA32(vf[dd][0], pa0, o[dd]); o[dd] = MFMA32(vf[dd][1], pa1, o[dd]); }
}
__device__ __forceinline__ void sb_unit(const Frame& F, int b, int tq, const bf16_t* sbq, const bf16_t* sbk, const bf16_t* sbvT, const LAS float* gain, bf16_t* mixed, LAS float* part, LAS unsigned char* lds) {
    int lane = F.lane; asm volatile("" : "+v"(lane));
    const int r32 = lane & 31, hi = lane >> 5, h = F.wave;
    const size_t rowbase = (size_t)b * SEQ; const int t0 = tq * 64;
    LAS bf16x8* qlds = (LAS bf16x8*)(lds + h * 8192) + lane;
    { bf16x8 qt[8];
#pragma unroll
      for (int i = 0; i < 8; ++i) qt[i] = *(const bf16x8*)(sbq + (rowbase + t0 + 32 * (i >> 2) + r32) * 512 + h * 64 + 16 * (i & 3) + 8 * hi);
#pragma unroll
      for (int i = 0; i < 8; ++i) qlds[64 * i] = qt[i]; }
    f32x16 o[2][2];
#pragma unroll
    for (int g = 0; g < 2; ++g)
#pragma unroll
        for (int dd = 0; dd < 2; ++dd)
#pragma unroll
            for (int r = 0; r < 16; ++r) o[g][dd][r] = 0.f;
    float C[2] = {0.f, 0.f};
    const bf16_t* kbase = sbk + (rowbase + pi32(r32)) * 512 + h * 64 + 8 * hi;
    const bf16_t* vbase = sbvT + ((size_t)(b * 8 + h) * 64 + r32) * SEQ + 16 * hi;
#define SB_LOAD(KF, VF, kb_) do { const int k0_ = (kb_) * 32; \
        _Pragma("unroll") for (int d0 = 0; d0 < 4; ++d0) KF[d0] = *(const bf16x8*)(kbase + (size_t)k0_ * 512 + 16 * d0); \
        _Pragma("unroll") for (int dd = 0; dd < 2; ++dd) _Pragma("unroll") for (int s_ = 0; s_ < 2; ++s_) VF[dd][s_] = *(const bf16x8*)(vbase + (size_t)(32 * dd) * SEQ + k0_ + 8 * s_); } while (0)
#define SB_STEP(KF, VF, kb_) do { const int k0_ = (kb_) * 32; \
        _Pragma("unroll") for (int g = 0; g < 2; ++g) { if (k0_ > t0 + 32 * g + 31) continue; if (__all(C[g] < SB_THR)) continue; sb_block(KF, VF, qlds + 256 * g, o[g], C[g], k0_, t0 + 32 * g, r32, hi); } } while (0)
    bf16x8 kfA[4], vfA[2][2], kfB[4], vfB[2][2];
    int kb = 2 * tq + 1;
    SB_LOAD(kfA, vfA, kb);
    for (;;) {
        SB_LOAD(kfB, vfB, kb >= 1 ? kb - 1 : 0);
        SB_STEP(kfA, vfA, kb);
        if (kb == 0 || __all(C[0] < SB_THR && C[1] < SB_THR)) break;
        SB_LOAD(kfA, vfA, kb >= 2 ? kb - 2 : 0);
        SB_STEP(kfB, vfB, kb - 1);
        if (kb == 1 || __all(C[0] < SB_THR && C[1] < SB_THR)) break;
        kb -= 2;
    }
#undef SB_LOAD
#undef SB_STEP
    group_norm_store(o[0], h, r32, hi, gain, mixed + (rowbase + t0) * 1024, part);
    group_norm_store(o[1], h, r32, hi, gain, mixed + (rowbase + t0 + 32) * 1024, part + 256);
}

constexpr int SW_KROW = 144, SW_VROW = 400;
constexpr int SW_KS = 0, SW_VT = 2 * 192 * SW_KROW, SW_END = SW_VT + 2 * 64 * SW_VROW;
template <bool INTERIOR>
__device__ __forceinline__ void swa_groups(const bf16x8 (&qraw0)[4], const bf16x8 (&qraw1)[4], int h, int kvh, int r32, int hi, int kstart, size_t rowbase, int t0, const LAS float* qgain, float sink, const LAS float* ogain,
                                           bf16_t* mixed, LAS unsigned char* lds, const LAS float* bias, LAS float* part) {
#pragma nounroll
    for (int g = 0; g < 2; ++g) {
        f32x16 o[2];
        bf16x8 qf[4];
        { float qv[4][8]; float ss = 0.f;
#pragma unroll
          for (int d0 = 0; d0 < 4; ++d0) { unpack8(g ? qraw1[d0] : qraw0[d0], qv[d0]);
#pragma unroll
              for (int jj = 0; jj < 8; ++jj) ss += qv[d0][jj] * qv[d0][jj]; }
          ss = xor32_add(ss);
          const float rs = (0.125f * 1.4426950408889634f) / sqrtf(ss * (1.f / 64.f) + EPS);
#pragma unroll
          for (int d0 = 0; d0 < 4; ++d0) { const f32x4 g0 = *(const LAS f32x4*)(qgain + 16 * d0 + 8 * hi), g1 = *(const LAS f32x4*)(qgain + 16 * d0 + 8 * hi + 4);
              float qn[8] = {qv[d0][0] * rs * g0.x, qv[d0][1] * rs * g0.y, qv[d0][2] * rs * g0.z, qv[d0][3] * rs * g0.w, qv[d0][4] * rs * g1.x, qv[d0][5] * rs * g1.y, qv[d0][6] * rs * g1.z, qv[d0][7] * rs * g1.w};
              qf[d0] = pack8(qn); } }
        f32x16 sc[5];
        const int qw = 128 + 32 * g + r32;
#pragma unroll
        for (int jb = 0; jb < 5; ++jb) {
            const LAS unsigned char* kp = lds + SW_KS + (kvh * 192 + 32 * (g + jb) + pi32(r32)) * SW_KROW + 16 * hi;
#pragma unroll
            for (int r = 0; r < 16; ++r) sc[jb][r] = 0.f;
#pragma unroll
            for (int d0 = 0; d0 < 4; ++d0) sc[jb] = MFMA32(*(const LAS bf16x8*)(kp + 32 * d0), qf[d0], sc[jb]);
        }
        float m = sink;
#pragma unroll
        for (int jb = 0; jb < 5; ++jb) {
            const int kb = g + jb;
            const LAS float* bt = bias + h * 128 + (qw - 32 * kb - 16 * hi - 15);
            float bv[16];
#pragma unroll
            for (int r = 0; r < 16; ++r) bv[r] = bt[15 - r];
            const int d0_ = qw - 32 * kb - 16 * hi;
            if constexpr (INTERIOR) {
#pragma unroll
                for (int r = 0; r < 16; ++r) { const bool valid = (jb == 0) ? (d0_ - r < 128) : (jb == 4) ? (d0_ - r >= 0) : true;
                    const float v = valid ? sc[jb][r] + bv[r] : -INFINITY; sc[jb][r] = v; m = fmaxf(m, v); }
            } else {
#pragma unroll
                for (int r = 0; r < 16; ++r) { const int kw = 32 * kb + 16 * hi + r, dist = d0_ - r; const bool valid = (dist >= 0) && (dist < 128) && (kstart + kw >= 0);
                    const float v = valid ? sc[jb][r] + bv[r] : -INFINITY; sc[jb][r] = v; m = fmaxf(m, v); }
            }
        }
        m = xor32_max(m);
        float l = 0.f;
#pragma unroll
        for (int jb = 0; jb < 5; ++jb)
#pragma unroll
            for (int r = 0; r < 16; ++r) { const float p = __builtin_amdgcn_exp2f(sc[jb][r] - m); sc[jb][r] = p; l += p; }
        l = xor32_add(l); l += __builtin_amdgcn_exp2f(sink - m);
#pragma unroll
        for (int dd = 0; dd < 2; ++dd)
#pragma unroll
            for (int r = 0; r < 16; ++r) o[dd][r] = 0.f;
#pragma unroll
        for (int jb = 0; jb < 5; ++jb) {
            const int kb = g + jb;
            float p[16];
#pragma unroll
            for (int r = 0; r < 16; ++r) p[r] = sc[jb][r];
            const bf16x8 pa0 = pack8(p), pa1 = pack8(p + 8);
#pragma unroll
            for (int dd = 0; dd < 2; ++dd) { const LAS unsigned char* vp = lds + SW_VT + (kvh * 64 + 32 * dd + r32) * SW_VROW; const int vsw = (4 * dd + (r32 >> 3)) & 7, vc = 4 * kb + 2 * hi;
                o[dd] = MFMA32(*(const LAS bf16x8*)(vp + ((vc ^ vsw) << 4)), pa0, o[dd]); o[dd] = MFMA32(*(const LAS bf16x8*)(vp + (((vc + 1) ^ vsw) << 4)), pa1, o[dd]); }
        }
        const float inv = 1.0f / l;
#pragma unroll
        for (int dd = 0; dd < 2; ++dd)
#pragma unroll
            for (int r = 0; r < 16; ++r) o[dd][r] *= inv;
        group_norm_store(o, h, r32, hi, ogain, mixed + (rowbase + t0 + 32 * g) * 1024 + 512, part + 256 * g);
    }
}
__device__ __forceinline__ void swa_unit(const Frame& F, int b, int tq, const bf16_t* swq, const bf16_t* swkv, const LAS float* qgain, const LAS float* kgain, const LAS float* sinks, const LAS float* ogain,
                                         bf16_t* mixed, LAS unsigned char* lds, const LAS float* bias, LAS float* part) {
    int tid = F.tid; asm volatile("" : "+v"(tid));
    const int lane = tid & 63, r32 = lane & 31, hi = lane >> 5, h = F.wave, kvh = h >> 2;
    const size_t rowbase = (size_t)b * SEQ; const int t0 = tq * 64, kstart = t0 - 128;
    bf16x8 qraw0[4], qraw1[4];
#pragma unroll
    for (int d0 = 0; d0 < 4; ++d0) { qraw0[d0] = *(const bf16x8*)(swq + (rowbase + t0 + r32) * 512 + h * 64 + 16 * d0 + 8 * hi); qraw1[d0] = *(const bf16x8*)(swq + (rowbase + t0 + 32 + r32) * 512 + h * 64 + 16 * d0 + 8 * hi); }
    bf16x8 kraw[6], vraw[6];
#pragma unroll
    for (int i = 0; i < 6; ++i) {
        const int c = tid + 512 * i, row = c >> 3, p8 = c & 7, kv = row / 192, j = row - kv * 192, spos = kstart + j;
        const bf16_t* src = swkv + (rowbase + (spos > 0 ? spos : 0)) * 256 + kv * 64 + 8 * p8; kraw[i] = *(const bf16x8*)src; vraw[i] = *(const bf16x8*)(src + 128);
    }
#pragma unroll
    for (int i = 0; i < 6; ++i) {
        const int c = tid + 512 * i, row = c >> 3, p8 = c & 7, kv = row / 192, j = row - kv * 192, spos = kstart + j;
        float kfv[8]; unpack8(kraw[i], kfv); bf16x8 vr = vraw[i];
        if (spos < 0) {
#pragma unroll
            for (int jj = 0; jj < 8; ++jj) { kfv[jj] = 0.f; vr[jj] = 0; } }
        float ss = 0.f;
#pragma unroll
        for (int jj = 0; jj < 8; ++jj) ss += kfv[jj] * kfv[jj];
        ss += lane_xor<1>(ss); ss += lane_xor<2>(ss); ss += lane_xor<4>(ss);
        const float rs = 1.0f / sqrtf(ss * (1.f / 64.f) + EPS);
        const f32x4 g0 = *(const LAS f32x4*)(kgain + 8 * p8), g1 = *(const LAS f32x4*)(kgain + 8 * p8 + 4);
        float kn[8] = {kfv[0] * rs * g0.x, kfv[1] * rs * g0.y, kfv[2] * rs * g0.z, kfv[3] * rs * g0.w, kfv[4] * rs * g1.x, kfv[5] * rs * g1.y, kfv[6] * rs * g1.z, kfv[7] * rs * g1.w};
        *(LAS bf16x8*)(lds + SW_KS + (kv * 192 + j) * SW_KROW + 16 * p8) = pack8(kn);
#pragma unroll
        for (int jj = 0; jj < 8; ++jj) *(LAS short*)(lds + SW_VT + (kv * 64 + 8 * p8 + jj) * SW_VROW + ((((j >> 3) ^ p8) << 4) + 2 * (j & 7))) = vr[jj];
    }
    __syncthreads();
    const float sink = sinks[h] * 1.4426950408889634f;
    if (kstart >= 0) swa_groups<true>(qraw0, qraw1, h, kvh, r32, hi, kstart, rowbase, t0, qgain, sink, ogain, mixed, lds, bias, part);
    else             swa_groups<false>(qraw0, qraw1, h, kvh, r32, hi, kstart, rowbase, t0, qgain, sink, ogain, mixed, lds, bias, part);
}

__device__ __forceinline__ void xattn_stage(const Frame& F, int b, int hx, const bf16_t* kn, const bf16_t* vt, LAS unsigned char* lds) {
    int tid = F.tid; asm volatile("" : "+v"(tid));
    { const bf16_t* ksrc = kn + (size_t)(b * NMEM) * 512 + hx * 128; const bf16_t* vsrc = vt + (size_t)((b * 4 + hx) * 128) * NMEM;
#pragma unroll
      for (int half = 0; half < 2; ++half) { u32x4 kv[4], vv[4];
#pragma unroll
          for (int i = 0; i < 4; ++i) { const int c = tid + 512 * (half * 4 + i);
              const int krow = c >> 4, kch = c & 15; kv[i] = *(const u32x4*)(ksrc + (size_t)krow * 512 + kch * 8);
              const int vrow = c >> 5, vch = c & 31; vv[i] = *(const u32x4*)(vsrc + (size_t)vrow * NMEM + vch * 8); }
#pragma unroll
          for (int i = 0; i < 4; ++i) { const int c = tid + 512 * (half * 4 + i);
              const int krow = c >> 4, kch = c & 15; *(LAS u32x4*)(lds + krow * 256 + ((kch ^ (krow & 15)) << 4)) = kv[i];
              const int vrow = c >> 5, vch = c & 31; *(LAS u32x4*)(lds + 65536 + vrow * 512 + ((vch ^ (vrow & 31)) << 4)) = vv[i]; } } }
}
__device__ __forceinline__ void xattn_tile(const Frame& F, int b, int hx, int qt, const bf16_t* xq, const LAS float* qgain  , bf16_t* xo, LAS unsigned char* lds) {
    int tid = F.tid; asm volatile("" : "+v"(tid));
    const int lane = tid & 63, r32 = lane & 31, hi = lane >> 5, w = F.wave;
    const size_t row = (size_t)b * SEQ + qt * 256 + 32 * w + r32;
    bf16x8 qf[8];
    { float ss = 0.f; float qv[8][8];
#pragma unroll
      for (int d0 = 0; d0 < 8; ++d0) { unpack8(*(const bf16x8*)(xq + row * 512 + hx * 128 + 16 * d0 + 8 * hi), qv[d0]);
#pragma unroll
          for (int jj = 0; jj < 8; ++jj) ss += qv[d0][jj] * qv[d0][jj]; }
      ss = xor32_add(ss);
      const float rs = (0.08838834764831845f * 1.4426950408889634f) / sqrtf(ss * (1.f / 128.f) + EPS);
#pragma unroll
      for (int d0 = 0; d0 < 8; ++d0) { const f32x4 g0 = *(const LAS f32x4*)(qgain + 16 * d0 + 8 * hi), g1 = *(const LAS f32x4*)(qgain + 16 * d0 + 8 * hi + 4);
          float qn[8] = {qv[d0][0] * rs * g0.x, qv[d0][1] * rs * g0.y, qv[d0][2] * rs * g0.z, qv[d0][3] * rs * g0.w, qv[d0][4] * rs * g1.x, qv[d0][5] * rs * g1.y, qv[d0][6] * rs * g1.z, qv[d0][7] * rs * g1.w};
          qf[d0] = pack8(qn); } }
    f32x16 o[4];
#pragma unroll
    for (int dd = 0; dd < 4; ++dd)
#pragma unroll
        for (int r = 0; r < 16; ++r) o[dd][r] = 0.f;
    float m = -INFINITY, l = 0.f;
    const int pk = pi32(r32);
#pragma nounroll
    for (int kb = 0; kb < 8; ++kb) {
        const int krow = 32 * kb + pk; const LAS unsigned char* kp = lds + krow * 256; const int ksw = krow & 15;
        f32x16 s;
#pragma unroll
        for (int r = 0; r < 16; ++r) s[r] = 0.f;
#pragma unroll
        for (int d0 = 0; d0 < 8; ++d0) s = MFMA32(*(const LAS bf16x8*)(kp + (((2 * d0 + hi) ^ ksw) << 4)), qf[d0], s);
        float rm = s[0];
#pragma unroll
        for (int r = 1; r < 16; ++r) rm = fmaxf(rm, s[r]);
        rm = xor32_max(rm);
        const bool resc = __any(rm > m + 8.0f);
        float f = 1.0f;
        if (resc) { const float mn = fmaxf(m, rm); f = __builtin_amdgcn_exp2f(m - mn); m = mn; l *= f; }
        float p[16]; float ls = 0.f;
#pragma unroll
        for (int r = 0; r < 16; ++r) { p[r] = __builtin_amdgcn_exp2f(s[r] - m); ls += p[r]; }
        l += ls;
        const bf16x8 pa0 = pack8(p), pa1 = pack8(p + 8);
#pragma unroll
        for (int dd = 0; dd < 4; ++dd) {
            if (resc) {
#pragma unroll
                for (int r = 0; r < 16; ++r) o[dd][r] *= f; }
            const int vrow = 32 * dd + r32; const LAS unsigned char* vp = lds + 65536 + vrow * 512; const int vsw = vrow & 31, vc = 4 * kb + 2 * hi;
            o[dd] = MFMA32(*(const LAS bf16x8*)(vp + ((vc ^ vsw) << 4)), pa0, o[dd]); o[dd] = MFMA32(*(const LAS bf16x8*)(vp + (((vc + 1) ^ vsw) << 4)), pa1, o[dd]); }
    }
    l = xor32_add(l);
    const float inv = 1.0f / l;
    bf16_t* orow = xo + row * 512 + hx * 128 + 8 * hi;
#pragma unroll
    for (int dd = 0; dd < 4; ++dd)
#pragma unroll
        for (int k = 0; k < 2; ++k) { u32x2 w[2];
#pragma unroll
            for (int e = 0; e < 2; ++e) { const int gq = 2 * k + e; w[e].x = cvt_pk_bf16(o[dd][4 * gq] * inv, o[dd][4 * gq + 1] * inv); w[e].y = cvt_pk_bf16(o[dd][4 * gq + 2] * inv, o[dd][4 * gq + 3] * inv); }
            *(u32x4*)(orow + 32 * dd + 16 * k) = pair_halves(w[0], w[1]); }
}

using pg8::Unit; using pg8::Out;
__device__ __forceinline__ float* ssq_slot(unsigned char* ws, int s) { return (float*)(ws + WS_SSQ) + (size_t)s * T * 4; }
struct SchedWin {
    int G, c, l; unsigned char* ws;
    __device__ __forceinline__ bool next(int i, Unit& u) const {
        const int L = i * G + c; if (L >= 256 * 9) return false; int pm, pn; pg8::tile_of(L, 256, 9, pm, pn); u.pm = pm; u.pn = pn;
        const char* arow = (const char*)(ws + WS_XQW) + (size_t)pm * 256 * 1024; const char* brow = (const char*)(ws + WS_WIN) + ((size_t)l * 2304 + pn * 256) * 1024;
        const float* asc = (const float*)(ws + WS_WSC + SC_ROWW) + (size_t)pm * 256; const float* bsc = (const float*)(ws + WS_WSC + SC_WIN) + (size_t)l * 2304 + pn * 256;
        if ((pn >> 1) == 2) { u.a = brow; u.b = arow; u.sc = bsc; u.sc2 = asc; } else { u.a = arow; u.b = brow; u.sc = asc; u.sc2 = bsc; }
        return true;
    }
    __device__ __forceinline__ void out(const Unit& u, Out& e) const {
        const int pm = u.pm, pn = u.pn; char* proj = (char*)(ws + WS_PROJ); e.r = nullptr; e.xb = nullptr; e.ssq = nullptr; e.scmode = 1;
        if (pn == 4 || pn == 5) { const int b = pm >> 3, t0 = (pm & 7) * 256; e.o = proj + PJ_SBVT + ((size_t)((b * 8 + 4 * (pn - 4)) * 64) * SEQ + t0) * 2; e.ldo = SEQ; }
        else if (pn < 2) { e.o = proj + PJ_SBQ + ((size_t)pm * 256 * 512 + pn * 256) * 2; e.ldo = 512; }
        else if (pn < 4) { e.o = proj + PJ_SBK + ((size_t)pm * 256 * 512 + (pn - 2) * 256) * 2; e.ldo = 512; }
        else if (pn < 8) { e.o = proj + PJ_SWQ + ((size_t)pm * 256 * 512 + (pn - 6) * 256) * 2; e.ldo = 512; }
        else             { e.o = proj + PJ_SWKV + ((size_t)pm * 256 * 256) * 2; e.ldo = 256; }
    }
};
struct SchedRes {
    int G, c, l, which; unsigned char* ws;
    __device__ __forceinline__ bool next(int i, Unit& u) const {
        const int L = i * G + c; if (L >= 1024) return false; int pm, pn; pg8::tile_of(L, 256, 4, pm, pn); u.pm = pm; u.pn = pn; u.sc = nullptr; u.sc2 = nullptr;
        if (which == 0) { u.a = (const char*)(ws + WS_YS) + (size_t)pm * 256 * 1024 * 2; u.b = (const char*)(ws + WS_WOUT) + ((size_t)l * 1024 + pn * 256) * 1024 * 2; }
        else            { u.a = (const char*)(ws + WS_PROJ + PJ_XO) + (size_t)pm * 256 * 512 * 2; u.b = (const char*)(ws + WS_WO) + ((size_t)l * 1024 + pn * 256) * 512 * 2; }
        return true;
    }
    __device__ __forceinline__ void out(const Unit& u, Out& e) const {
        const size_t eoff = (size_t)u.pm * 256 * 1024 + u.pn * 256; e.o = nullptr; e.r = nullptr; e.ldo = 1024; e.scmode = 0;
        e.xb = (bf16_t*)(ws + WS_XB) + eoff; e.ssq = ssq_slot(ws, 3 * l + 1 + which) + (size_t)u.pm * 256 * 4 + u.pn;
    }
};
struct SchedWq {
    int G, c, l; unsigned char* ws;
    __device__ __forceinline__ bool next(int i, Unit& u) const {
        const int L = i * G + c; if (L >= 512) return false; int pm, pn; pg8::tile_of(L, 256, 2, pm, pn); u.pm = pm; u.pn = pn;
        u.a = (const char*)(ws + WS_XB) + (size_t)pm * 256 * 1024 * 2; u.b = (const char*)(ws + WS_WQ) + ((size_t)l * 512 + pn * 256) * 1024 * 2; u.sc = ssq_slot(ws, 3 * l + 1) + (size_t)pm * 256 * 4; u.sc2 = nullptr; return true;
    }
    __device__ __forceinline__ void out(const Unit& u, Out& e) const { e.o = (char*)(ws + WS_PROJ + PJ_XQ) + ((size_t)u.pm * 256 * 512 + u.pn * 256) * 2; e.r = nullptr; e.ldo = 512; e.xb = nullptr; e.ssq = nullptr; e.scmode = 1; }
};
struct SchedKV {
    int G, c; unsigned char* ws;
    __device__ __forceinline__ bool next(int i, Unit& u) const {
        const int L = i * G + c; if (L >= 512) return false; const int l = L >> 7, rem = L & 127; u.pm = L; u.pn = 0; u.sc = nullptr; u.sc2 = nullptr;
        const char* hml = (const char*)(ws + WS_PROJ + PJ_HM) + (size_t)l * 8192 * 1024 * 2; const char* wl = (const char*)(ws + WS_WKV) + (size_t)l * 1024 * 1024 * 2;
        if (rem < 64) { const int pm = rem >> 1, pn = rem & 1; u.a = hml + (size_t)pm * 256 * 1024 * 2; u.b = wl + (size_t)pn * 256 * 1024 * 2; }
        else { const int r2 = rem - 64, bb = r2 >> 1, dt = r2 & 1; u.a = wl + (size_t)(512 + dt * 256) * 1024 * 2; u.b = hml + (size_t)bb * 256 * 1024 * 2; }
        return true;
    }
    __device__ __forceinline__ void out(const Unit& u, Out& e) const {
        const int L = u.pm, l = L >> 7, rem = L & 127; e.r = nullptr; e.xb = nullptr; e.ssq = nullptr; e.scmode = 0;
        if (rem < 64) { const int pm = rem >> 1, pn = rem & 1; e.o = (char*)(ws + WS_YS) + (size_t)l * 8192 * 512 * 2 + ((size_t)pm * 256 * 512 + pn * 256) * 2; e.ldo = 512; }
        else { const int r2 = rem - 64, bb = r2 >> 1, dt = r2 & 1; e.o = (char*)(ws + WS_VT) + (size_t)l * 8192 * 512 * 2 + ((size_t)(bb * 4 + 2 * dt) * 128 * 256) * 2; e.ldo = 256; }
    }
};
struct SchedGU {
    int G, c, nM, ch, l; unsigned char* ws; const LAS int* pblk;
    __device__ __forceinline__ bool next(int i, Unit& u) const {
        const int L = i * G + c; if (L >= nM * 28) return false; int pm, pn; pg8::tile_of(L, nM, 28, pm, pn); u.pm = pm; u.pn = pn;
        if (pblk) { const int blk = ch * CHUNK_BLK + pm; int e = 0;
#pragma unroll
            for (int k = 1; k < 8; ++k) e += (pblk[k] <= blk) ? 1 : 0;
            e = __builtin_amdgcn_readfirstlane(e);
            u.a = (const char*)(ws + WS_PROJ + PJ_GB) + (size_t)(ch & 1) * GB_BUF + (size_t)pm * 256 * 1024; u.b = (const char*)(ws + WS_EGU) + ((size_t)e * 7168 + pn * 256) * 1024;
            u.sc = (const float*)(ws + WS_WSC + SC_SROW) + ((size_t)ch * CHUNK_BLK + pm) * 256; u.sc2 = (const float*)(ws + WS_WSC + SC_WE) + (size_t)e * 7168 + pn * 256; }
        else { const size_t row0 = ((size_t)ch * CHUNK_BLK + pm) * 256;
            u.a = (const char*)(ws + WS_PROJ + PJ_XQ8) + row0 * 1024; u.b = (const char*)(ws + WS_WGU) + ((size_t)(l >> 1) * 7168 + pn * 256) * 1024;
            u.sc = (const float*)(ws + WS_WSC + SC_ROW) + row0; u.sc2 = (const float*)(ws + WS_WSC + SC_WD) + (size_t)(l >> 1) * 7168 + pn * 256; }
        return true;
    }
    __device__ __forceinline__ void out(const Unit& u, Out& e) const { e.o = (char*)(ws + WS_PROJ + PJ_H) + (size_t)(ch & 1) * H_BUF + ((size_t)u.pm * 256 * FF + u.pn * 128); e.r = nullptr; e.ldo = FF; e.xb = nullptr; e.ssq = nullptr; e.scmode = 1; }
};
struct SchedDown {
    int G, c, nM, ch, l; unsigned char* ws; const LAS int* pblk;
    __device__ __forceinline__ bool next(int i, Unit& u) const {
        const int L = i * G + c; if (L >= nM * 4) return false; int pm, pn; pg8::tile_of(L, nM, 4, pm, pn); u.pm = pm; u.pn = pn; u.sc = nullptr; u.sc2 = nullptr;
        int e = 0; if (pblk) { const int blk = ch * CHUNK_BLK + pm;
#pragma unroll
            for (int k = 1; k < 8; ++k) e += (pblk[k] <= blk) ? 1 : 0;
            e = __builtin_amdgcn_readfirstlane(e); }
        u.a = (const char*)(ws + WS_PROJ + PJ_H) + (size_t)(ch & 1) * H_BUF + (size_t)pm * 256 * FF;
        u.b = (pblk ? (const char*)(ws + WS_EDN) + (size_t)e * 1024 * FF : (const char*)(ws + WS_WDN) + (size_t)(l >> 1) * 1024 * FF) + (size_t)pn * 256 * FF; return true;
    }
    __device__ __forceinline__ void out(const Unit& u, Out& e) const {
        const size_t eoff = ((size_t)ch * CHUNK_BLK + u.pm) * 256 * 1024 + u.pn * 256; e.ldo = 1024; e.scmode = 0;
        if (pblk) { e.o = (char*)((bf16_t*)(ws + WS_YS) + eoff); e.r = nullptr; e.xb = nullptr; e.ssq = nullptr; }
        else { e.o = nullptr; e.r = nullptr; e.xb = (bf16_t*)(ws + WS_XB) + eoff; e.ssq = ssq_slot(ws, 3 * l + 3) + ((size_t)ch * CHUNK_BLK + u.pm) * 256 * 4 + u.pn; }
    }
};

__constant__ unsigned char T5B[128] = {0,1,2,3,4,5,6,7,8,9,10,11,12,13,14,15,16,16,16,17,17,18,18,18,19,19,19,20,20,20,20,21,21,21,21,22,22,22,22,22,23,23,23,23,23,23,24,24,24,24,24,24,25,25,25,25,25,25,25,26,26,26,26,26,26,26,26,27,27,27,27,27,27,27,27,27,27,28,28,28,28,28,28,28,28,28,28,29,29,29,29,29,29,29,29,29,29,29,29,30,30,30,30,30,30,30,30,30,30,30,30,30,30,31,31,31,31,31,31,31,31,31,31,31,31,31,31,31};

__device__ __forceinline__ void moe_meta(const Frame& F, unsigned* gcnt, LAS int* meta) {
    __syncthreads();
    if (F.tid < 8) meta[F.tid] = (int)__hip_atomic_load(gcnt + 64 * F.tid, __ATOMIC_RELAXED, __HIP_MEMORY_SCOPE_AGENT);
    __syncthreads();
    if (F.tid == 0) { int pre = 0;
        for (int e = 0; e < 8; ++e) { meta[8 + e] = pre; pre += (meta[e] + 255) >> 8; }
        meta[16] = pre; }
    __syncthreads();
}
__device__ __forceinline__ int expert_of_blk(const LAS int* pblk, int blk) { int e = 0;
#pragma unroll
    for (int k = 1; k < 8; ++k) e += (pblk[k] <= blk) ? 1 : 0;
    return e; }

__device__ __forceinline__ float lane_max16(float v) { v = fmaxf(v, lane_xor<1>(v)); v = fmaxf(v, lane_xor<2>(v)); v = fmaxf(v, lane_xor<4>(v)); return fmaxf(v, lane_xor<8>(v)); }
__device__ __forceinline__ float wave_max(float v) { v = lane_max16(v); v = fmaxf(v, lane_xor<16>(v)); return xor32_max(v); }
__device__ __forceinline__ unsigned q4(float a, float b, float c, float d, float inv) {
    const int qa = (int)rintf(a * inv), qb = (int)rintf(b * inv), qc = (int)rintf(c * inv), qd = (int)rintf(d * inv);
    return (unsigned)(qa & 255) | ((unsigned)(qb & 255) << 8) | ((unsigned)(qc & 255) << 16) | ((unsigned)(qd & 255) << 24);
}
struct StripDesc { const float* src; const float* gain; signed char* W8; float* wscale; int N, dr0; };
__device__ __forceinline__ void strip_issue(const Frame& F, const StripDesc& d, f32x4 (&wv)[16], float (&gk)[16]) {
    const int kk = F.tid >> 3, n4 = (F.tid & 7) * 4;
#pragma unroll
    for (int p = 0; p < 16; ++p) wv[p] = *(const f32x4*)(d.src + (size_t)(p * 64 + kk) * d.N + n4);
#pragma unroll
    for (int p = 0; p < 16; ++p) gk[p] = d.gain[p * 64 + kk];
}
__device__ __forceinline__ void strip_to_lds(const Frame& F, const f32x4 (&wv)[16], const float (&gk)[16]) {
    constexpr int SP = 1028; LAS float* st = (LAS float*)F.lds; const int kk = F.tid >> 3, n4 = (F.tid & 7) * 4;
#pragma unroll
    for (int p = 0; p < 16; ++p) { const int k = p * 64 + kk; const float g = gk[p];
        st[(n4 + 0) * SP + k] = wv[p].x * g; st[(n4 + 1) * SP + k] = wv[p].y * g; st[(n4 + 2) * SP + k] = wv[p].z * g; st[(n4 + 3) * SP + k] = wv[p].w * g; }
}
__device__ __forceinline__ void strip_quant(const Frame& F, const StripDesc& d) {
    constexpr int SP = 1028; LAS float* st = (LAS float*)F.lds;
    const int n = F.tid >> 4, cch = F.tid & 15; const LAS f32x4* row = (const LAS f32x4*)(st + n * SP + cch * 64);
    f32x4 v[16]; float mx = 0.f;
#pragma unroll
    for (int j = 0; j < 16; ++j) { v[j] = row[j]; mx = fmaxf(mx, fmaxf(fmaxf(fabsf(v[j].x), fabsf(v[j].y)), fmaxf(fabsf(v[j].z), fabsf(v[j].w)))); }
    mx = lane_max16(mx);
    const float sc = mx > 0.f ? mx * (1.f / 127.f) : 1.f, inv = 1.0f / sc; const int dr = d.dr0 + n;
    u32x4* dst = (u32x4*)(d.W8 + (size_t)dr * 1024 + cch * 64);
#pragma unroll
    for (int j = 0; j < 4; ++j) { u32x4 w; w.x = q4(v[4 * j].x, v[4 * j].y, v[4 * j].z, v[4 * j].w, inv); w.y = q4(v[4 * j + 1].x, v[4 * j + 1].y, v[4 * j + 1].z, v[4 * j + 1].w, inv);
        w.z = q4(v[4 * j + 2].x, v[4 * j + 2].y, v[4 * j + 2].z, v[4 * j + 2].w, inv); w.w = q4(v[4 * j + 3].x, v[4 * j + 3].y, v[4 * j + 3].z, v[4 * j + 3].w, inv); dst[j] = w; }
    if (cch == 0) d.wscale[dr] = sc;
}
template <class DescFn>
__device__ __forceinline__ void convert_strip_list(const Frame& F, int nstrips, DescFn desc) {
    int fs = F.bx; if (fs >= nstrips) return;
    StripDesc d = desc(fs); f32x4 wv[16]; float gk[16]; strip_issue(F, d, wv, gk);
#pragma nounroll
    for (;;) {
        strip_to_lds(F, wv, gk);
        __syncthreads();
        const int nx = fs + F.G; const bool more = nx < nstrips; StripDesc dn = d;
        if (more) { dn = desc(nx); strip_issue(F, dn, wv, gk); }
        strip_quant(F, d);
        __syncthreads();
        if (!more) break;
        d = dn; fs = nx;
    }
}
__device__ __forceinline__ float quant_regs_i8(const u32x2 (&xw)[4], signed char* qrow, int lane) {
    f32x4 v[4]; float mx = 0.f;
#pragma unroll
    for (int j = 0; j < 4; ++j) { const u32x2 w = xw[j]; v[j] = (f32x4){bf_lo(w.x), bf_hi(w.x), bf_lo(w.y), bf_hi(w.y)}; mx = fmaxf(mx, fmaxf(fmaxf(fabsf(v[j].x), fabsf(v[j].y)), fmaxf(fabsf(v[j].z), fabsf(v[j].w)))); }
    mx = wave_max(mx);
    const float sc = mx > 0.f ? mx * (1.f / 127.f) : 1.f, inv = 1.0f / sc;
    unsigned* q = (unsigned*)qrow + lane;
#pragma unroll
    for (int j = 0; j < 4; ++j) q[64 * j] = q4(v[j].x, v[j].y, v[j].z, v[j].w, inv);
    return sc;
}
__device__ __forceinline__ void load_row4(u32x2 (&xw)[4], const bf16_t* xrow, int lane) { const u32x2* xr = (const u32x2*)xrow + lane;
#pragma unroll
    for (int j = 0; j < 4; ++j) xw[j] = xr[64 * j]; }
__device__ __forceinline__ void quant_pass(const Frame& F, const bf16_t* xb, const float* sq, signed char* xq, float* rowsc) {
    const int gw = F.bx * NWAVES + F.wave, NGW = F.G * NWAVES;
    if (gw >= T) return;
#define QP_LOAD(XW, SP, m0_) do { _Pragma("unroll") for (int i = 0; i < 4; ++i) { const int m_ = (m0_) + i * NGW, mm_ = m_ < T ? m_ : gw; load_row4(XW[i], xb + (size_t)mm_ * D, F.lane); SP[i] = *(const f32x4*)(sq + (size_t)mm_ * 4); } } while (0)
#define QP_DO(XW, SP, m0_) do { _Pragma("unroll") for (int i = 0; i < 4; ++i) { const int m_ = (m0_) + i * NGW; if (m_ < T) { const float sc_ = quant_regs_i8(XW[i], xq + (size_t)m_ * D, F.lane); \
            if (F.lane == 0) rowsc[m_] = sc_ / sqrtf(((SP[i].x + SP[i].y) + (SP[i].z + SP[i].w)) * (1.f / 1024.f) + EPS); } } } while (0)
    u32x2 xa[4][4], xb2[4][4]; f32x4 spa[4], spb[4];
    int m0 = gw; const int step = 4 * NGW;
    QP_LOAD(xa, spa, m0);
    for (;;) {
        QP_LOAD(xb2, spb, m0 + step);
        QP_DO(xa, spa, m0);
        m0 += step; if (m0 >= T) break;
        QP_LOAD(xa, spa, m0 + step);
        QP_DO(xb2, spb, m0);
        m0 += step; if (m0 >= T) break;
    }
#undef QP_LOAD
#undef QP_DO
}
__device__ __forceinline__ void moe_gather(const Frame& F0, int c, int nbtot, const LAS int* meta, const int* mlist, const bf16_t* xb, const float* ssq, float* srow, char* proj) {
    const LAS int* pblk = meta + 8; const int gw = F0.bx * NWAVES + F0.wave, NGW = F0.G * NWAVES;
    const int r0 = c * CHUNK_BLK * 256, r1 = min((c + 1) * CHUNK_BLK * 256, nbtot * 256); signed char* dst0 = (signed char*)(proj + PJ_GB + (size_t)(c & 1) * GB_BUF);
#define MG_TOK(TJ, rb_) do { TJ = -1; int ln_ = F0.lane; asm volatile("" : "+v"(ln_)); const int r = (rb_) + (ln_ & 7) * NGW; if (ln_ < 8 && r < r1) { const int blk = r >> 8, e = expert_of_blk(pblk, blk), pos = r - pblk[e] * 256; if (pos < meta[e]) TJ = mlist[(size_t)e * T + pos]; } } while (0)
#define MG_LOAD(XW, SP, TK, TJ, sub_) do { int ln_ = F0.lane; asm volatile("" : "+v"(ln_)); _Pragma("unroll") for (int i = 0; i < 4; ++i) { TK[i] = __builtin_amdgcn_readlane(TJ, (sub_) * 4 + i); const int tc_ = TK[i] >= 0 ? TK[i] : 0; \
        load_row4(XW[i], xb + (size_t)tc_ * D, ln_); SP[i] = *(const f32x4*)(ssq + (size_t)tc_ * 4); } } while (0)
#define MG_DO(XW, SP, TK, rb_, sub_) do { int ln_ = F0.lane; asm volatile("" : "+v"(ln_)); _Pragma("unroll") for (int i = 0; i < 4; ++i) { const int j = (sub_) * 4 + i, r = (rb_) + j * NGW; if (r < r1) { signed char* d = dst0 + (size_t)(r - r0) * D; \
        if (TK[i] >= 0) { const float sc = quant_regs_i8(XW[i], d, ln_); if (ln_ == 0) srow[r] = sc / sqrtf(((SP[i].x + SP[i].y) + (SP[i].z + SP[i].w)) * (1.f / 1024.f) + EPS); } \
        else { unsigned* q = (unsigned*)d + ln_; _Pragma("unroll") for (int jj = 0; jj < 4; ++jj) q[64 * jj] = 0u; if (ln_ == 0) srow[r] = 0.f; } } } } while (0)
    if (r0 + gw < r1) {
        u32x2 xa[4][4], xc[4][4]; f32x4 spa[4], spc[4]; int tka[4], tkc[4]; int tj, tjn; int rb = r0 + gw; const int step = 8 * NGW;
        MG_TOK(tj, rb);
        MG_LOAD(xa, spa, tka, tj, 0);
#pragma nounroll
        for (;;) {
            MG_TOK(tjn, rb + step);
            MG_LOAD(xc, spc, tkc, tj, 1); MG_DO(xa, spa, tka, rb, 0);
            MG_LOAD(xa, spa, tka, tjn, 0); MG_DO(xc, spc, tkc, rb, 1);
            rb += step; if (rb >= r1) break;
            tj = tjn;
        }
    }
#undef MG_TOK
#undef MG_LOAD
#undef MG_DO
}

template <class RowMap>
__device__ __forceinline__ void convert_job_f8(const Frame& F, const float* W, int K, int N, unsigned char* WT, const RowMap& rm) {
    LAS float* scr = (LAS float*)(F.lds + F.wave * 8448);
    const int gw = F.bx * NWAVES + F.wave, NGW = F.G * NWAVES, nitems = (K / 64) * (N / 32);
    int ln = F.lane; asm volatile("" : "+v"(ln));
#pragma nounroll
    for (int it = gw; it < nitems; it += NGW) transpose_item_f8(W, K, N, WT, rm, scr, it, ln);
}
template <class RowMap>
__device__ __forceinline__ void convert_job(const Frame& F, const float* W, int K, int N, bf16_t* WT, const RowMap& rm) {
    LAS float* scr = (LAS float*)(F.lds + F.wave * 8448);
    const int gw = F.bx * NWAVES + F.wave, NGW = F.G * NWAVES, nitems = (K / 64) * (N / 32);
    int ln = F.lane; asm volatile("" : "+v"(ln));
#pragma nounroll
    for (int it = gw; it < nitems; it += NGW) transpose_item(W, K, N, WT, rm, scr, it, ln);
}

constexpr int PH_PRO0 = 0, PH_PRO1 = 1, PH_L0 = 2, NPL = 9, N_PHASES = PH_L0 + DEPTH * NPL;
#ifndef PROBE_DUP
#define PROBE_DUP 0
#endif
typedef const Params __attribute__((address_space(4))) CParams;
__device__ __forceinline__ CParams* get_params() { CParams* p = (CParams*)__builtin_amdgcn_kernarg_segment_ptr(); asm volatile("" : "+s"(p)); return p; }
#define PIN(i) ((const float*)pp->in[i])

__global__ void __launch_bounds__(NTHR, 2) fwd_kernel(Params P_unused) {
    extern __shared__ __attribute__((aligned(16))) unsigned char lds_raw[];
    Frame F; F.lds = (LAS unsigned char*)lds_raw; F.tid = threadIdx.x; F.lane = F.tid & 63; F.wave = __builtin_amdgcn_readfirstlane(F.tid >> 6); F.G = gridDim.x; F.bx = blockIdx.x;
#define PHASE_FRAME Frame F; { int t_ = threadIdx.x; asm volatile("" : "+v"(t_)); F.lds = (LAS unsigned char*)lds_raw; F.tid = t_; F.lane = t_ & 63; F.wave = __builtin_amdgcn_readfirstlane(t_ >> 6); F.G = gridDim.x; int b_ = blockIdx.x; asm volatile("" : "+s"(b_)); F.bx = b_; }
    volatile LAS unsigned* MISC = (volatile LAS unsigned*)(F.lds + MISC_OFF);
    LAS int* meta = (LAS int*)(F.lds + MISC_OFF + 64);
    LAS int* lcnt = (LAS int*)(F.lds + MISC_OFF + 256);
    for (int u = F.tid; u < 1024; u += NTHR) ((LAS unsigned*)(F.lds + MISC_OFF))[u] = 0u;
    __syncthreads();
    XcdBarrier bar;
    { CParams* pp = get_params(); bar = xcd_barrier_post((unsigned*)(pp->ws + WS_CTL) + CW_BAR, MISC); }
#define IN(k) true
#define SEAM(k) do { if ((k) + 1 < N_PHASES) xcd_barrier(bar); } while (0)
#define GWS const int gw = F.bx * NWAVES + F.wave, NGW = F.G * NWAVES

    if (IN(PH_PRO0)) {
        PHASE_FRAME; CParams* pp = get_params(); unsigned char* ws = pp->ws; GWS;
#pragma nounroll
        for (int rep = 0; rep < ((PROBE_DUP >> 8) & 1) + 1; ++rep) {
        convert_strip_list(F, 4 * 72 + 4 * 112, [&](int fs) -> StripDesc {
            if (fs < 288) { const int l = fs / 72, st = fs - l * 72;
                return StripDesc{PIN(I_W_IN) + (size_t)l * D * 2304 + st * 32, PIN(I_NORM_MIX) + l * D, (signed char*)(ws + WS_WIN) + (size_t)l * 2304 * D, (float*)(ws + WS_WSC + SC_WIN) + l * 2304, 2304, st * 32}; }
            const int r = fs - 288, up = r / 224, r2 = r - up * 224, i = r2 / 112, st = r2 - i * 112, n0 = st * 32;
            return StripDesc{(up ? PIN(I_DUP) : PIN(I_DGATE)) + (size_t)i * D * FF + n0, PIN(I_NORM_FFN) + (2 * i) * D, (signed char*)(ws + WS_WGU) + (size_t)i * 7168 * D, (float*)(ws + WS_WSC + SC_WD) + i * 7168, FF,
                             (n0 >> 7) * 256 + 128 * up + (n0 & 127)}; });
        __syncthreads();
#pragma nounroll
        for (int l = 0; l < DEPTH; ++l) {
            convert_job(F, PIN(I_W_OUT) + (size_t)l * D * D, D, D, (bf16_t*)(ws + WS_WOUT) + (size_t)l * D * D, RowIdent{});
            convert_job(F, PIN(I_XWQ) + (size_t)l * D * 512, D, 512, (bf16_t*)(ws + WS_WQ) + (size_t)l * 512 * D, RowIdent{PIN(I_NORM_XATTN) + l * D});
            convert_job(F, PIN(I_XWKV) + (size_t)l * D * 1024, D, 1024, (bf16_t*)(ws + WS_WKV) + (size_t)l * 1024 * D, RowIdent{});
            convert_job(F, PIN(I_XWO) + (size_t)l * 512 * D, 512, D, (bf16_t*)(ws + WS_WO) + (size_t)l * D * 512, RowIdent{});
        }
#pragma nounroll
        for (int i = 0; i < 2; ++i) convert_job_f8(F, PIN(I_DDOWN) + (size_t)i * FF * D, FF, D, (unsigned char*)(ws + WS_WDN) + (size_t)i * D * FF, RowIdent{});
#pragma nounroll
        for (int l = 0; l < DEPTH; ++l) {
            f32x4 g[4], v[4];
#pragma unroll
            for (int j = 0; j < 4; ++j) g[j] = ((const f32x4*)(PIN(I_NORM_MEM) + l * D))[64 * j + F.lane];
            for (int m = gw; m < NB * NMEM; m += NGW) norm_row(PIN(I_MEM) + (size_t)m * D, (bf16_t*)(ws + WS_PROJ + PJ_HM) + ((size_t)l * 8192 + m) * D, g, v, F.lane);
        }
        { const float* x = PIN(I_X); bf16_t* xb = (bf16_t*)(ws + WS_XB); float* sq = ssq_slot(ws, 0); signed char* xq = (signed char*)(ws + WS_XQW); float* roww = (float*)(ws + WS_WSC + SC_ROWW);
#define XP_LOAD(XV, m0_) do { _Pragma("unroll") for (int i = 0; i < 2; ++i) { int m_ = (m0_) + i * NGW; m_ = m_ < T ? m_ : gw; const f32x4* xr = (const f32x4*)(x + (size_t)m_ * D) + F.lane; \
              _Pragma("unroll") for (int j = 0; j < 4; ++j) XV[i][j] = xr[64 * j]; } } while (0)
#define XP_DO(XV, m0_) do { _Pragma("unroll") for (int i = 0; i < 2; ++i) { const int m = (m0_) + i * NGW; if (m < T) { u32x2* o8 = (u32x2*)(xb + (size_t)m * D) + F.lane; float q = 0.f, mx = 0.f; \
              _Pragma("unroll") for (int j = 0; j < 4; ++j) { const f32x4 v = XV[i][j]; q += (v.x * v.x + v.y * v.y) + (v.z * v.z + v.w * v.w); mx = fmaxf(mx, fmaxf(fmaxf(fabsf(v.x), fabsf(v.y)), fmaxf(fabsf(v.z), fabsf(v.w)))); \
                  u32x2 w; w.x = cvt_pk_bf16(v.x, v.y); w.y = cvt_pk_bf16(v.z, v.w); o8[64 * j] = w; } \
              q = wave_sum(q); mx = wave_max(mx); const float sc = mx > 0.f ? mx * (1.f / 127.f) : 1.f, inv = 1.0f / sc; unsigned* q8 = (unsigned*)(xq + (size_t)m * D) + F.lane; \
              _Pragma("unroll") for (int j = 0; j < 4; ++j) q8[64 * j] = q4(XV[i][j].x, XV[i][j].y, XV[i][j].z, XV[i][j].w, inv); \
              if (F.lane == 0) { *(f32x4*)(sq + (size_t)m * 4) = (f32x4){q, 0.f, 0.f, 0.f}; roww[m] = sc / sqrtf(q * (1.f / 1024.f) + EPS); } } } } while (0)
          if (gw < T) { f32x4 xa[2][4], xc[2][4]; int m0 = gw; const int step = 2 * NGW;
              XP_LOAD(xa, m0);
#pragma nounroll
              for (;;) {
                  XP_LOAD(xc, m0 + step); XP_DO(xa, m0); m0 += step; if (m0 >= T) break;
                  XP_LOAD(xa, m0 + step); XP_DO(xc, m0); m0 += step; if (m0 >= T) break;
              } }
#undef XP_LOAD
#undef XP_DO
        }
        }
        SEAM(PH_PRO0);
    }
    if (IN(PH_PRO1)) {
        PHASE_FRAME; CParams* pp = get_params(); unsigned char* ws = pp->ws;
        SchedKV S{F.G, F.bx, ws};
        pg8::gemm_phase(F.lds, 2048, S, pg8::EpiStoreBf16{});
        SEAM(PH_PRO1);
    }

#pragma nounroll
    for (int l = 0; l < DEPTH; ++l) {
        const int pb = PH_L0 + l * NPL;
        const bool moe = (l & 1) != 0; const int fi = l >> 1;
        if (IN(pb + 0)) {
            if (l == 0) {
                PHASE_FRAME; CParams* pp = get_params(); unsigned char* ws = pp->ws; GWS;
                for (int rr = gw; rr < DEPTH * 8192; rr += NGW) { const int ll = rr >> 13;
                    float kv[8]; unpack8(*(const bf16x8*)((const bf16_t*)(ws + WS_YS) + (size_t)rr * 512 + 8 * F.lane), kv);
                    float ss = 0.f;
#pragma unroll
                    for (int j = 0; j < 8; ++j) ss += kv[j] * kv[j];
                    ss += lane_xor<1>(ss); ss += lane_xor<2>(ss); ss += lane_xor<4>(ss); ss += lane_xor<8>(ss);
                    const float rs = 1.0f / sqrtf(ss * (1.f / 128.f) + EPS);
                    const float* kg = PIN(I_XK_GAIN) + ll * 128 + 8 * (F.lane & 15);
#pragma unroll
                    for (int j = 0; j < 8; ++j) kv[j] = kv[j] * rs * kg[j];
                    *(bf16x8*)((bf16_t*)(ws + WS_KN) + (size_t)rr * 512 + 8 * F.lane) = pack8(kv); }
            }
            if (l & 1) {
                PHASE_FRAME; CParams* pp = get_params(); unsigned char* ws = pp->ws; GWS; const bf16_t* xb = (const bf16_t*)(ws + WS_XB); const float* sq = ssq_slot(ws, 3 * l);
                signed char* xq = (signed char*)(ws + WS_XQW); float* roww = (float*)(ws + WS_WSC + SC_ROWW);
                quant_pass(F, xb, sq, xq, roww);
                xcd_barrier(bar);
            }
            PHASE_FRAME; CParams* pp = get_params(); unsigned char* ws = pp->ws;
            SchedWin S{F.G, F.bx, l, ws};
            pg8::gemm_phase(F.lds, 1024, S, pg8::EpiStoreI8{});
            SEAM(pb + 0);
        }
        if (IN(pb + 1)) {
            PHASE_FRAME; CParams* pp = get_params(); unsigned char* ws = pp->ws; char* proj = (char*)(ws + WS_PROJ); bf16_t* mixed = (bf16_t*)(ws + WS_YS);
            if (F.wave >= 4) __builtin_amdgcn_s_setprio(1);
            LAS float* bias = (LAS float*)(F.lds + SW_END); LAS float* part = (LAS float*)(F.lds + SW_END + 4096);
            LAS float* cst = (LAS float*)(F.lds + SW_END + 4096 + 2048);
            for (int i = F.tid; i < 1024; i += NTHR) { const int h = i >> 7, d = i & 127; bias[i] = PIN(I_REL_BIAS)[T5B[d] * 8 + h] * 1.4426950408889634f; }
            for (int i = F.tid; i < 1160; i += NTHR) cst[i] = (i < 512) ? PIN(I_SB_OUT_GAIN)[l * 512 + i] : (i < 1024) ? PIN(I_SWA_OUT_GAIN)[l * 512 + i - 512] : (i < 1088) ? PIN(I_SWA_Q_GAIN)[l * 64 + i - 1024] : (i < 1152) ? PIN(I_SWA_K_GAIN)[l * 64 + i - 1088] : PIN(I_SWA_SINKS)[l * 8 + i - 1152];
            __syncthreads();
#pragma nounroll
            for (int rep = 0; rep < ((PROBE_DUP >> 1) & 3 ? 2 : 1); ++rep)
#pragma nounroll
            for (int u = F.bx + ((rep == 1 && ((PROBE_DUP >> 2) & 1)) ? 1024 : 0); u < ((rep == 1 && ((PROBE_DUP >> 1) & 3) == 1) ? 1024 : 2048); u += F.G) {
                const int uu = u & 1023, b = uu >> 5, tq = uu & 31;
                if (u < 1024) sb_unit(F, b, tq, (const bf16_t*)(proj + PJ_SBQ), (const bf16_t*)(proj + PJ_SBK), (const bf16_t*)(proj + PJ_SBVT), cst, mixed, part, F.lds);
                else swa_unit(F, b, tq, (const bf16_t*)(proj + PJ_SWQ), (const bf16_t*)(proj + PJ_SWKV), cst + 1024, cst + 1088, cst + 1152, cst + 512, mixed, F.lds, bias, part);
            }
            __builtin_amdgcn_s_setprio(0);
            SEAM(pb + 1);
        }
        if (IN(pb + 2)) {
            PHASE_FRAME; CParams* pp = get_params(); unsigned char* ws = pp->ws;
            SchedRes S{F.G, F.bx, l, 0, ws};
            pg8::gemm_phase(F.lds, 2048, S, pg8::EpiResid{});
            SEAM(pb + 2);
        }
        if (IN(pb + 3)) {
            PHASE_FRAME; CParams* pp = get_params(); unsigned char* ws = pp->ws;
            SchedWq S{F.G, F.bx, l, ws};
            pg8::gemm_phase(F.lds, 2048, S, pg8::EpiStoreBf16{});
            SEAM(pb + 3);
        }
        if (IN(pb + 4)) {
            PHASE_FRAME; CParams* pp = get_params(); unsigned char* ws = pp->ws;
            if (F.wave >= 4) __builtin_amdgcn_s_setprio(1);
            LAS float* qg = (LAS float*)(F.lds + pg8::XL_OFF);
            if (F.tid < 128) qg[F.tid] = PIN(I_XQ_GAIN)[l * 128 + F.tid];
            __syncthreads();
#pragma nounroll
            for (int rep = 0; rep < ((PROBE_DUP >> 4) & 1) + 1; ++rep)
#pragma nounroll
            for (int hu = F.bx; hu < 256; hu += F.G) {
                const int p = hu >> 1;
                __syncthreads();
                xattn_stage(F, p >> 2, p & 3, (const bf16_t*)(ws + WS_KN) + (size_t)l * 8192 * 512, (const bf16_t*)(ws + WS_VT) + (size_t)l * 8192 * 512, F.lds);
                __syncthreads();
#pragma nounroll
                for (int i = 0; i < 4; ++i) xattn_tile(F, p >> 2, p & 3, 4 * (hu & 1) + i, (const bf16_t*)(ws + WS_PROJ + PJ_XQ), qg, (bf16_t*)(ws + WS_PROJ + PJ_XO), F.lds);
            }
            __builtin_amdgcn_s_setprio(0);
            SEAM(pb + 4);
        }
        if (IN(pb + 5)) {
            PHASE_FRAME; CParams* pp = get_params(); unsigned char* ws = pp->ws;
            SchedRes S{F.G, F.bx, l, 1, ws};
            pg8::gemm_phase(F.lds, 1024, S, pg8::EpiResid{});
            SEAM(pb + 5);
        }
        if (IN(pb + 6) && moe) {
            PHASE_FRAME; CParams* pp = get_params(); unsigned char* ws = pp->ws; const bf16_t* xb = (const bf16_t*)(ws + WS_XB); const float* sq = ssq_slot(ws, 3 * l + 2);
            unsigned* gcnt = (unsigned*)(ws + WS_CTL) + CW_CNT + fi * 8 * 64;
            int* mlist = (int*)(ws + WS_MOE + MO_LIST); int4* minfo = (int4*)(ws + WS_MOE + MO_INFO); float2* mgate = (float2*)(ws + WS_MOE + MO_GATE);
            const float* rw = PIN(I_ROUTER_W) + (size_t)fi * D * NE; const float* rb = PIN(I_ROUTER_B) + fi * NE; const float* gn = PIN(I_NORM_FFN) + l * D;
            LAS float* rwl = (LAS float*)(F.lds + 70 * 1024);
            for (int i = F.tid; i < D * NE; i += NTHR) rwl[i] = rw[i] * gn[i >> 3];
            float rbv[8];
#pragma unroll
            for (int e = 0; e < 8; ++e) rbv[e] = rb[e];
#pragma nounroll
            for (int grp = F.bx; grp < T / 256; grp += F.G) {
                if (F.tid < 8) lcnt[F.tid] = 0;
                __syncthreads();
                int me1 = 0, me2 = 0; float mg1 = 0.f, mg2 = 0.f;
                u32x2 xnext[4]; f32x4 sqnext;
                { const int m0 = grp * 256 + F.wave * 32; load_row4(xnext, xb + (size_t)m0 * D, F.lane); sqnext = *(const f32x4*)(sq + (size_t)m0 * 4); }
#pragma nounroll
                for (int i = 0; i < 32; ++i) {
                    const int m = grp * 256 + F.wave * 32 + i;
                    const int ln = F.lane;
                    u32x2 xcur[4];
#pragma unroll
                    for (int j = 0; j < 4; ++j) xcur[j] = xnext[j];
                    const float rs = 1.0f / sqrtf(((sqnext.x + sqnext.y) + (sqnext.z + sqnext.w)) * (1.f / 1024.f) + EPS);
                    if (i < 31) { load_row4(xnext, xb + (size_t)(m + 1) * D, ln); sqnext = *(const f32x4*)(sq + (size_t)(m + 1) * 4); }
                    float lg[8]; typedef float f32x2_ __attribute__((ext_vector_type(2)));
                    f32x2_ l2[4] = {{0.f, 0.f}, {0.f, 0.f}, {0.f, 0.f}, {0.f, 0.f}};
#pragma unroll
                    for (int j = 0; j < 4; ++j) { const u32x2 xw = xcur[j]; const f32x4 xv = {bf_lo(xw.x), bf_hi(xw.x), bf_lo(xw.y), bf_hi(xw.y)};
#pragma unroll
                        for (int cc = 0; cc < 4; ++cc) { const LAS float* wr_ = rwl + (256 * j + 4 * ln + cc) * 8; const f32x4 w0 = *(const LAS f32x4*)wr_, w1 = *(const LAS f32x4*)(wr_ + 4); const f32x2_ hv = {xv[cc], xv[cc]};
                            l2[0] = hv * (f32x2_){w0.x, w0.y} + l2[0]; l2[1] = hv * (f32x2_){w0.z, w0.w} + l2[1]; l2[2] = hv * (f32x2_){w1.x, w1.y} + l2[2]; l2[3] = hv * (f32x2_){w1.z, w1.w} + l2[3]; } }
#pragma unroll
                    for (int e = 0; e < 4; ++e) { lg[2 * e] = l2[e].x; lg[2 * e + 1] = l2[e].y; }
#pragma unroll
                    for (int e = 0; e < 8; ++e) lg[e] = wave_sum(lg[e]) * rs + rbv[e];
                    int e1 = 0; float v1 = lg[0];
#pragma unroll
                    for (int e = 1; e < 8; ++e) if (lg[e] > v1) { v1 = lg[e]; e1 = e; }
                    int e2 = -1; float v2 = -INFINITY;
#pragma unroll
                    for (int e = 0; e < 8; ++e) if (e != e1 && lg[e] > v2) { v2 = lg[e]; e2 = e; }
                    const float ex = __expf(v2 - v1), den = 1.0f / (1.0f + ex);
                    if (F.lane == i) { me1 = e1; me2 = e2; mg1 = den; mg2 = ex * den; }
                }
                int p1 = 0, p2 = 0;
                if (F.lane < 32) { p1 = __hip_atomic_fetch_add(&lcnt[me1], 1, __ATOMIC_RELAXED, __HIP_MEMORY_SCOPE_WORKGROUP); p2 = __hip_atomic_fetch_add(&lcnt[me2], 1, __ATOMIC_RELAXED, __HIP_MEMORY_SCOPE_WORKGROUP); }
                __syncthreads();
                if (F.tid < 8) lcnt[8 + F.tid] = (int)__hip_atomic_fetch_add(gcnt + 64 * F.tid, (unsigned)lcnt[F.tid], __ATOMIC_RELAXED, __HIP_MEMORY_SCOPE_AGENT);
                __syncthreads();
                if (F.lane < 32) { const int tok = grp * 256 + F.wave * 32 + F.lane; const int q1 = lcnt[8 + me1] + p1, q2 = lcnt[8 + me2] + p2;
                    mlist[(size_t)me1 * T + q1] = tok; mlist[(size_t)me2 * T + q2] = tok; minfo[tok] = make_int4(me1 | (me2 << 8), q1, q2, 0); mgate[tok] = make_float2(mg1, mg2); }
                __syncthreads();
            }
            __syncthreads();
#pragma nounroll
            for (int rep = 0; rep < ((PROBE_DUP >> 5) & 1) + 1; ++rep) {
                convert_strip_list(F, NE * 224, [&](int fs) -> StripDesc {
                    const int e = fs / 224, r = fs - e * 224, up = r / 112, st = r - up * 112, n0 = st * 32; const size_t eo = ((size_t)fi * NE + e) * D * FF;
                    return StripDesc{(up ? PIN(I_EUP) : PIN(I_EGATE)) + eo + n0, gn, (signed char*)(ws + WS_EGU) + (size_t)e * 7168 * D, (float*)(ws + WS_WSC + SC_WE) + e * 7168, FF, (n0 >> 7) * 256 + 128 * up + (n0 & 127)}; });
                __syncthreads();
#pragma nounroll
                for (int e = 0; e < NE; ++e) convert_job_f8(F, PIN(I_EDOWN) + ((size_t)fi * NE + e) * D * FF, FF, D, (unsigned char*)(ws + WS_EDN) + (size_t)e * D * FF, RowIdent{});
            }
            SEAM(pb + 6);
        }
        if (IN(pb + 6) && !moe) {
            PHASE_FRAME; CParams* pp = get_params(); unsigned char* ws = pp->ws; GWS; const bf16_t* xb = (const bf16_t*)(ws + WS_XB); const float* sq = ssq_slot(ws, 3 * l + 2);
            signed char* xq = (signed char*)(ws + WS_PROJ + PJ_XQ8); float* rowsc = (float*)(ws + WS_WSC + SC_ROW);
            quant_pass(F, xb, sq, xq, rowsc);
            SEAM(pb + 6);
        }
        if (IN(pb + 7)) {
            if (!moe) {
                constexpr int NCH = 256 / CHUNK_BLK;
#pragma nounroll
                for (int c = 0; c <= NCH; ++c) {
                    if (c > 0) { PHASE_FRAME; CParams* pp = get_params(); unsigned char* ws = pp->ws;
                      SchedDown S{F.G, F.bx, CHUNK_BLK, c - 1, l, ws, nullptr};
                      pg8::gemm_phase(F.lds, FF, S, pg8::EpiResidT<2>{}); }
                    if (c < NCH) { PHASE_FRAME; CParams* pp = get_params(); unsigned char* ws = pp->ws;
                      SchedGU S{F.G, F.bx, CHUNK_BLK, c, l, ws, nullptr};
                      pg8::gemm_phase(F.lds, 1024, S, pg8::EpiSwiGLU8{});
                      xcd_barrier(bar); }
                }
            } else {
                { PHASE_FRAME; CParams* pp = get_params(); unsigned char* ws = pp->ws; moe_meta(F, (unsigned*)(ws + WS_CTL) + CW_CNT + fi * 8 * 64, meta);
                  moe_gather(F, 0, meta[16], meta, (const int*)(ws + WS_MOE + MO_LIST), (const bf16_t*)(ws + WS_XB), ssq_slot(ws, 3 * l + 2), (float*)(ws + WS_WSC + SC_SROW), (char*)(ws + WS_PROJ)); }
                const LAS int* pblk = meta + 8; const int nbtot = meta[16], nchunk = (nbtot + CHUNK_BLK - 1) / CHUNK_BLK;
                xcd_barrier(bar);
#pragma nounroll
                for (int c = 0; c <= nchunk; ++c) {
                    if (c > 0) { PHASE_FRAME; CParams* pp = get_params(); unsigned char* ws = pp->ws;
                      SchedDown S{F.G, F.bx, min(CHUNK_BLK, nbtot - CHUNK_BLK * (c - 1)), c - 1, l, ws, pblk};
                      pg8::gemm_phase(F.lds, FF, S, pg8::EpiStoreBf16T<2>{});
                      if ((PROBE_DUP >> 7) & 1) pg8::gemm_phase(F.lds, FF, S, pg8::EpiStoreBf16T<2>{}); }
                    if (c < nchunk) { PHASE_FRAME; CParams* pp = get_params(); unsigned char* ws = pp->ws;
                      SchedGU S{F.G, F.bx, min(CHUNK_BLK, nbtot - CHUNK_BLK * c), c, l, ws, pblk};
                      pg8::gemm_phase(F.lds, 1024, S, pg8::EpiSwiGLU8{});
                      if ((PROBE_DUP >> 6) & 1) pg8::gemm_phase(F.lds, 1024, S, pg8::EpiSwiGLU8{});
                      if (c + 1 < nchunk) moe_gather(F, c + 1, nbtot, meta, (const int*)(ws + WS_MOE + MO_LIST), (const bf16_t*)(ws + WS_XB), ssq_slot(ws, 3 * l + 2), (float*)(ws + WS_WSC + SC_SROW), (char*)(ws + WS_PROJ));
                      xcd_barrier(bar); }
                }
            }
            SEAM(pb + 7);
        }
        if (IN(pb + 8) && moe) {
            PHASE_FRAME; CParams* pp = get_params(); unsigned char* ws = pp->ws; GWS; float* xo = pp->out; bf16_t* xb = (bf16_t*)(ws + WS_XB); float* sq = ssq_slot(ws, 3 * l + 3); const bool lastl = (l == DEPTH - 1);
            const int4* minfo = (const int4*)(ws + WS_MOE + MO_INFO); const float2* mgate = (const float2*)(ws + WS_MOE + MO_GATE);
            moe_meta(F, (unsigned*)(ws + WS_CTL) + CW_CNT + fi * 8 * 64, meta);
            const LAS int* pblk = meta + 8; const bf16_t* ys = (const bf16_t*)(ws + WS_YS);
            struct Rec { unsigned r1, r2; float g1, g2; };
#define CB_REC(R, mb_) do { R.r1 = 0u; R.r2 = 0u; R.g1 = 0.f; R.g2 = 0.f; if (F.lane < 8) { int mj_ = (mb_) + F.lane * NGW; mj_ = mj_ < T ? mj_ : gw; const int4 inf = minfo[mj_]; const float2 gt = mgate[mj_]; const int e1 = inf.x & 255, e2 = inf.x >> 8; \
                R.r1 = (unsigned)(pblk[e1] * 256 + inf.y); R.r2 = (unsigned)(pblk[e2] * 256 + inf.z); R.g1 = gt.x; R.g2 = gt.y; } } while (0)
#define CB_LOAD(XW, YA, YB, GA, GB, R, mb_, sub_) do { _Pragma("unroll") for (int i = 0; i < 2; ++i) { const int j = (sub_) * 2 + i; int m_ = (mb_) + j * NGW; m_ = m_ < T ? m_ : gw; \
                const size_t r1 = (size_t)(unsigned)__builtin_amdgcn_readlane((int)R.r1, j), r2 = (size_t)(unsigned)__builtin_amdgcn_readlane((int)R.r2, j); \
                GA[i] = __builtin_bit_cast(float, __builtin_amdgcn_readlane(__builtin_bit_cast(int, R.g1), j)); GB[i] = __builtin_bit_cast(float, __builtin_amdgcn_readlane(__builtin_bit_cast(int, R.g2), j)); \
                load_row4(XW[i], xb + (size_t)m_ * D, F.lane); load_row4(YA[i], ys + r1 * D, F.lane); load_row4(YB[i], ys + r2 * D, F.lane); } } while (0)
#define CB_PROC(XW, YA, YB, GA, GB, mb_, sub_) do { _Pragma("unroll") for (int i = 0; i < 2; ++i) { const int j = (sub_) * 2 + i, m = (mb_) + j * NGW; if (m < T) { \
                u32x2* xr = (u32x2*)(xb + (size_t)m * D) + F.lane; f32x4* o4 = (f32x4*)(xo + (size_t)m * D) + F.lane; float q = 0.f, mx = 0.f; f32x4 xs[4]; \
                _Pragma("unroll") for (int jj = 0; jj < 4; ++jj) { const u32x2 xw_ = XW[i][jj], a = YA[i][jj], bq = YB[i][jj]; f32x4 xv; \
                    xv.x = bf_lo(xw_.x) + GA[i] * bf_lo(a.x) + GB[i] * bf_lo(bq.x); xv.y = bf_hi(xw_.x) + GA[i] * bf_hi(a.x) + GB[i] * bf_hi(bq.x); xv.z = bf_lo(xw_.y) + GA[i] * bf_lo(a.y) + GB[i] * bf_lo(bq.y); xv.w = bf_hi(xw_.y) + GA[i] * bf_hi(a.y) + GB[i] * bf_hi(bq.y); \
                    xs[jj] = xv; \
                    if (lastl) o4[64 * jj] = xv; \
                    else { q += (xv.x * xv.x + xv.y * xv.y) + (xv.z * xv.z + xv.w * xv.w); mx = fmaxf(mx, fmaxf(fmaxf(fabsf(xv.x), fabsf(xv.y)), fmaxf(fabsf(xv.z), fabsf(xv.w)))); \
                        u32x2 w; w.x = cvt_pk_bf16(xv.x, xv.y); w.y = cvt_pk_bf16(xv.z, xv.w); xr[64 * jj] = w; } } \
                if (!lastl) { q = wave_sum(q); mx = wave_max(mx); const float sc = mx > 0.f ? mx * (1.f / 127.f) : 1.f, inv = 1.0f / sc; unsigned* q8 = (unsigned*)((signed char*)(ws + WS_XQW) + (size_t)m * D) + F.lane; \
                    _Pragma("unroll") for (int jj = 0; jj < 4; ++jj) q8[64 * jj] = q4(xs[jj].x, xs[jj].y, xs[jj].z, xs[jj].w, inv); \
                    if (F.lane == 0) { *(f32x4*)(sq + (size_t)m * 4) = (f32x4){q, 0.f, 0.f, 0.f}; ((float*)(ws + WS_WSC + SC_ROWW))[m] = sc / sqrtf(q * (1.f / 1024.f) + EPS); } } } } } while (0)
            if (gw < T) {
                u32x2 xwA[2][4], yaA[2][4], ybA[2][4], xwB[2][4], yaB[2][4], ybB[2][4]; float gaA[2], gbA[2], gaB[2], gbB[2];
                Rec R, Rn; int mb = gw; const int bstep = 8 * NGW;
                CB_REC(R, mb);
                CB_LOAD(xwA, yaA, ybA, gaA, gbA, R, mb, 0);
#pragma nounroll
                for (;;) {
                    CB_REC(Rn, mb + bstep);
                    CB_LOAD(xwB, yaB, ybB, gaB, gbB, R, mb, 1); CB_PROC(xwA, yaA, ybA, gaA, gbA, mb, 0);
                    CB_LOAD(xwA, yaA, ybA, gaA, gbA, R, mb, 2); CB_PROC(xwB, yaB, ybB, gaB, gbB, mb, 1);
                    CB_LOAD(xwB, yaB, ybB, gaB, gbB, R, mb, 3); CB_PROC(xwA, yaA, ybA, gaA, gbA, mb, 2);
                    CB_LOAD(xwA, yaA, ybA, gaA, gbA, Rn, mb + bstep, 0); CB_PROC(xwB, yaB, ybB, gaB, gbB, mb, 3);
                    mb += bstep; if (mb >= T) break;
                    R = Rn;
                }
            }
#undef CB_REC
#undef CB_LOAD
#undef CB_PROC
            SEAM(pb + 8);
        }
    }
#undef IN
#undef SEAM
#undef GWS
#undef PHASE_FRAME
}

extern "C" void kernel_launch(void* const* d_in, const int* in_sizes, int n_in, void* d_out, int out_size, void* d_ws, size_t ws_size, hipStream_t stream) {
    static int grid = 0;
    if (grid == 0) {
        if (n_in != 27 || in_sizes[0] != T * D || out_size != T * D || ws_size < WS_END) { fprintf(stderr, "kernel_launch: unexpected shapes (n_in %d, in0 %d, out %d, ws %zu < %zu)\n", n_in, n_in > 0 ? in_sizes[0] : -1, out_size, ws_size, (size_t)WS_END); grid = -1; return; }
        int dev = 0, cus = 0, per_cu = 0;
        if (hipGetDevice(&dev) != hipSuccess || hipDeviceGetAttribute(&cus, hipDeviceAttributeMultiprocessorCount, dev) != hipSuccess) { grid = -1; return; }
        if (hipFuncSetAttribute((const void*)fwd_kernel, hipFuncAttributeMaxDynamicSharedMemorySize, LDS_BYTES) != hipSuccess) { fprintf(stderr, "kernel_launch: hipFuncSetAttribute failed\n"); grid = -1; return; }
        if (hipOccupancyMaxActiveBlocksPerMultiprocessor(&per_cu, (const void*)fwd_kernel, NTHR, LDS_BYTES) != hipSuccess || per_cu < 1) { fprintf(stderr, "kernel_launch: occupancy query says %d blocks per CU\n", per_cu); }
        (void)hipGetLastError();
        grid = cus;
    }
    if (grid < 0) return;
    if (hipMemsetAsync((char*)d_ws + WS_CTL, 0, CTL_BYTES, stream) != hipSuccess) return;
    Params p{};
    for (int i = 0; i < 27; ++i) p.in[i] = (const float*)d_in[i];
    p.out = (float*)d_out; p.ws = (unsigned char*)d_ws; p.ph_lo = 0; p.ph_hi = N_PHASES;
    hipLaunchKernelGGL(fwd_kernel, dim3(grid), dim3(NTHR), LDS_BYTES, stream, p);
}
```

```cpp
#include <hip/hip_runtime.h>
#include <cstdio>
#include <cstdint>

#define GAS __attribute__((address_space(1)))
#define LAS __attribute__((address_space(3)))
typedef unsigned short bf16_t;
typedef short bf16x8 __attribute__((ext_vector_type(8)));
typedef float f32x4 __attribute__((ext_vector_type(4)));
typedef float f32x16 __attribute__((ext_vector_type(16)));
typedef unsigned u32x4 __attribute__((ext_vector_type(4)));
typedef unsigned u32x2 __attribute__((ext_vector_type(2)));
typedef int i32x4 __attribute__((ext_vector_type(4)));
typedef int i32x8 __attribute__((ext_vector_type(8)));

constexpr int D = 1024, NB = 32, SEQ = 2048, T = NB * SEQ, DEPTH = 4, FF = 3584, NE = 8, NMEM = 256;
constexpr float EPS = 1e-6f;
constexpr int NWAVES = 8, NTHR = 512;

constexpr size_t MiB = 1u << 20;
constexpr size_t WS_CTL = 0, CTL_BYTES = 1 * MiB;
constexpr size_t WS_WIN = 1 * MiB;
constexpr size_t WS_WOUT = 19 * MiB;
constexpr size_t WS_WQ = 27 * MiB;
constexpr size_t WS_WKV = 31 * MiB;
constexpr size_t WS_WO = 39 * MiB;
constexpr size_t WS_WGU = 43 * MiB;
constexpr size_t WS_WDN = 71 * MiB;
constexpr size_t WS_EGU = 85 * MiB;
constexpr size_t WS_EDN = 197 * MiB;
constexpr size_t WS_KN = 253 * MiB;
constexpr size_t WS_VT = 285 * MiB;
constexpr size_t WS_XB = 317 * MiB;
constexpr size_t WS_PROJ = 445 * MiB;
constexpr size_t WS_YS = 733 * MiB;
constexpr size_t WS_MOE = 993 * MiB;
constexpr size_t WS_SSQ = 1001 * MiB;
constexpr size_t WS_WSC = 1013 * MiB;
constexpr size_t WS_XQW = 1015 * MiB;
constexpr size_t WS_END = 1079 * MiB;
constexpr size_t SC_WD = 0, SC_WE = 64 * 1024, SC_ROW = 512 * 1024, SC_SROW = 1024 * 1024, SC_ROWW = 1568 * 1024, SC_WIN = 1856 * 1024;
constexpr size_t PJ_SBQ = 0, PJ_SBK = 64 * MiB, PJ_SBVT = 128 * MiB, PJ_SWQ = 192 * MiB, PJ_SWKV = 256 * MiB;
constexpr size_t PJ_XQ = 0, PJ_XO = 64 * MiB;
constexpr size_t PJ_H = 0;
constexpr size_t PJ_GB = 224 * MiB;
constexpr size_t PJ_XQ8 = 224 * MiB;
constexpr size_t PJ_HM = 0;
constexpr size_t MO_LIST = 0;
constexpr size_t MO_INFO = 2 * MiB;
constexpr size_t MO_GATE = 3 * MiB;
constexpr int CHUNK_BLK = 128;
constexpr size_t H_BUF = (size_t)CHUNK_BLK * 256 * FF, GB_BUF = (size_t)CHUNK_BLK * 256 * 1024;
constexpr int CW_BAR = 1024;
constexpr int CW_CNT = 8192;

__device__ __forceinline__ unsigned cvt_pk_bf16(float lo, float hi) { unsigned r; asm volatile("v_cvt_pk_bf16_f32 %0, %1, %2" : "=v"(r) : "v"(lo), "v"(hi)); return r; }
__device__ __forceinline__ float bf_lo(unsigned w) { return __uint_as_float(w << 16); }
__device__ __forceinline__ float bf_hi(unsigned w) { return __uint_as_float(w & 0xffff0000u); }
template <int K> __device__ __forceinline__ float lane_xor(float v) { return __int_as_float(__builtin_amdgcn_ds_swizzle(__float_as_int(v), (K << 10) | 0x1F)); }
__device__ __forceinline__ float xor32_add(float v) { const auto rr = __builtin_amdgcn_permlane32_swap(__float_as_uint(v), __float_as_uint(v), false, false); return __uint_as_float(rr[0]) + __uint_as_float(rr[1]); }
__device__ __forceinline__ float xor32_max(float v) { const auto rr = __builtin_amdgcn_permlane32_swap(__float_as_uint(v), __float_as_uint(v), false, false); return fmaxf(__uint_as_float(rr[0]), __uint_as_float(rr[1])); }
__device__ __forceinline__ float xor32_get(float v, int hi) { const auto rr = __builtin_amdgcn_permlane32_swap(__float_as_uint(v), __float_as_uint(v), false, false); return hi ? __uint_as_float(rr[0]) : __uint_as_float(rr[1]); }
__device__ __forceinline__ float wave_sum(float v) {
    v += lane_xor<1>(v); v += lane_xor<2>(v); v += lane_xor<4>(v); v += lane_xor<8>(v); v += lane_xor<16>(v); return xor32_add(v);
}
#define LDS_WAIT() asm volatile("s_waitcnt lgkmcnt(0)" ::: "memory")
__device__ __forceinline__ unsigned pk4_fp8(float a, float b, float c, float d) { int p = __builtin_amdgcn_cvt_pk_fp8_f32(a, b, 0, false); p = __builtin_amdgcn_cvt_pk_fp8_f32(c, d, p, true); return (unsigned)p; }
constexpr float WDN_SCALE = 256.f;

namespace pg8 {
constexpr int BM = 256, BK = 64, HALF = 128, HTB = HALF * BK * 2, STAGE_BYTES = 8 * HTB, NXCD = 8, WGM = 8;
constexpr int XL_OFF = STAGE_BYTES;
__host__ __device__ __forceinline__ int lds_byte(int r, int c) { const int st = (r >> 4) * 2 + (c >> 5), rr = r & 15, cc = c & 31, ob = rr * 64 + cc * 2; return st * 1024 + (ob ^ (((ob >> 9) & 1) << 5)); }
__host__ __device__ __forceinline__ void stage_rc(int b, int& R, int& C) { const int st = b / 1024, sb = b % 1024, swz = sb ^ (((sb >> 9) & 1) << 5); R = (st >> 1) * 16 + swz / 64; C = (st & 1) * 32 + (swz % 64) / 2; }
__host__ __device__ __forceinline__ int perm32(int rho) { const int n = rho >> 4, i = rho & 15; return 8 * (i >> 2) + 4 * n + (i & 3); }

struct Unit { const char* a; const char* b; const float* sc; const float* sc2; int pm, pn; };
__device__ __forceinline__ void tile_of(int L, int nM, int nN, int& pm, int& pn) {
    const int nwg = nM * nN; int wgid = L;
    { const int q = nwg / NXCD, r = nwg % NXCD, xcd = wgid % NXCD, off = wgid / NXCD; wgid = (xcd < r ? xcd * (q + 1) : r * (q + 1) + (xcd - r) * q) + off; }
    const int nig = WGM * nN, gid = wgid / nig, fm = gid * WGM, gsz = (nM - fm) < WGM ? (nM - fm) : WGM;
    pm = fm + ((wgid % nig) % gsz); pn = (wgid % nig) / gsz;
}
struct Out { char* o; const char* r; int ldo; bf16_t* xb; float* ssq; int scmode; };
__device__ __forceinline__ float rs_of(const float* p4) { const f32x4 q = *(const f32x4*)p4; return 1.0f / sqrtf(((q.x + q.y) + (q.z + q.w)) * (1.f / 1024.f) + 1e-6f); }
__device__ __forceinline__ float rs_lds(const LAS float* p4) { const f32x4 q = *(const LAS f32x4*)p4; return 1.0f / sqrtf(((q.x + q.y) + (q.z + q.w)) * (1.f / 1024.f) + 1e-6f); }

template <int MD> struct EpiStoreBf16T {
    static constexpr bool PERM = true; static constexpr int MODE = MD; typedef f32x4 acc_t; static constexpr float OSC = (MD == 2) ? 1.0f / WDN_SCALE : 1.0f;
    __device__ __forceinline__ void operator()(const f32x4 (&acc)[2][2][4][2], const Out& u, int wr, int wc, int fr, int fq, const LAS float* xl, LAS float* xr) const {
        asm volatile("" : "+v"(fr), "+v"(fq));
        bf16_t* base = (bf16_t*)u.o + wc * 32 + 8 * fq;
        float cs[2][8];
        if (u.scmode == 2) {
#pragma unroll
            for (int bj = 0; bj < 2; ++bj)
#pragma unroll
                for (int j = 0; j < 8; ++j) cs[bj][j] = rs_lds(xl + (bj * HALF + wc * 32 + 8 * fq + j) * 4);
        }
#pragma unroll
        for (int ai = 0; ai < 2; ++ai)
#pragma unroll
            for (int m = 0; m < 4; ++m) { const int row = ai * HALF + wr * 64 + m * 16 + fr; bf16_t* rowp = base + (size_t)row * u.ldo;
                float rsc = OSC; if (u.scmode == 1) rsc = rs_lds(xl + row * 4);
#pragma unroll
                for (int bj = 0; bj < 2; ++bj) { f32x4 v0 = acc[ai][bj][m][0] * rsc, v1 = acc[ai][bj][m][1] * rsc;
                    if (u.scmode == 2) { v0.x *= cs[bj][0]; v0.y *= cs[bj][1]; v0.z *= cs[bj][2]; v0.w *= cs[bj][3]; v1.x *= cs[bj][4]; v1.y *= cs[bj][5]; v1.z *= cs[bj][6]; v1.w *= cs[bj][7]; }
                    u32x4 w; w.x = cvt_pk_bf16(v0[0], v0[1]); w.y = cvt_pk_bf16(v0[2], v0[3]); w.z = cvt_pk_bf16(v1[0], v1[1]); w.w = cvt_pk_bf16(v1[2], v1[3]);
                    *(u32x4*)(rowp + bj * HALF) = w; } }
    }
};
typedef EpiStoreBf16T<0> EpiStoreBf16;
struct EpiStoreI8 {
    static constexpr bool PERM = true; static constexpr int MODE = 1; typedef i32x4 acc_t;
    __device__ __forceinline__ void operator()(const i32x4 (&acc)[2][2][4][2], const Out& u, int wr, int wc, int fr, int fq, const LAS float* xl, LAS float* xr) const {
        asm volatile("" : "+v"(fr), "+v"(fq));
        bf16_t* base = (bf16_t*)u.o + wc * 32 + 8 * fq;
        float cs[2][8];
#pragma unroll
        for (int bj = 0; bj < 2; ++bj) { const f32x4 c0 = *(const LAS f32x4*)(xl + 256 + bj * HALF + wc * 32 + 8 * fq), c1 = *(const LAS f32x4*)(xl + 256 + bj * HALF + wc * 32 + 8 * fq + 4);
            cs[bj][0] = c0.x; cs[bj][1] = c0.y; cs[bj][2] = c0.z; cs[bj][3] = c0.w; cs[bj][4] = c1.x; cs[bj][5] = c1.y; cs[bj][6] = c1.z; cs[bj][7] = c1.w; }
#pragma unroll
        for (int ai = 0; ai < 2; ++ai)
#pragma unroll
            for (int m = 0; m < 4; ++m) { const int row = ai * HALF + wr * 64 + m * 16 + fr; bf16_t* rowp = base + (size_t)row * u.ldo; const float rsc = xl[row];
#pragma unroll
                for (int bj = 0; bj < 2; ++bj) { float v[8];
#pragma unroll
                    for (int n = 0; n < 2; ++n)
#pragma unroll
                        for (int j = 0; j < 4; ++j) v[n * 4 + j] = (float)acc[ai][bj][m][n][j] * (rsc * cs[bj][n * 4 + j]);
                    u32x4 w; w.x = cvt_pk_bf16(v[0], v[1]); w.y = cvt_pk_bf16(v[2], v[3]); w.z = cvt_pk_bf16(v[4], v[5]); w.w = cvt_pk_bf16(v[6], v[7]);
                    *(u32x4*)(rowp + bj * HALF) = w; } }
    }
};
struct EpiSwiGLU8 {
    static constexpr bool PERM = true; static constexpr int MODE = 1; typedef i32x4 acc_t;
    __device__ __forceinline__ void operator()(const i32x4 (&acc)[2][2][4][2], const Out& u, int wr, int wc, int fr, int fq, const LAS float* xl, LAS float* xr) const {
        asm volatile("" : "+v"(fr), "+v"(fq));
        unsigned char* base = (unsigned char*)u.o + wc * 32 + 8 * fq;
        const f32x4 cg0 = *(const LAS f32x4*)(xl + 256 + wc * 32 + 8 * fq), cg1 = *(const LAS f32x4*)(xl + 256 + wc * 32 + 8 * fq + 4);
        const f32x4 cu0 = *(const LAS f32x4*)(xl + 256 + HALF + wc * 32 + 8 * fq), cu1 = *(const LAS f32x4*)(xl + 256 + HALF + wc * 32 + 8 * fq + 4);
        const float cg[8] = {cg0.x, cg0.y, cg0.z, cg0.w, cg1.x, cg1.y, cg1.z, cg1.w}, cu[8] = {cu0.x, cu0.y, cu0.z, cu0.w, cu1.x, cu1.y, cu1.z, cu1.w};
#pragma unroll
        for (int ai = 0; ai < 2; ++ai)
#pragma unroll
            for (int m = 0; m < 4; ++m) { const int row = ai * HALF + wr * 64 + m * 16 + fr; unsigned char* rowp = base + (size_t)row * u.ldo;
                float nl2e = -1.4426950408889634f; asm volatile("" : "+s"(nl2e));
                const float rsc = xl[row], r2 = rsc * nl2e, rs2 = rsc * rsc;
                float h[8];
                typedef float f32x2_ __attribute__((ext_vector_type(2)));
#pragma unroll
                for (int n = 0; n < 2; ++n) { f32x2_ p[2], q[2], e[2];
#pragma unroll
                    for (int j = 0; j < 2; ++j) { p[j] = (f32x2_){(float)acc[ai][0][m][n][2 * j], (float)acc[ai][0][m][n][2 * j + 1]} * (f32x2_){cg[n * 4 + 2 * j], cg[n * 4 + 2 * j + 1]};
                                                  q[j] = (f32x2_){(float)acc[ai][1][m][n][2 * j], (float)acc[ai][1][m][n][2 * j + 1]} * (f32x2_){cu[n * 4 + 2 * j], cu[n * 4 + 2 * j + 1]}; }
#pragma unroll
                    for (int j = 0; j < 2; ++j) { const f32x2_ t = p[j] * r2; e[j].x = __builtin_amdgcn_exp2f(t.x); e[j].y = __builtin_amdgcn_exp2f(t.y); }
#pragma unroll
                    for (int j = 0; j < 2; ++j) { e[j] = e[j] + 1.0f; q[j] = p[j] * q[j]; }
#pragma unroll
                    for (int j = 0; j < 2; ++j) { e[j].x = __builtin_amdgcn_rcpf(e[j].x); e[j].y = __builtin_amdgcn_rcpf(e[j].y); }
#pragma unroll
                    for (int j = 0; j < 2; ++j) { const f32x2_ hh = q[j] * (e[j] * rs2); h[n * 4 + 2 * j] = hh.x; h[n * 4 + 2 * j + 1] = hh.y; } }
                u32x2 w; w.x = pk4_fp8(h[0], h[1], h[2], h[3]); w.y = pk4_fp8(h[4], h[5], h[6], h[7]);
                *(u32x2*)rowp = w; }
    }
};
template <int MD> struct EpiResidT {
    static constexpr bool PERM = true; static constexpr int MODE = MD; typedef f32x4 acc_t; static constexpr float OSC = (MD == 2) ? 1.0f / WDN_SCALE : 1.0f;
    __device__ __forceinline__ void operator()(const f32x4 (&acc)[2][2][4][2], const Out& u, int wr, int wc, int fr, int fq, const LAS float* xl_unused, LAS float* xl) const {
        asm volatile("" : "+v"(fr), "+v"(fq));
        bf16_t* base = u.xb + wc * 32 + 8 * fq;
        float ps[8];
        u32x4 rv[2][4][2];
#pragma unroll
        for (int ai = 0; ai < 2; ++ai)
#pragma unroll
            for (int m = 0; m < 4; ++m)
#pragma unroll
                for (int bj = 0; bj < 2; ++bj) rv[ai][m][bj] = *(const u32x4*)(base + (size_t)(ai * HALF + wr * 64 + m * 16 + fr) * 1024 + bj * HALF);
#pragma unroll
        for (int ai = 0; ai < 2; ++ai)
#pragma unroll
            for (int m = 0; m < 4; ++m) { bf16_t* rowp = base + (size_t)(ai * HALF + wr * 64 + m * 16 + fr) * 1024; float q = 0.f;
#pragma unroll
                for (int bj = 0; bj < 2; ++bj) { const u32x4 r = rv[ai][m][bj]; const f32x4 a0 = acc[ai][bj][m][0] * OSC, a1 = acc[ai][bj][m][1] * OSC;
                    const float x0 = bf_lo(r.x) + a0.x, x1 = bf_hi(r.x) + a0.y, x2 = bf_lo(r.y) + a0.z, x3 = bf_hi(r.y) + a0.w, x4 = bf_lo(r.z) + a1.x, x5 = bf_hi(r.z) + a1.y, x6 = bf_lo(r.w) + a1.z, x7 = bf_hi(r.w) + a1.w;
                    q += ((x0 * x0 + x1 * x1) + (x2 * x2 + x3 * x3)) + ((x4 * x4 + x5 * x5) + (x6 * x6 + x7 * x7));
                    u32x4 w; w.x = cvt_pk_bf16(x0, x1); w.y = cvt_pk_bf16(x2, x3); w.z = cvt_pk_bf16(x4, x5); w.w = cvt_pk_bf16(x6, x7);
                    *(u32x4*)(rowp + bj * HALF) = w; }
                q += lane_xor<16>(q); q = xor32_add(q); ps[ai * 4 + m] = q; }
        if (fq == 0) {
#pragma unroll
            for (int ai = 0; ai < 2; ++ai)
#pragma unroll
                for (int m = 0; m < 4; ++m) xl[(ai * HALF + wr * 64 + m * 16 + fr) * 4 + wc] = ps[ai * 4 + m]; }
        asm volatile("s_waitcnt lgkmcnt(0)" ::: "memory"); __builtin_amdgcn_s_barrier(); asm volatile("" ::: "memory");
        const int t = wr * 256 + wc * 64 + fq * 16 + fr;
        if (t < 256) { const f32x4 q4 = *(const LAS f32x4*)(xl + t * 4); u.ssq[(size_t)t * 4] = (q4.x + q4.y) + (q4.z + q4.w); }
        asm volatile("s_waitcnt lgkmcnt(0)" ::: "memory"); __builtin_amdgcn_s_barrier(); asm volatile("" ::: "memory");
    }
};

typedef EpiResidT<0> EpiResid;
template <class Epi, class Sched>
__device__ __forceinline__ void gemm_phase(LAS unsigned char* lds, const int KB, const Sched& S, const Epi& E) {
    int tid = threadIdx.x; asm volatile("" : "+v"(tid));
    const int wid = __builtin_amdgcn_readfirstlane(tid >> 6), lane = tid & 63, wr = wid >> 2, wc = wid & 3, fr = lane & 15, fq = lane >> 4;
    const int nt = KB / 128;
    unsigned voffA[2], voffB[2];
#pragma unroll
    for (int i = 0; i < 2; ++i) { int R, C; stage_rc(tid * 16 + i * 8192, R, C); const int Rb = Epi::PERM ? ((R & ~31) + perm32(R & 31)) : R;
        voffA[i] = (unsigned)(R * KB + C * 2); voffB[i] = (unsigned)(Rb * KB + C * 2); }
    const size_t kstep = (size_t)(BK * 2);
    const size_t hstep = (size_t)HALF * KB;
    const unsigned ldsw = (unsigned)wid * 1024u;
    const unsigned ldsb_ = (unsigned)(size_t)lds;
    const int aoff = lds_byte(wr * 64 + fr, fq * 8), boff = lds_byte(wc * 32 + fr, fq * 8);
#define PG8_SA(b, h) (((b) * 2 + (h)) * HTB)
#define PG8_SB(b, h) ((4 + (b) * 2 + (h)) * HTB)
#define PG8_STAGE(bufoff, gbase, voff) do { const unsigned so_ = (unsigned)(size_t)(gbase) - (unsigned)(size_t)S.ws; \
        const __amdgpu_buffer_rsrc_t srd_ = __builtin_amdgcn_make_buffer_rsrc((void*)S.ws, (short)0, 0x7FFFFFFF, 0x00020000); \
        _Pragma("unroll") for (int _i = 0; _i < 2; ++_i) \
        asm volatile("s_mov_b32 m0, %0\n\ts_nop 0\n\tbuffer_load_dwordx4 %1, %2, %3 offen lds" :: "s"(ldsb_ + (unsigned)(bufoff) + ldsw + (unsigned)(_i * 8192)), "v"((voff)[_i]), "s"(srd_), "s"(so_) : "m0", "memory"); } while (0)
#define PG8_LDA(dst, b, h) do { _Pragma("unroll") for (int m = 0; m < 4; ++m) { if constexpr (Epi::MODE == 2) { const i32x4 lo_ = *(const LAS i32x4*)(lds + PG8_SA(b, h) + aoff + m * 2048), hi_ = *(const LAS i32x4*)(lds + PG8_SA(b, h) + aoff + m * 2048 + 1024); \
            dst##8[m] = __builtin_shufflevector(lo_, hi_, 0, 1, 2, 3, 4, 5, 6, 7); } else { _Pragma("unroll") for (int k = 0; k < 2; ++k) dst[m][k] = *(const LAS bf16x8*)(lds + PG8_SA(b, h) + aoff + m * 2048 + k * 1024); } } } while (0)
#define PG8_LDB(dst, b, h) do { _Pragma("unroll") for (int n = 0; n < 2; ++n) { if constexpr (Epi::MODE == 2) { const i32x4 lo_ = *(const LAS i32x4*)(lds + PG8_SB(b, h) + boff + n * 2048), hi_ = *(const LAS i32x4*)(lds + PG8_SB(b, h) + boff + n * 2048 + 1024); \
            dst##8[n] = __builtin_shufflevector(lo_, hi_, 0, 1, 2, 3, 4, 5, 6, 7); } else { _Pragma("unroll") for (int k = 0; k < 2; ++k) dst[n][k] = *(const LAS bf16x8*)(lds + PG8_SB(b, h) + boff + n * 2048 + k * 1024); } } } while (0)
#define PG8_MMA(ai, bj, At, Bt, Z) do { __builtin_amdgcn_s_setprio(1); _Pragma("unroll") for (int m = 0; m < 4; ++m) _Pragma("unroll") for (int n = 0; n < 2; ++n) { \
        if constexpr (Epi::MODE == 2) { \
            if constexpr ((Z) != 0) asm volatile("s_nop 1\n\tv_mfma_scale_f32_16x16x128_f8f6f4 %0, %1, %2, 0, %3, %3 op_sel_hi:[0,0,0]" : "=&v"(acc[ai][bj][m][n]) : "v"(Bt##8[n]), "v"(At##8[m]), "v"(f8one)); \
            else asm volatile("s_nop 1\n\tv_mfma_scale_f32_16x16x128_f8f6f4 %0, %1, %2, %0, %3, %3 op_sel_hi:[0,0,0]" : "+v"(acc[ai][bj][m][n]) : "v"(Bt##8[n]), "v"(At##8[m]), "v"(f8one)); } \
        else { _Pragma("unroll") for (int k = 0; k < 2; ++k) { const typename Epi::acc_t c_ = ((Z) != 0 && k == 0 && Epi::MODE == 1) ? (typename Epi::acc_t){0, 0, 0, 0} : acc[ai][bj][m][n]; \
            if constexpr (Epi::MODE == 1) acc[ai][bj][m][n] = __builtin_amdgcn_mfma_i32_16x16x64_i8(__builtin_bit_cast(i32x4, Bt[n][k]), __builtin_bit_cast(i32x4, At[m][k]), c_, 0, 0, 0); \
            else acc[ai][bj][m][n] = __builtin_amdgcn_mfma_f32_16x16x32_bf16(Bt[n][k], At[m][k], c_, 0, 0, 0); } } } __builtin_amdgcn_s_setprio(0); } while (0)
#define PG8_WAIT_V(n) asm volatile("s_waitcnt vmcnt(" #n ")" ::: "memory")
#define PG8_WAIT_L(n) asm volatile("s_waitcnt lgkmcnt(" #n ")" ::: "memory")
#define PG8_BAR __builtin_amdgcn_s_barrier()
#define PG8_SCHED __builtin_amdgcn_sched_barrier(0)
    Unit cur, nxt; int ui = 0;
    if (!__builtin_amdgcn_readfirstlane((int)S.next(0, cur))) return;
    typename Epi::acc_t acc[2][2][4][2];
#define PG8_ZERO_ACC do { if constexpr (Epi::MODE == 0) { _Pragma("unroll") for (int a = 0; a < 2; ++a) _Pragma("unroll") for (int b = 0; b < 2; ++b) _Pragma("unroll") for (int m = 0; m < 4; ++m) _Pragma("unroll") for (int n = 0; n < 2; ++n) \
        acc[a][b][m][n] = (typename Epi::acc_t){0, 0, 0, 0}; } } while (0)
    PG8_ZERO_ACC;
    bf16x8 At[4][2], B0[2][2], B1[2][2];
    i32x8 At8[4], B08[2], B18[2];
    const int f8one = 0x7F7F7F7F;
    const char* cA = cur.a; const char* cB = cur.b;
#define PG8_SCALES(un, buf) do { if ((un).sc != nullptr && wid < 4) { unsigned lane; asm volatile("v_mbcnt_lo_u32_b32 %0, -1, 0\n\tv_mbcnt_hi_u32_b32 %0, -1, %0" : "=v"(lane));        \
        if constexpr (Epi::MODE == 1) { __builtin_amdgcn_global_load_lds((const unsigned*)((un).sc + wid * 64 + lane), (LAS unsigned*)(lds + XL_OFF + (buf) * 4096 + wid * 256), 4, 0, 0); \
                                 __builtin_amdgcn_global_load_lds((const unsigned*)((un).sc2 + wid * 64 + lane), (LAS unsigned*)(lds + XL_OFF + (buf) * 4096 + 1024 + wid * 256), 4, 0, 0); } \
        else __builtin_amdgcn_global_load_lds((const unsigned*)((un).sc + (wid * 64 + lane) * 4), (LAS unsigned*)(lds + XL_OFF + (buf) * 4096 + wid * 1024), 16, 0, 0); } } while (0)
    PG8_SCALES(cur, 0);
    PG8_STAGE(PG8_SB(0, 0), cB, voffB); PG8_STAGE(PG8_SB(0, 1), cB + hstep, voffB); PG8_STAGE(PG8_SA(0, 0), cA, voffA); PG8_STAGE(PG8_SA(0, 1), cA + hstep, voffA);
    if (wr == 1) PG8_BAR;
    PG8_WAIT_V(2); PG8_BAR;
    PG8_STAGE(PG8_SB(1, 0), cB + kstep, voffB); PG8_STAGE(PG8_SA(1, 0), cA + kstep, voffA); PG8_STAGE(PG8_SB(1, 1), cB + hstep + kstep, voffB);
    PG8_WAIT_V(6); PG8_BAR;
    for (;;) {
        const bool has_next = S.next(ui + 1, nxt);
        const char* nA = has_next ? nxt.a : cA; const char* nB = has_next ? nxt.b : cB;
#define PG8_ITER(Z) do { \
            const bool last = (t == nt - 2); \
            const char* a1 = cA + (size_t)(t + 1) * kstep; \
            const char* a2 = last ? nA : cA + (size_t)(t + 2) * kstep; const char* b2 = last ? nB : cB + (size_t)(t + 2) * kstep; \
            const char* a3 = a2 + kstep; const char* b3 = b2 + kstep; \
            PG8_LDB(B0, 0, 0); PG8_LDB(B1, 0, 1); PG8_SCHED; PG8_LDA(At, 0, 0); PG8_STAGE(PG8_SA(1, 1), a1 + hstep, voffA); \
            PG8_WAIT_V(8); PG8_WAIT_L(0); PG8_BAR; PG8_MMA(0, 0, At, B0, Z); PG8_MMA(0, 1, At, B1, Z); PG8_BAR; PG8_SCHED; \
            PG8_LDA(At, 0, 1); PG8_STAGE(PG8_SB(0, 0), b2, voffB); PG8_STAGE(PG8_SB(0, 1), b2 + hstep, voffB); PG8_STAGE(PG8_SA(0, 0), a2, voffA); \
            PG8_WAIT_V(8); PG8_WAIT_L(0); PG8_BAR; PG8_MMA(1, 0, At, B0, Z); PG8_MMA(1, 1, At, B1, Z); PG8_BAR; PG8_SCHED; \
            PG8_LDB(B0, 1, 0); PG8_LDB(B1, 1, 1); PG8_SCHED; PG8_LDA(At, 1, 0); PG8_STAGE(PG8_SA(0, 1), a2 + hstep, voffA); \
            PG8_WAIT_V(8); PG8_WAIT_L(0); PG8_BAR; PG8_MMA(0, 0, At, B0, 0); PG8_MMA(0, 1, At, B1, 0); PG8_BAR; PG8_SCHED; \
            PG8_LDA(At, 1, 1); PG8_STAGE(PG8_SB(1, 0), b3, voffB); PG8_STAGE(PG8_SB(1, 1), b3 + hstep, voffB); PG8_STAGE(PG8_SA(1, 0), a3, voffA); \
            PG8_WAIT_V(8); PG8_WAIT_L(0); PG8_BAR; PG8_MMA(1, 0, At, B0, 0); PG8_MMA(1, 1, At, B1, 0); PG8_BAR; PG8_SCHED; } while (0)
        if constexpr (Epi::MODE == 0) { for (int t = 0; t < nt; t += 2) PG8_ITER(0); }
        else { { const int t = 0; PG8_ITER(1); }
               for (int t = 2; t < nt; t += 2) PG8_ITER(0); }
#undef PG8_ITER
        if (has_next) PG8_SCALES(nxt, (ui + 1) & 1);
        if (wr == 0) PG8_BAR;
        if constexpr (Epi::MODE == 2) asm volatile("s_nop 15\n\ts_nop 15\n\ts_nop 15" ::: "memory");
        { Out eo; S.out(cur, eo); unsigned le_; asm volatile("v_mbcnt_lo_u32_b32 %0, -1, 0\n\tv_mbcnt_hi_u32_b32 %0, -1, %0" : "=v"(le_));
          E(acc, eo, wr, wc, (int)(le_ & 15u), (int)(le_ >> 4), (LAS float*)(lds + XL_OFF + (ui & 1) * 4096), (LAS float*)(lds + XL_OFF + 8192)); }
        if (!has_next) break;
        PG8_ZERO_ACC;
        cur = nxt; cA = nA; cB = nB; ++ui;
        if (wr == 1) PG8_BAR;
    }
    PG8_WAIT_V(0);
    PG8_BAR;
#undef PG8_SCALES
#undef PG8_SA
#undef PG8_SB
#undef PG8_STAGE
#undef PG8_LDA
#undef PG8_LDB
#undef PG8_MMA
#undef PG8_WAIT_V
#undef PG8_WAIT_L
#undef PG8_BAR
#undef PG8_SCHED
}
}

#define XB_TMO      128
#define XB_XCNT(j)  (256  + 64 * (j))
#define XB_XSUB(j)  (1280 + 64 * (j))
#define XB_XGEN(j)  (2304 + 64 * (j))
#define XB_TOP      3328
#define XB_TOPGEN   3392
#define XCD_BAR_WORDS 3456
#define XB_SPIN_CAP (1u << 18)
__device__ __forceinline__ unsigned xb_ld(unsigned* p)              { return __hip_atomic_load(p, __ATOMIC_RELAXED, __HIP_MEMORY_SCOPE_AGENT); }
__device__ __forceinline__ unsigned xb_add(unsigned* p, unsigned v) { return __hip_atomic_fetch_add(p, v, __ATOMIC_RELAXED, __HIP_MEMORY_SCOPE_AGENT); }
__device__ __forceinline__ unsigned xb_xcc_id() { return (unsigned)__builtin_amdgcn_s_getreg((3 << 11) | 20) & 0xFu; }
#define XB_SPIN(cond, bar) do { unsigned _sp = 0; while (cond) { __builtin_amdgcn_s_sleep(1); \
    if ((++_sp & 255u) == 0u) { if (xb_ld(&(bar)[XB_TMO])) break; if (_sp > XB_SPIN_CAP) { atomicAdd(&(bar)[XB_TMO], 1u); break; } } } } while (0)
struct XcdBarrier { unsigned* bar; unsigned x; volatile LAS unsigned* st; };
__device__ __forceinline__ XcdBarrier xcd_barrier_post(unsigned* bar, volatile LAS unsigned* st) {
    XcdBarrier b; b.bar = bar; b.x = xb_xcc_id(); b.st = st;
    if (threadIdx.x == 0) (void)xb_add(&bar[XB_XCNT(b.x)], 1u);
    return b;
}
__device__ __forceinline__ void xcd_barrier_complete(unsigned* bar, unsigned x, unsigned& nloc, unsigned& nx) {
    const unsigned G = gridDim.x * gridDim.y * gridDim.z;
    unsigned sum, cnt, mine, sp = 0u;
    for (;;) {
        sum = 0u; cnt = 0u; mine = 0u;
#pragma unroll
        for (unsigned j = 0; j < 16; ++j) { const unsigned c = xb_ld(&bar[XB_XCNT(j)]); sum += c; cnt += (c > 0u) ? 1u : 0u; mine = (j == x) ? c : mine; }
        if (sum == G) break;
        __builtin_amdgcn_s_sleep(1);
        if ((++sp & 255u) == 0u) { if (xb_ld(&bar[XB_TMO])) break; if (sp > XB_SPIN_CAP) { atomicAdd(&bar[XB_TMO], 1u); break; } }
    }
    nloc = mine > 0u ? mine : 1u; nx = cnt > 0u ? cnt : 1u;
}
__device__ __forceinline__ void xcd_barrier(const XcdBarrier& b) {
    asm volatile("s_waitcnt vmcnt(0)" ::: "memory");
    __syncthreads();
    if (threadIdx.x == 0) {
        unsigned* bar = b.bar; asm volatile("" : "+s"(bar)); unsigned bx_ = b.x; asm volatile("" : "+s"(bx_));
        __builtin_amdgcn_s_waitcnt(0);
        unsigned nloc = b.st[0], nx = b.st[1];
        if (nloc == 0u) { xcd_barrier_complete(bar, bx_, nloc, nx); b.st[0] = nloc; b.st[1] = nx; }
        const unsigned old = xb_add(&bar[XB_XSUB(bx_)], 1u);
        const unsigned gen = old / nloc;
        if (old + 1u == (gen + 1u) * nloc) {
            __builtin_amdgcn_fence(__ATOMIC_RELEASE, "agent");
            asm volatile("s_waitcnt vmcnt(0)" ::: "memory");
            const unsigned og = xb_add(&bar[XB_TOP], 1u);
            const unsigned tg = og / nx;
            if (og + 1u == (tg + 1u) * nx) xb_add(&bar[XB_TOPGEN], 1u);
            else XB_SPIN(xb_ld(&bar[XB_TOPGEN]) == tg, bar);
            __builtin_amdgcn_fence(__ATOMIC_ACQUIRE, "agent");
            xb_add(&bar[XB_XGEN(bx_)], 1u);
            asm volatile("s_waitcnt vmcnt(0)" ::: "memory");
        } else {
            XB_SPIN(xb_ld(&bar[XB_XGEN(bx_)]) == gen, bar);
            __builtin_amdgcn_fence(__ATOMIC_ACQUIRE, "agent");
            asm volatile("s_waitcnt vmcnt(0)" ::: "memory");
        }
    }
    __syncthreads();
}

constexpr int RING_BYTES = 131072;
constexpr int MISC_OFF = RING_BYTES + 12288;
constexpr int LDS_BYTES = RING_BYTES + 4096 + 12288;

struct Params {
    const float* in[27];
    float* out;
    unsigned char* ws;
    int ph_lo, ph_hi;
};
enum { I_X = 0, I_MEM, I_NORM_MIX, I_W_IN, I_SB_OUT_GAIN, I_SWA_Q_GAIN, I_SWA_K_GAIN, I_SWA_SINKS, I_SWA_OUT_GAIN, I_REL_BIAS, I_W_OUT, I_NORM_XATTN, I_NORM_MEM,
       I_XWQ, I_XWKV, I_XQ_GAIN, I_XK_GAIN, I_XWO, I_NORM_FFN, I_DGATE, I_DUP, I_DDOWN, I_ROUTER_W, I_ROUTER_B, I_EGATE, I_EUP, I_EDOWN };

struct Frame {
    LAS unsigned char* lds;
    int tid, lane, wave;
    int G, bx;
};

template <class RowMap>
__device__ __forceinline__ void transpose_item(const float* W, int K, int N, bf16_t* WT, const RowMap& rm, LAS float* scr, int item, int lane) {
    const int nblk = N / 32, kb = item / nblk, nb = item % nblk, k0 = 64 * kb, n0 = 32 * nb;
    { f32x4 wv[8]; const int n4 = (lane & 7) * 4;
#pragma unroll
      for (int i = 0; i < 8; ++i) wv[i] = *(const f32x4*)(W + (size_t)(k0 + 8 * i + (lane >> 3)) * N + n0 + n4);
#pragma unroll
      for (int i = 0; i < 8; ++i) { const int kk = 8 * i + (lane >> 3); const float gk = rm.gain ? rm.gain[k0 + kk] : 1.0f; LAS float* d = scr + kk * 33 + n4; d[0] = wv[i].x * gk; d[1] = wv[i].y * gk; d[2] = wv[i].z * gk; d[3] = wv[i].w * gk; } }
    LDS_WAIT(); asm volatile("" ::: "memory");
    const int c = lane & 7; const int r0 = rm(n0);
#pragma unroll
    for (int j = 0; j < 4; ++j) { const int n = (lane >> 3) + 8 * j; const LAS float* s = scr + (8 * c) * 33 + n;
        u32x4 o; o.x = cvt_pk_bf16(s[0 * 33], s[1 * 33]); o.y = cvt_pk_bf16(s[2 * 33], s[3 * 33]); o.z = cvt_pk_bf16(s[4 * 33], s[5 * 33]); o.w = cvt_pk_bf16(s[6 * 33], s[7 * 33]);
        *(u32x4*)(WT + (size_t)(r0 + n) * K + k0 + 8 * c) = o; }
    LDS_WAIT(); asm volatile("" ::: "memory");
}
template <class RowMap>
__device__ __forceinline__ void transpose_item_f8(const float* W, int K, int N, unsigned char* WT, const RowMap& rm, LAS float* scr, int item, int lane) {
    const int nblk = N / 32, kb = item / nblk, nb = item % nblk, k0 = 64 * kb, n0 = 32 * nb;
    { f32x4 wv[8]; const int n4 = (lane & 7) * 4;
#pragma unroll
      for (int i = 0; i < 8; ++i) wv[i] = *(const f32x4*)(W + (size_t)(k0 + 8 * i + (lane >> 3)) * N + n0 + n4);
#pragma unroll
      for (int i = 0; i < 8; ++i) { LAS float* d = scr + (8 * i + (lane >> 3)) * 33 + n4; d[0] = wv[i].x * WDN_SCALE; d[1] = wv[i].y * WDN_SCALE; d[2] = wv[i].z * WDN_SCALE; d[3] = wv[i].w * WDN_SCALE; } }
    LDS_WAIT(); asm volatile("" ::: "memory");
    const int c = lane & 7; const int r0 = rm(n0);
#pragma unroll
    for (int j = 0; j < 4; ++j) { const int n = (lane >> 3) + 8 * j; const LAS float* sp = scr + (8 * c) * 33 + n;
        u32x2 o; o.x = pk4_fp8(sp[0 * 33], sp[1 * 33], sp[2 * 33], sp[3 * 33]); o.y = pk4_fp8(sp[4 * 33], sp[5 * 33], sp[6 * 33], sp[7 * 33]);
        *(u32x2*)(WT + (size_t)(r0 + n) * K + k0 + 8 * c) = o; }
    LDS_WAIT(); asm volatile("" ::: "memory");
}
struct RowIdent { const float* gain = nullptr; __device__ __forceinline__ int operator()(int n0) const { return n0; } };
struct RowGate { const float* gain = nullptr; __device__ __forceinline__ int operator()(int n0) const { return (n0 >> 7) * 256 + (n0 & 127); } };
struct RowUp { const float* gain = nullptr; __device__ __forceinline__ int operator()(int n0) const { return (n0 >> 7) * 256 + 128 + (n0 & 127); } };

__device__ __forceinline__ void norm_row(const float* xrow, bf16_t* orow, const f32x4 (&g)[4], f32x4 (&v)[4], int lane) {
    const f32x4* xr = (const f32x4*)xrow + lane; float s = 0.f;
#pragma unroll
    for (int j = 0; j < 4; ++j) { v[j] = xr[64 * j]; s += (v[j].x * v[j].x + v[j].y * v[j].y) + (v[j].z * v[j].z + v[j].w * v[j].w); }
    const float rs = 1.0f / sqrtf(wave_sum(s) * (1.f / D) + EPS);
    u32x2* o8 = (u32x2*)orow + lane;
#pragma unroll
    for (int j = 0; j < 4; ++j) { v[j] = v[j] * rs * g[j]; u32x2 w; w.x = cvt_pk_bf16(v[j].x, v[j].y); w.y = cvt_pk_bf16(v[j].z, v[j].w); o8[64 * j] = w; }
}

__device__ __forceinline__ int pi32(int i) { return 16 * ((i >> 2) & 1) + 4 * (i >> 3) + (i & 3); }
__device__ __forceinline__ bf16x8 pack8(const float* p) {
    u32x4 w; w.x = cvt_pk_bf16(p[0], p[1]); w.y = cvt_pk_bf16(p[2], p[3]); w.z = cvt_pk_bf16(p[4], p[5]); w.w = cvt_pk_bf16(p[6], p[7]);
    return __builtin_bit_cast(bf16x8, w);
}
__device__ __forceinline__ void unpack8(bf16x8 v, float* f) {
    const u32x4 w = __builtin_bit_cast(u32x4, v);
    f[0] = bf_lo(w.x); f[1] = bf_hi(w.x); f[2] = bf_lo(w.y); f[3] = bf_hi(w.y); f[4] = bf_lo(w.z); f[5] = bf_hi(w.z); f[6] = bf_lo(w.w); f[7] = bf_hi(w.w);
}
#define MFMA32(a, b, c) __builtin_amdgcn_mfma_f32_32x32x16_bf16((a), (b), (c), 0, 0, 0)
__device__ __forceinline__ u32x4 pair_halves(u32x2 even, u32x2 odd) {
    const auto x = __builtin_amdgcn_permlane32_swap(even.x, odd.x, false, false), y = __builtin_amdgcn_permlane32_swap(even.y, odd.y, false, false);
    return (u32x4){x[0], y[0], x[1], y[1]};
}

__device__ __forceinline__ void group_norm_store(const f32x16 (&o)[2], int h, int r32, int hi, const LAS float* gain, bf16_t* outrow0, LAS float* part  ) {
    float a = 0.f;
#pragma unroll
    for (int dd = 0; dd < 2; ++dd)
#pragma unroll
        for (int r = 0; r < 16; ++r) a += o[dd][r] * o[dd][r];
    a = xor32_add(a);
    if (hi == 0) part[h * 32 + r32] = a;
    __syncthreads();
    float tot = 0.f;
#pragma unroll
    for (int hh = 0; hh < 8; ++hh) tot += part[hh * 32 + r32];
    const float rs = 1.0f / sqrtf(tot * (1.f / 512.f) + EPS);
    bf16_t* orow = outrow0 + (size_t)r32 * 1024 + h * 64 + 8 * hi;
#pragma unroll
    for (int dd = 0; dd < 2; ++dd)
#pragma unroll
        for (int k = 0; k < 2; ++k) { u32x2 w[2];
#pragma unroll
            for (int e = 0; e < 2; ++e) { const int gq = 2 * k + e; const f32x4 gv = *(const LAS f32x4*)(gain + h * 64 + 32 * dd + 8 * gq + 4 * hi);
                w[e].x = cvt_pk_bf16(o[dd][4 * gq] * rs * gv.x, o[dd][4 * gq + 1] * rs * gv.y); w[e].y = cvt_pk_bf16(o[dd][4 * gq + 2] * rs * gv.z, o[dd][4 * gq + 3] * rs * gv.w); }
            *(u32x4*)(orow + 32 * dd + 16 * k) = pair_halves(w[0], w[1]); }
}

constexpr float SB_THR = -40.f * 1.4426950408889634f;
__device__ __forceinline__ void sb_block(const bf16x8 (&kf)[4], const bf16x8 (&vf)[2][2], const LAS bf16x8* qp  , f32x16 (&o)[2], float& C, int key0, int tq0  , int r32, int hi) {
    f32x16 s;
#pragma unroll
    for (int r = 0; r < 16; ++r) s[r] = 0.f;
#pragma unroll
    for (int d0 = 0; d0 < 4; ++d0) s = MFMA32(kf[d0], qp[64 * d0], s);
    const int tqr = tq0 + r32, kk0 = key0 + 16 * hi;
    float pre[16]; float run = 0.f; float p[16];
    if (key0 + 31 >= tq0) {
#pragma unroll
        for (int r = 15; r >= 0; --r) {
            const float z = s[r] * (0.125f * 1.4426950408889634f);
            const float sp = fmaxf(z, 0.f) + __builtin_amdgcn_logf(1.0f + __builtin_amdgcn_exp2f(-fabsf(z)));
            pre[r] = (z - sp) + run;
            run += ((kk0 + r) < tqr) ? -sp : 0.f;
        }
        const float other = xor32_get(run, hi);
        const float base = C + (hi == 0 ? other : 0.f);
#pragma unroll
        for (int r = 0; r < 16; ++r) p[r] = ((kk0 + r) < tqr) ? __builtin_amdgcn_exp2f(pre[r] + base) : 0.f;
        C += run + other;
    } else {
#pragma unroll
        for (int r = 15; r >= 0; --r) {
            const float z = s[r] * (0.125f * 1.4426950408889634f);
            const float sp = fmaxf(z, 0.f) + __builtin_amdgcn_logf(1.0f + __builtin_amdgcn_exp2f(-fabsf(z)));
            pre[r] = (z - sp) + run;
            run -= sp;
        }
        const float other = xor32_get(run, hi);
        const float base = C + (hi == 0 ? other : 0.f);
#pragma unroll
        for (int r = 0; r < 16; ++r) p[r] = __builtin_amdgcn_exp2f(pre[r] + base);
        C += run + other;
    }
    const bf16x8 pa0 = pack8(p), pa1 = pack8(p + 8);
#pragma unroll
    for (int dd = 0; dd < 2; ++dd) { o[dd] = MFMA32(vf[dd][0], pa0, o[dd]); o[dd] = MFMA32(vf[dd][1], pa1, o[dd]); }
}
__device__ __forceinline__ void sb_unit(const Frame& F, int b, int tq, const bf16_t* sbq, const bf16_t* sbk, const bf16_t* sbvT, const LAS float* gain, bf16_t* mixed, LAS float* part, LAS unsigned char* lds) {
    int lane = F.lane; asm volatile("" : "+v"(lane));
    const int r32 = lane & 31, hi = lane >> 5, h = F.wave;
    const size_t rowbase = (size_t)b * SEQ; const int t0 = tq * 64;
    LAS bf16x8* qlds = (LAS bf16x8*)(lds + h * 8192) + lane;
    { bf16x8 qt[8];
#pragma unroll
      for (int i = 0; i < 8; ++i) qt[i] = *(const bf16x8*)(sbq + (rowbase + t0 + 32 * (i >> 2) + r32) * 512 + h * 64 + 16 * (i & 3) + 8 * hi);
#pragma unroll
      for (int i = 0; i < 8; ++i) qlds[64 * i] = qt[i]; }
    f32x16 o[2][2];
#pragma unroll
    for (int g = 0; g < 2; ++g)
#pragma unroll
        for (int dd = 0; dd < 2; ++dd)
#pragma unroll
            for (int r = 0; r < 16; ++r) o[g][dd][r] = 0.f;
    float C[2] = {0.f, 0.f};
    const bf16_t* kbase = sbk + (rowbase + pi32(r32)) * 512 + h * 64 + 8 * hi;
    const bf16_t* vbase = sbvT + ((size_t)(b * 8 + h) * 64 + r32) * SEQ + 16 * hi;
#define SB_LOAD(KF, VF, kb_) do { const int k0_ = (kb_) * 32; \
        _Pragma("unroll") for (int d0 = 0; d0 < 4; ++d0) KF[d0] = *(const bf16x8*)(kbase + (size_t)k0_ * 512 + 16 * d0); \
        _Pragma("unroll") for (int dd = 0; dd < 2; ++dd) _Pragma("unroll") for (int s_ = 0; s_ < 2; ++s_) VF[dd][s_] = *(const bf16x8*)(vbase + (size_t)(32 * dd) * SEQ + k0_ + 8 * s_); } while (0)
#define SB_STEP(KF, VF, kb_) do { const int k0_ = (kb_) * 32; \
        _Pragma("unroll") for (int g = 0; g < 2; ++g) { if (k0_ > t0 + 32 * g + 31) continue; if (__all(C[g] < SB_THR)) continue; sb_block(KF, VF, qlds + 256 * g, o[g], C[g], k0_, t0 + 32 * g, r32, hi); } } while (0)
    bf16x8 kfA[4], vfA[2][2], kfB[4], vfB[2][2];
    int kb = 2 * tq + 1;
    SB_LOAD(kfA, vfA, kb);
    for (;;) {
        SB_LOAD(kfB, vfB, kb >= 1 ? kb - 1 : 0);
        SB_STEP(kfA, vfA, kb);
        if (kb == 0 || __all(C[0] < SB_THR && C[1] < SB_THR)) break;
        SB_LOAD(kfA, vfA, kb >= 2 ? kb - 2 : 0);
        SB_STEP(kfB, vfB, kb - 1);
        if (kb == 1 || __all(C[0] < SB_THR && C[1] < SB_THR)) break;
        kb -= 2;
    }
#undef SB_LOAD
#undef SB_STEP
    group_norm_store(o[0], h, r32, hi, gain, mixed + (rowbase + t0) * 1024, part);
    group_norm_store(o[1], h, r32, hi, gain, mixed + (rowbase + t0 + 32) * 1024, part + 256);
}

constexpr int SW_KROW = 144, SW_VROW = 400;
constexpr int SW_KS = 0, SW_VT = 2 * 192 * SW_KROW, SW_END = SW_VT + 2 * 64 * SW_VROW;
template <bool INTERIOR>
__device__ __forceinline__ void swa_groups(const bf16x8 (&qraw0)[4], const bf16x8 (&qraw1)[4], int h, int kvh, int r32, int hi, int kstart, size_t rowbase, int t0, const LAS float* qgain, float sink, const LAS float* ogain,
                                           bf16_t* mixed, LAS unsigned char* lds, const LAS float* bias, LAS float* part) {
#pragma nounroll
    for (int g = 0; g < 2; ++g) {
        f32x16 o[2];
        bf16x8 qf[4];
        { float qv[4][8]; float ss = 0.f;
#pragma unroll
          for (int d0 = 0; d0 < 4; ++d0) { unpack8(g ? qraw1[d0] : qraw0[d0], qv[d0]);
#pragma unroll
              for (int jj = 0; jj < 8; ++jj) ss += qv[d0][jj] * qv[d0][jj]; }
          ss = xor32_add(ss);
          const float rs = (0.125f * 1.4426950408889634f) / sqrtf(ss * (1.f / 64.f) + EPS);
#pragma unroll
          for (int d0 = 0; d0 < 4; ++d0) { const f32x4 g0 = *(const LAS f32x4*)(qgain + 16 * d0 + 8 * hi), g1 = *(const LAS f32x4*)(qgain + 16 * d0 + 8 * hi + 4);
              float qn[8] = {qv[d0][0] * rs * g0.x, qv[d0][1] * rs * g0.y, qv[d0][2] * rs * g0.z, qv[d0][3] * rs * g0.w, qv[d0][4] * rs * g1.x, qv[d0][5] * rs * g1.y, qv[d0][6] * rs * g1.z, qv[d0][7] * rs * g1.w};
              qf[d0] = pack8(qn); } }
        f32x16 sc[5];
        const int qw = 128 + 32 * g + r32;
#pragma unroll
        for (int jb = 0; jb < 5; ++jb) {
            const LAS unsigned char* kp = lds + SW_KS + (kvh * 192 + 32 * (g + jb) + pi32(r32)) * SW_KROW + 16 * hi;
#pragma unroll
            for (int r = 0; r < 16; ++r) sc[jb][r] = 0.f;
#pragma unroll
            for (int d0 = 0; d0 < 4; ++d0) sc[jb] = MFMA32(*(const LAS bf16x8*)(kp + 32 * d0), qf[d0], sc[jb]);
        }
        float m = sink;
#pragma unroll
        for (int jb = 0; jb < 5; ++jb) {
            const int kb = g + jb;
            const LAS float* bt = bias + h * 128 + (qw - 32 * kb - 16 * hi - 15);
            float bv[16];
#pragma unroll
            for (int r = 0; r < 16; ++r) bv[r] = bt[15 - r];
            const int d0_ = qw - 32 * kb - 16 * hi;
            if constexpr (INTERIOR) {
#pragma unroll
                for (int r = 0; r < 16; ++r) { const bool valid = (jb == 0) ? (d0_ - r < 128) : (jb == 4) ? (d0_ - r >= 0) : true;
                    const float v = valid ? sc[jb][r] + bv[r] : -INFINITY; sc[jb][r] = v; m = fmaxf(m, v); }
            } else {
#pragma unroll
                for (int r = 0; r < 16; ++r) { const int kw = 32 * kb + 16 * hi + r, dist = d0_ - r; const bool valid = (dist >= 0) && (dist < 128) && (kstart + kw >= 0);
                    const float v = valid ? sc[jb][r] + bv[r] : -INFINITY; sc[jb][r] = v; m = fmaxf(m, v); }
            }
        }
        m = xor32_max(m);
        float l = 0.f;
#pragma unroll
        for (int jb = 0; jb < 5; ++jb)
#pragma unroll
            for (int r = 0; r < 16; ++r) { const float p = __builtin_amdgcn_exp2f(sc[jb][r] - m); sc[jb][r] = p; l += p; }
        l = xor32_add(l); l += __builtin_amdgcn_exp2f(sink - m);
#pragma unroll
        for (int dd = 0; dd < 2; ++dd)
#pragma unroll
            for (int r = 0; r < 16; ++r) o[dd][r] = 0.f;
#pragma unroll
        for (int jb = 0; jb < 5; ++jb) {
            const int kb = g + jb;
            float p[16];
#pragma unroll
            for (int r = 0; r < 16; ++r) p[r] = sc[jb][r];
            const bf16x8 pa0 = pack8(p), pa1 = pack8(p + 8);
#pragma unroll
            for (int dd = 0; dd < 2; ++dd) { const LAS unsigned char* vp = lds + SW_VT + (kvh * 64 + 32 * dd + r32) * SW_VROW; const int vsw = (4 * dd + (r32 >> 3)) & 7, vc = 4 * kb + 2 * hi;
                o[dd] = MFMA32(*(const LAS bf16x8*)(vp + ((vc ^ vsw) << 4)), pa0, o[dd]); o[dd] = MFMA32(*(const LAS bf16x8*)(vp + (((vc + 1) ^ vsw) << 4)), pa1, o[dd]); }
        }
        const float inv = 1.0f / l;
#pragma unroll
        for (int dd = 0; dd < 2; ++dd)
#pragma unroll
            for (int r = 0; r < 16; ++r) o[dd][r] *= inv;
        group_norm_store(o, h, r32, hi, ogain, mixed + (rowbase + t0 + 32 * g) * 1024 + 512, part + 256 * g);
    }
}
__device__ __forceinline__ void swa_unit(const Frame& F, int b, int tq, const bf16_t* swq, const bf16_t* swkv, const LAS float* qgain, const LAS float* kgain, const LAS float* sinks, const LAS float* ogain,
                                         bf16_t* mixed, LAS unsigned char* lds, const LAS float* bias, LAS float* part) {
    int tid = F.tid; asm volatile("" : "+v"(tid));
    const int lane = tid & 63, r32 = lane & 31, hi = lane >> 5, h = F.wave, kvh = h >> 2;
    const size_t rowbase = (size_t)b * SEQ; const int t0 = tq * 64, kstart = t0 - 128;
    bf16x8 qraw0[4], qraw1[4];
#pragma unroll
    for (int d0 = 0; d0 < 4; ++d0) { qraw0[d0] = *(const bf16x8*)(swq + (rowbase + t0 + r32) * 512 + h * 64 + 16 * d0 + 8 * hi); qraw1[d0] = *(const bf16x8*)(swq + (rowbase + t0 + 32 + r32) * 512 + h * 64 + 16 * d0 + 8 * hi); }
    bf16x8 kraw[6], vraw[6];
#pragma unroll
    for (int i = 0; i < 6; ++i) {
        const int c = tid + 512 * i, row = c >> 3, p8 = c & 7, kv = row / 192, j = row - kv * 192, spos = kstart + j;
        const bf16_t* src = swkv + (rowbase + (spos > 0 ? spos : 0)) * 256 + kv * 64 + 8 * p8; kraw[i] = *(const bf16x8*)src; vraw[i] = *(const bf16x8*)(src + 128);
    }
#pragma unroll
    for (int i = 0; i < 6; ++i) {
        const int c = tid + 512 * i, row = c >> 3, p8 = c & 7, kv = row / 192, j = row - kv * 192, spos = kstart + j;
        float kfv[8]; unpack8(kraw[i], kfv); bf16x8 vr = vraw[i];
        if (spos < 0) {
#pragma unroll
            for (int jj = 0; jj < 8; ++jj) { kfv[jj] = 0.f; vr[jj] = 0; } }
        float ss = 0.f;
#pragma unroll
        for (int jj = 0; jj < 8; ++jj) ss += kfv[jj] * kfv[jj];
        ss += lane_xor<1>(ss); ss += lane_xor<2>(ss); ss += lane_xor<4>(ss);
        const float rs = 1.0f / sqrtf(ss * (1.f / 64.f) + EPS);
        const f32x4 g0 = *(const LAS f32x4*)(kgain + 8 * p8), g1 = *(const LAS f32x4*)(kgain + 8 * p8 + 4);
        float kn[8] = {kfv[0] * rs * g0.x, kfv[1] * rs * g0.y, kfv[2] * rs * g0.z, kfv[3] * rs * g0.w, kfv[4] * rs * g1.x, kfv[5] * rs * g1.y, kfv[6] * rs * g1.z, kfv[7] * rs * g1.w};
        *(LAS bf16x8*)(lds + SW_KS + (kv * 192 + j) * SW_KROW + 16 * p8) = pack8(kn);
#pragma unroll
        for (int jj = 0; jj < 8; ++jj) *(LAS short*)(lds + SW_VT + (kv * 64 + 8 * p8 + jj) * SW_VROW + ((((j >> 3) ^ p8) << 4) + 2 * (j & 7))) = vr[jj];
    }
    __syncthreads();
    const float sink = sinks[h] * 1.4426950408889634f;
    if (kstart >= 0) swa_groups<true>(qraw0, qraw1, h, kvh, r32, hi, kstart, rowbase, t0, qgain, sink, ogain, mixed, lds, bias, part);
    else             swa_groups<false>(qraw0, qraw1, h, kvh, r32, hi, kstart, rowbase, t0, qgain, sink, ogain, mixed, lds, bias, part);
}

__device__ __forceinline__ void xattn_stage(const Frame& F, int b, int hx, const bf16_t* kn, const bf16_t* vt, LAS unsigned char* lds) {
    int tid = F.tid; asm volatile("" : "+v"(tid));
    { const bf16_t* ksrc = kn + (size_t)(b * NMEM) * 512 + hx * 128; const bf16_t* vsrc = vt + (size_t)((b * 4 + hx) * 128) * NMEM;
#pragma unroll
      for (int half = 0; half < 2; ++half) { u32x4 kv[4], vv[4];
#pragma unroll
          for (int i = 0; i < 4; ++i) { const int c = tid + 512 * (half * 4 + i);
              const int krow = c >> 4, kch = c & 15; kv[i] = *(const u32x4*)(ksrc + (size_t)krow * 512 + kch * 8);
              const int vrow = c >> 5, vch = c & 31; vv[i] = *(const u32x4*)(vsrc + (size_t)vrow * NMEM + vch * 8); }
#pragma unroll
          for (int i = 0; i < 4; ++i) { const int c = tid + 512 * (half * 4 + i);
              const int krow = c >> 4, kch = c & 15; *(LAS u32x4*)(lds + krow * 256 + ((kch ^ (krow & 15)) << 4)) = kv[i];
              const int vrow = c >> 5, vch = c & 31; *(LAS u32x4*)(lds + 65536 + vrow * 512 + ((vch ^ (vrow & 31)) << 4)) = vv[i]; } } }
}
__device__ __forceinline__ void xattn_tile(const Frame& F, int b, int hx, int qt, const bf16_t* xq, const LAS float* qgain  , bf16_t* xo, LAS unsigned char* lds) {
    int tid = F.tid; asm volatile("" : "+v"(tid));
    const int lane = tid & 63, r32 = lane & 31, hi = lane >> 5, w = F.wave;
    const size_t row = (size_t)b * SEQ + qt * 256 + 32 * w + r32;
    bf16x8 qf[8];
    { float ss = 0.f; float qv[8][8];
#pragma unroll
      for (int d0 = 0; d0 < 8; ++d0) { unpack8(*(const bf16x8*)(xq + row * 512 + hx * 128 + 16 * d0 + 8 * hi), qv[d0]);
#pragma unroll
          for (int jj = 0; jj < 8; ++jj) ss += qv[d0][jj] * qv[d0][jj]; }
      ss = xor32_add(ss);
      const float rs = (0.08838834764831845f * 1.4426950408889634f) / sqrtf(ss * (1.f / 128.f) + EPS);
#pragma unroll
      for (int d0 = 0; d0 < 8; ++d0) { const f32x4 g0 = *(const LAS f32x4*)(qgain + 16 * d0 + 8 * hi), g1 = *(const LAS f32x4*)(qgain + 16 * d0 + 8 * hi + 4);
          float qn[8] = {qv[d0][0] * rs * g0.x, qv[d0][1] * rs * g0.y, qv[d0][2] * rs * g0.z, qv[d0][3] * rs * g0.w, qv[d0][4] * rs * g1.x, qv[d0][5] * rs * g1.y, qv[d0][6] * rs * g1.z, qv[d0][7] * rs * g1.w};
          qf[d0] = pack8(qn); } }
    f32x16 o[4];
#pragma unroll
    for (int dd = 0; dd < 4; ++dd)
#pragma unroll
        for (int r = 0; r < 16; ++r) o[dd][r] = 0.f;
    float m = -INFINITY, l = 0.f;
    const int pk = pi32(r32);
#pragma nounroll
    for (int kb = 0; kb < 8; ++kb) {
        const int krow = 32 * kb + pk; const LAS unsigned char* kp = lds + krow * 256; const int ksw = krow & 15;
        f32x16 s;
#pragma unroll
        for (int r = 0; r < 16; ++r) s[r] = 0.f;
#pragma unroll
        for (int d0 = 0; d0 < 8; ++d0) s = MFMA32(*(const LAS bf16x8*)(kp + (((2 * d0 + hi) ^ ksw) << 4)), qf[d0], s);
        float rm = s[0];
#pragma unroll
        for (int r = 1; r < 16; ++r) rm = fmaxf(rm, s[r]);
        rm = xor32_max(rm);
        const bool resc = __any(rm > m + 8.0f);
        float f = 1.0f;
        if (resc) { const float mn = fmaxf(m, rm); f = __builtin_amdgcn_exp2f(m - mn); m = mn; l *= f; }
        float p[16]; float ls = 0.f;
#pragma unroll
        for (int r = 0; r < 16; ++r) { p[r] = __builtin_amdgcn_exp2f(s[r] - m); ls += p[r]; }
        l += ls;
        const bf16x8 pa0 = pack8(p), pa1 = pack8(p + 8);
#pragma unroll
        for (int dd = 0; dd < 4; ++dd) {
            if (resc) {
#pragma unroll
                for (int r = 0; r < 16; ++r) o[dd][r] *= f; }
            const int vrow = 32 * dd + r32; const LAS unsigned char* vp = lds + 65536 + vrow * 512; const int vsw = vrow & 31, vc = 4 * kb + 2 * hi;
            o[dd] = MFMA32(*(const LAS bf16x8*)(vp + ((vc ^ vsw) << 4)), pa0, o[dd]); o[dd] = MFMA32(*(const LAS bf16x8*)(vp + (((vc + 1) ^ vsw) << 4)), pa1, o[dd]); }
    }
    l = xor32_add(l);
    const float inv = 1.0f / l;
    bf16_t* orow = xo + row * 512 + hx * 128 + 8 * hi;
#pragma unroll
    for (int dd = 0; dd < 4; ++dd)
#pragma unroll
        for (int k = 0; k < 2; ++k) { u32x2 w[2];
#pragma unroll
            for (int e = 0; e < 2; ++e) { const int gq = 2 * k + e; w[e].x = cvt_pk_bf16(o[dd][4 * gq] * inv, o[dd][4 * gq + 1] * inv); w[e].y = cvt_pk_bf16(o[dd][4 * gq + 2] * inv, o[dd][4 * gq + 3] * inv); }
            *(u32x4*)(orow + 32 * dd + 16 * k) = pair_halves(w[0], w[1]); }
}

using pg8::Unit; using pg8::Out;
__device__ __forceinline__ float* ssq_slot(unsigned char* ws, int s) { return (float*)(ws + WS_SSQ) + (size_t)s * T * 4; }
struct SchedWin {
    int G, c, l; unsigned char* ws;
    __device__ __forceinline__ bool next(int i, Unit& u) const {
        const int L = i * G + c; if (L >= 256 * 9) return false; int pm, pn; pg8::tile_of(L, 256, 9, pm, pn); u.pm = pm; u.pn = pn;
        const char* arow = (const char*)(ws + WS_XQW) + (size_t)pm * 256 * 1024; const char* brow = (const char*)(ws + WS_WIN) + ((size_t)l * 2304 + pn * 256) * 1024;
        const float* asc = (const float*)(ws + WS_WSC + SC_ROWW) + (size_t)pm * 256; const float* bsc = (const float*)(ws + WS_WSC + SC_WIN) + (size_t)l * 2304 + pn * 256;
        if ((pn >> 1) == 2) { u.a = brow; u.b = arow; u.sc = bsc; u.sc2 = asc; } else { u.a = arow; u.b = brow; u.sc = asc; u.sc2 = bsc; }
        return true;
    }
    __device__ __forceinline__ void out(const Unit& u, Out& e) const {
        const int pm = u.pm, pn = u.pn; char* proj = (char*)(ws + WS_PROJ); e.r = nullptr; e.xb = nullptr; e.ssq = nullptr; e.scmode = 1;
        if (pn == 4 || pn == 5) { const int b = pm >> 3, t0 = (pm & 7) * 256; e.o = proj + PJ_SBVT + ((size_t)((b * 8 + 4 * (pn - 4)) * 64) * SEQ + t0) * 2; e.ldo = SEQ; }
        else if (pn < 2) { e.o = proj + PJ_SBQ + ((size_t)pm * 256 * 512 + pn * 256) * 2; e.ldo = 512; }
        else if (pn < 4) { e.o = proj + PJ_SBK + ((size_t)pm * 256 * 512 + (pn - 2) * 256) * 2; e.ldo = 512; }
        else if (pn < 8) { e.o = proj + PJ_SWQ + ((size_t)pm * 256 * 512 + (pn - 6) * 256) * 2; e.ldo = 512; }
        else             { e.o = proj + PJ_SWKV + ((size_t)pm * 256 * 256) * 2; e.ldo = 256; }
    }
};
struct SchedRes {
    int G, c, l, which; unsigned char* ws;
    __device__ __forceinline__ bool next(int i, Unit& u) const {
        const int L = i * G + c; if (L >= 1024) return false; int pm, pn; pg8::tile_of(L, 256, 4, pm, pn); u.pm = pm; u.pn = pn; u.sc = nullptr; u.sc2 = nullptr;
        if (which == 0) { u.a = (const char*)(ws + WS_YS) + (size_t)pm * 256 * 1024 * 2; u.b = (const char*)(ws + WS_WOUT) + ((size_t)l * 1024 + pn * 256) * 1024 * 2; }
        else            { u.a = (const char*)(ws + WS_PROJ + PJ_XO) + (size_t)pm * 256 * 512 * 2; u.b = (const char*)(ws + WS_WO) + ((size_t)l * 1024 + pn * 256) * 512 * 2; }
        return true;
    }
    __device__ __forceinline__ void out(const Unit& u, Out& e) const {
        const size_t eoff = (size_t)u.pm * 256 * 1024 + u.pn * 256; e.o = nullptr; e.r = nullptr; e.ldo = 1024; e.scmode = 0;
        e.xb = (bf16_t*)(ws + WS_XB) + eoff; e.ssq = ssq_slot(ws, 3 * l + 1 + which) + (size_t)u.pm * 256 * 4 + u.pn;
    }
};
struct SchedWq {
    int G, c, l; unsigned char* ws;
    __device__ __forceinline__ bool next(int i, Unit& u) const {
        const int L = i * G + c; if (L >= 512) return false; int pm, pn; pg8::tile_of(L, 256, 2, pm, pn); u.pm = pm; u.pn = pn;
        u.a = (const char*)(ws + WS_XB) + (size_t)pm * 256 * 1024 * 2; u.b = (const char*)(ws + WS_WQ) + ((size_t)l * 512 + pn * 256) * 1024 * 2; u.sc = ssq_slot(ws, 3 * l + 1) + (size_t)pm * 256 * 4; u.sc2 = nullptr; return true;
    }
    __device__ __forceinline__ void out(const Unit& u, Out& e) const { e.o = (char*)(ws + WS_PROJ + PJ_XQ) + ((size_t)u.pm * 256 * 512 + u.pn * 256) * 2; e.r = nullptr; e.ldo = 512; e.xb = nullptr; e.ssq = nullptr; e.scmode = 1; }
};
struct SchedKV {
    int G, c; unsigned char* ws;
    __device__ __forceinline__ bool next(int i, Unit& u) const {
        const int L = i * G + c; if (L >= 512) return false; const int l = L >> 7, rem = L & 127; u.pm = L; u.pn = 0; u.sc = nullptr; u.sc2 = nullptr;
        const char* hml = (const char*)(ws + WS_PROJ + PJ_HM) + (size_t)l * 8192 * 1024 * 2; const char* wl = (const char*)(ws + WS_WKV) + (size_t)l * 1024 * 1024 * 2;
        if (rem < 64) { const int pm = rem >> 1, pn = rem & 1; u.a = hml + (size_t)pm * 256 * 1024 * 2; u.b = wl + (size_t)pn * 256 * 1024 * 2; }
        else { const int r2 = rem - 64, bb = r2 >> 1, dt = r2 & 1; u.a = wl + (size_t)(512 + dt * 256) * 1024 * 2; u.b = hml + (size_t)bb * 256 * 1024 * 2; }
        return true;
    }
    __device__ __forceinline__ void out(const Unit& u, Out& e) const {
        const int L = u.pm, l = L >> 7, rem = L & 127; e.r = nullptr; e.xb = nullptr; e.ssq = nullptr; e.scmode = 0;
        if (rem < 64) { const int pm = rem >> 1, pn = rem & 1; e.o = (char*)(ws + WS_YS) + (size_t)l * 8192 * 512 * 2 + ((size_t)pm * 256 * 512 + pn * 256) * 2; e.ldo = 512; }
        else { const int r2 = rem - 64, bb = r2 >> 1, dt = r2 & 1; e.o = (char*)(ws + WS_VT) + (size_t)l * 8192 * 512 * 2 + ((size_t)(bb * 4 + 2 * dt) * 128 * 256) * 2; e.ldo = 256; }
    }
};
struct SchedGU {
    int G, c, nM, ch, l; unsigned char* ws; const LAS int* pblk;
    __device__ __forceinline__ bool next(int i, Unit& u) const {
        const int L = i * G + c; if (L >= nM * 28) return false; int pm, pn; pg8::tile_of(L, nM, 28, pm, pn); u.pm = pm; u.pn = pn;
        if (pblk) { const int blk = ch * CHUNK_BLK + pm; int e = 0;
#pragma unroll
            for (int k = 1; k < 8; ++k) e += (pblk[k] <= blk) ? 1 : 0;
            e = __builtin_amdgcn_readfirstlane(e);
            u.a = (const char*)(ws + WS_PROJ + PJ_GB) + (size_t)(ch & 1) * GB_BUF + (size_t)pm * 256 * 1024; u.b = (const char*)(ws + WS_EGU) + ((size_t)e * 7168 + pn * 256) * 1024;
            u.sc = (const float*)(ws + WS_WSC + SC_SROW) + ((size_t)ch * CHUNK_BLK + pm) * 256; u.sc2 = (const float*)(ws + WS_WSC + SC_WE) + (size_t)e * 7168 + pn * 256; }
        else { const size_t row0 = ((size_t)ch * CHUNK_BLK + pm) * 256;
            u.a = (const char*)(ws + WS_PROJ + PJ_XQ8) + row0 * 1024; u.b = (const char*)(ws + WS_WGU) + ((size_t)(l >> 1) * 7168 + pn * 256) * 1024;
            u.sc = (const float*)(ws + WS_WSC + SC_ROW) + row0; u.sc2 = (const float*)(ws + WS_WSC + SC_WD) + (size_t)(l >> 1) * 7168 + pn * 256; }
        return true;
    }
    __device__ __forceinline__ void out(const Unit& u, Out& e) const { e.o = (char*)(ws + WS_PROJ + PJ_H) + (size_t)(ch & 1) * H_BUF + ((size_t)u.pm * 256 * FF + u.pn * 128); e.r = nullptr; e.ldo = FF; e.xb = nullptr; e.ssq = nullptr; e.scmode = 1; }
};
struct SchedDown {
    int G, c, nM, ch, l; unsigned char* ws; const LAS int* pblk;
    __device__ __forceinline__ bool next(int i, Unit& u) const {
        const int L = i * G + c; if (L >= nM * 4) return false; int pm, pn; pg8::tile_of(L, nM, 4, pm, pn); u.pm = pm; u.pn = pn; u.sc = nullptr; u.sc2 = nullptr;
        int e = 0; if (pblk) { const int blk = ch * CHUNK_BLK + pm;
#pragma unroll
            for (int k = 1; k < 8; ++k) e += (pblk[k] <= blk) ? 1 : 0;
            e = __builtin_amdgcn_readfirstlane(e); }
        u.a = (const char*)(ws + WS_PROJ + PJ_H) + (size_t)(ch & 1) * H_BUF + (size_t)pm * 256 * FF;
        u.b = (pblk ? (const char*)(ws + WS_EDN) + (size_t)e * 1024 * FF : (const char*)(ws + WS_WDN) + (size_t)(l >> 1) * 1024 * FF) + (size_t)pn * 256 * FF; return true;
    }
    __device__ __forceinline__ void out(const Unit& u, Out& e) const {
        const size_t eoff = ((size_t)ch * CHUNK_BLK + u.pm) * 256 * 1024 + u.pn * 256; e.ldo = 1024; e.scmode = 0;
        if (pblk) { e.o = (char*)((bf16_t*)(ws + WS_YS) + eoff); e.r = nullptr; e.xb = nullptr; e.ssq = nullptr; }
        else { e.o = nullptr; e.r = nullptr; e.xb = (bf16_t*)(ws + WS_XB) + eoff; e.ssq = ssq_slot(ws, 3 * l + 3) + ((size_t)ch * CHUNK_BLK + u.pm) * 256 * 4 + u.pn; }
    }
};

__constant__ unsigned char T5B[128] = {0,1,2,3,4,5,6,7,8,9,10,11,12,13,14,15,16,16,16,17,17,18,18,18,19,19,19,20,20,20,20,21,21,21,21,22,22,22,22,22,23,23,23,23,23,23,24,24,24,24,24,24,25,25,25,25,25,25,25,26,26,26,26,26,26,26,26,27,27,27,27,27,27,27,27,27,27,28,28,28,28,28,28,28,28,28,28,29,29,29,29,29,29,29,29,29,29,29,29,30,30,30,30,30,30,30,30,30,30,30,30,30,30,31,31,31,31,31,31,31,31,31,31,31,31,31,31,31};

__device__ __forceinline__ void moe_meta(const Frame& F, unsigned* gcnt, LAS int* meta) {
    __syncthreads();
    if (F.tid < 8) meta[F.tid] = (int)__hip_atomic_load(gcnt + 64 * F.tid, __ATOMIC_RELAXED, __HIP_MEMORY_SCOPE_AGENT);
    __syncthreads();
    if (F.tid == 0) { int pre = 0;
        for (int e = 0; e < 8; ++e) { meta[8 + e] = pre; pre += (meta[e] + 255) >> 8; }
        meta[16] = pre; }
    __syncthreads();
}
__device__ __forceinline__ int expert_of_blk(const LAS int* pblk, int blk) { int e = 0;
#pragma unroll
    for (int k = 1; k < 8; ++k) e += (pblk[k] <= blk) ? 1 : 0;
    return e; }

__device__ __forceinline__ float lane_max16(float v) { v = fmaxf(v, lane_xor<1>(v)); v = fmaxf(v, lane_xor<2>(v)); v = fmaxf(v, lane_xor<4>(v)); return fmaxf(v, lane_xor<8>(v)); }
__device__ __forceinline__ float wave_max(float v) { v = lane_max16(v); v = fmaxf(v, lane_xor<16>(v)); return xor32_max(v); }
__device__ __forceinline__ unsigned q4(float a, float b, float c, float d, float inv) {
    const int qa = (int)rintf(a * inv), qb = (int)rintf(b * inv), qc = (int)rintf(c * inv), qd = (int)rintf(d * inv);
    return (unsigned)(qa & 255) | ((unsigned)(qb & 255) << 8) | ((unsigned)(qc & 255) << 16) | ((unsigned)(qd & 255) << 24);
}
struct StripDesc { const float* src; const float* gain; signed char* W8; float* wscale; int N, dr0; };
__device__ __forceinline__ void strip_issue(const Frame& F, const StripDesc& d, f32x4 (&wv)[16], float (&gk)[16]) {
    const int kk = F.tid >> 3, n4 = (F.tid & 7) * 4;
#pragma unroll
    for (int p = 0; p < 16; ++p) wv[p] = *(const f32x4*)(d.src + (size_t)(p * 64 + kk) * d.N + n4);
#pragma unroll
    for (int p = 0; p < 16; ++p) gk[p] = d.gain[p * 64 + kk];
}
__device__ __forceinline__ void strip_to_lds(const Frame& F, const f32x4 (&wv)[16], const float (&gk)[16]) {
    constexpr int SP = 1028; LAS float* st = (LAS float*)F.lds; const int kk = F.tid >> 3, n4 = (F.tid & 7) * 4;
#pragma unroll
    for (int p = 0; p < 16; ++p) { const int k = p * 64 + kk; const float g = gk[p];
        st[(n4 + 0) * SP + k] = wv[p].x * g; st[(n4 + 1) * SP + k] = wv[p].y * g; st[(n4 + 2) * SP + k] = wv[p].z * g; st[(n4 + 3) * SP + k] = wv[p].w * g; }
}
__device__ __forceinline__ void strip_quant(const Frame& F, const StripDesc& d) {
    constexpr int SP = 1028; LAS float* st = (LAS float*)F.lds;
    const int n = F.tid >> 4, cch = F.tid & 15; const LAS f32x4* row = (const LAS f32x4*)(st + n * SP + cch * 64);
    f32x4 v[16]; float mx = 0.f;
#pragma unroll
    for (int j = 0; j < 16; ++j) { v[j] = row[j]; mx = fmaxf(mx, fmaxf(fmaxf(fabsf(v[j].x), fabsf(v[j].y)), fmaxf(fabsf(v[j].z), fabsf(v[j].w)))); }
    mx = lane_max16(mx);
    const float sc = mx > 0.f ? mx * (1.f / 127.f) : 1.f, inv = 1.0f / sc; const int dr = d.dr0 + n;
    u32x4* dst = (u32x4*)(d.W8 + (size_t)dr * 1024 + cch * 64);
#pragma unroll
    for (int j = 0; j < 4; ++j) { u32x4 w; w.x = q4(v[4 * j].x, v[4 * j].y, v[4 * j].z, v[4 * j].w, inv); w.y = q4(v[4 * j + 1].x, v[4 * j + 1].y, v[4 * j + 1].z, v[4 * j + 1].w, inv);
        w.z = q4(v[4 * j + 2].x, v[4 * j + 2].y, v[4 * j + 2].z, v[4 * j + 2].w, inv); w.w = q4(v[4 * j + 3].x, v[4 * j + 3].y, v[4 * j + 3].z, v[4 * j + 3].w, inv); dst[j] = w; }
    if (cch == 0) d.wscale[dr] = sc;
}
template <class DescFn>
__device__ __forceinline__ void convert_strip_list(const Frame& F, int nstrips, DescFn desc) {
    int fs = F.bx; if (fs >= nstrips) return;
    StripDesc d = desc(fs); f32x4 wv[16]; float gk[16]; strip_issue(F, d, wv, gk);
#pragma nounroll
    for (;;) {
        strip_to_lds(F, wv, gk);
        __syncthreads();
        const int nx = fs + F.G; const bool more = nx < nstrips; StripDesc dn = d;
        if (more) { dn = desc(nx); strip_issue(F, dn, wv, gk); }
        strip_quant(F, d);
        __syncthreads();
        if (!more) break;
        d = dn; fs = nx;
    }
}
__device__ __forceinline__ float quant_regs_i8(const u32x2 (&xw)[4], signed char* qrow, int lane) {
    f32x4 v[4]; float mx = 0.f;
#pragma unroll
    for (int j = 0; j < 4; ++j) { const u32x2 w = xw[j]; v[j] = (f32x4){bf_lo(w.x), bf_hi(w.x), bf_lo(w.y), bf_hi(w.y)}; mx = fmaxf(mx, fmaxf(fmaxf(fabsf(v[j].x), fabsf(v[j].y)), fmaxf(fabsf(v[j].z), fabsf(v[j].w)))); }
    mx = wave_max(mx);
    const float sc = mx > 0.f ? mx * (1.f / 127.f) : 1.f, inv = 1.0f / sc;
    unsigned* q = (unsigned*)qrow + lane;
#pragma unroll
    for (int j = 0; j < 4; ++j) q[64 * j] = q4(v[j].x, v[j].y, v[j].z, v[j].w, inv);
    return sc;
}
__device__ __forceinline__ void load_row4(u32x2 (&xw)[4], const bf16_t* xrow, int lane) { const u32x2* xr = (const u32x2*)xrow + lane;
#pragma unroll
    for (int j = 0; j < 4; ++j) xw[j] = xr[64 * j]; }
__device__ __forceinline__ void quant_pass(const Frame& F, const bf16_t* xb, const float* sq, signed char* xq, float* rowsc) {
    const int gw = F.bx * NWAVES + F.wave, NGW = F.G * NWAVES;
    if (gw >= T) return;
#define QP_LOAD(XW, SP, m0_) do { _Pragma("unroll") for (int i = 0; i < 4; ++i) { const int m_ = (m0_) + i * NGW, mm_ = m_ < T ? m_ : gw; load_row4(XW[i], xb + (size_t)mm_ * D, F.lane); SP[i] = *(const f32x4*)(sq + (size_t)mm_ * 4); } } while (0)
#define QP_DO(XW, SP, m0_) do { _Pragma("unroll") for (int i = 0; i < 4; ++i) { const int m_ = (m0_) + i * NGW; if (m_ < T) { const float sc_ = quant_regs_i8(XW[i], xq + (size_t)m_ * D, F.lane); \
            if (F.lane == 0) rowsc[m_] = sc_ / sqrtf(((SP[i].x + SP[i].y) + (SP[i].z + SP[i].w)) * (1.f / 1024.f) + EPS); } } } while (0)
    u32x2 xa[4][4], xb2[4][4]; f32x4 spa[4], spb[4];
    int m0 = gw; const int step = 4 * NGW;
    QP_LOAD(xa, spa, m0);
    for (;;) {
        QP_LOAD(xb2, spb, m0 + step);
        QP_DO(xa, spa, m0);
        m0 += step; if (m0 >= T) break;
        QP_LOAD(xa, spa, m0 + step);
        QP_DO(xb2, spb, m0);
        m0 += step; if (m0 >= T) break;
    }
#undef QP_LOAD
#undef QP_DO
}
__device__ __forceinline__ void moe_gather(const Frame& F0, int c, int nbtot, const LAS int* meta, const int* mlist, const bf16_t* xb, const float* ssq, float* srow, char* proj) {
    const LAS int* pblk = meta + 8; const int gw = F0.bx * NWAVES + F0.wave, NGW = F0.G * NWAVES;
    const int r0 = c * CHUNK_BLK * 256, r1 = min((c + 1) * CHUNK_BLK * 256, nbtot * 256); signed char* dst0 = (signed char*)(proj + PJ_GB + (size_t)(c & 1) * GB_BUF);
    for (int rb = r0 + gw; rb < r1; rb += 8 * NGW) {
        int tokj = -1; int ln_ = F0.lane; asm volatile("" : "+v"(ln_)); Frame F = F0; F.lane = ln_;
        { const int r = rb + (F.lane & 7) * NGW; if (F.lane < 8 && r < r1) { const int blk = r >> 8, e = expert_of_blk(pblk, blk), pos = r - pblk[e] * 256; if (pos < meta[e]) tokj = mlist[(size_t)e * T + pos]; } }
#pragma unroll
        for (int h4 = 0; h4 < 2; ++h4) {
            u32x2 xw[4][4]; int tk[4]; f32x4 sp[4];
#pragma unroll
            for (int i = 0; i < 4; ++i) { tk[i] = __builtin_amdgcn_readlane(tokj, h4 * 4 + i); if (tk[i] >= 0) { load_row4(xw[i], xb + (size_t)tk[i] * D, F.lane); sp[i] = *(const f32x4*)(ssq + (size_t)tk[i] * 4); } }
#pragma unroll
            for (int i = 0; i < 4; ++i) { const int j = h4 * 4 + i, r = rb + j * NGW; if (r < r1) { signed char* d = dst0 + (size_t)(r - r0) * D;
                if (tk[i] >= 0) { const float sc = quant_regs_i8(xw[i], d, F.lane); if (F.lane == 0) srow[r] = sc / sqrtf(((sp[i].x + sp[i].y) + (sp[i].z + sp[i].w)) * (1.f / 1024.f) + EPS); }
                else { unsigned* q = (unsigned*)d + F.lane;
#pragma unroll
                    for (int jj = 0; jj < 4; ++jj) q[64 * jj] = 0u;
                    if (F.lane == 0) srow[r] = 0.f; } } }
        }
    }
}

template <class RowMap>
__device__ __forceinline__ void convert_job_f8(const Frame& F, const float* W, int K, int N, unsigned char* WT, const RowMap& rm) {
    LAS float* scr = (LAS float*)(F.lds + F.wave * 8448);
    const int gw = F.bx * NWAVES + F.wave, NGW = F.G * NWAVES, nitems = (K / 64) * (N / 32);
    int ln = F.lane; asm volatile("" : "+v"(ln));
#pragma nounroll
    for (int it = gw; it < nitems; it += NGW) transpose_item_f8(W, K, N, WT, rm, scr, it, ln);
}
template <class RowMap>
__device__ __forceinline__ void convert_job(const Frame& F, const float* W, int K, int N, bf16_t* WT, const RowMap& rm) {
    LAS float* scr = (LAS float*)(F.lds + F.wave * 8448);
    const int gw = F.bx * NWAVES + F.wave, NGW = F.G * NWAVES, nitems = (K / 64) * (N / 32);
    int ln = F.lane; asm volatile("" : "+v"(ln));
#pragma nounroll
    for (int it = gw; it < nitems; it += NGW) transpose_item(W, K, N, WT, rm, scr, it, ln);
}

constexpr int PH_PRO0 = 0, PH_PRO1 = 1, PH_L0 = 2, NPL = 9, N_PHASES = PH_L0 + DEPTH * NPL;
#ifndef PROBE_DUP
#define PROBE_DUP 0
#endif
typedef const Params __attribute__((address_space(4))) CParams;
__device__ __forceinline__ CParams* get_params() { CParams* p = (CParams*)__builtin_amdgcn_kernarg_segment_ptr(); asm volatile("" : "+s"(p)); return p; }
#define PIN(i) ((const float*)pp->in[i])

__global__ void __launch_bounds__(NTHR, 2) fwd_kernel(Params P_unused) {
    extern __shared__ __attribute__((aligned(16))) unsigned char lds_raw[];
    Frame F; F.lds = (LAS unsigned char*)lds_raw; F.tid = threadIdx.x; F.lane = F.tid & 63; F.wave = __builtin_amdgcn_readfirstlane(F.tid >> 6); F.G = gridDim.x; F.bx = blockIdx.x;
#define PHASE_FRAME Frame F; { int t_ = threadIdx.x; asm volatile("" : "+v"(t_)); F.lds = (LAS unsigned char*)lds_raw; F.tid = t_; F.lane = t_ & 63; F.wave = __builtin_amdgcn_readfirstlane(t_ >> 6); F.G = gridDim.x; int b_ = blockIdx.x; asm volatile("" : "+s"(b_)); F.bx = b_; }
    volatile LAS unsigned* MISC = (volatile LAS unsigned*)(F.lds + MISC_OFF);
    LAS int* meta = (LAS int*)(F.lds + MISC_OFF + 64);
    LAS int* lcnt = (LAS int*)(F.lds + MISC_OFF + 256);
    for (int u = F.tid; u < 1024; u += NTHR) ((LAS unsigned*)(F.lds + MISC_OFF))[u] = 0u;
    __syncthreads();
    XcdBarrier bar;
    { CParams* pp = get_params(); bar = xcd_barrier_post((unsigned*)(pp->ws + WS_CTL) + CW_BAR, MISC); }
#define IN(k) true
#define SEAM(k) do { if ((k) + 1 < N_PHASES) xcd_barrier(bar); } while (0)
#define GWS const int gw = F.bx * NWAVES + F.wave, NGW = F.G * NWAVES

    if (IN(PH_PRO0)) {
        PHASE_FRAME; CParams* pp = get_params(); unsigned char* ws = pp->ws; GWS;
#pragma nounroll
        for (int rep = 0; rep < ((PROBE_DUP >> 8) & 1) + 1; ++rep) {
        convert_strip_list(F, 4 * 72 + 4 * 112, [&](int fs) -> StripDesc {
            if (fs < 288) { const int l = fs / 72, st = fs - l * 72;
                return StripDesc{PIN(I_W_IN) + (size_t)l * D * 2304 + st * 32, PIN(I_NORM_MIX) + l * D, (signed char*)(ws + WS_WIN) + (size_t)l * 2304 * D, (float*)(ws + WS_WSC + SC_WIN) + l * 2304, 2304, st * 32}; }
            const int r = fs - 288, up = r / 224, r2 = r - up * 224, i = r2 / 112, st = r2 - i * 112, n0 = st * 32;
            return StripDesc{(up ? PIN(I_DUP) : PIN(I_DGATE)) + (size_t)i * D * FF + n0, PIN(I_NORM_FFN) + (2 * i) * D, (signed char*)(ws + WS_WGU) + (size_t)i * 7168 * D, (float*)(ws + WS_WSC + SC_WD) + i * 7168, FF,
                             (n0 >> 7) * 256 + 128 * up + (n0 & 127)}; });
        __syncthreads();
#pragma nounroll
        for (int l = 0; l < DEPTH; ++l) {
            convert_job(F, PIN(I_W_OUT) + (size_t)l * D * D, D, D, (bf16_t*)(ws + WS_WOUT) + (size_t)l * D * D, RowIdent{});
            convert_job(F, PIN(I_XWQ) + (size_t)l * D * 512, D, 512, (bf16_t*)(ws + WS_WQ) + (size_t)l * 512 * D, RowIdent{PIN(I_NORM_XATTN) + l * D});
            convert_job(F, PIN(I_XWKV) + (size_t)l * D * 1024, D, 1024, (bf16_t*)(ws + WS_WKV) + (size_t)l * 1024 * D, RowIdent{});
            convert_job(F, PIN(I_XWO) + (size_t)l * 512 * D, 512, D, (bf16_t*)(ws + WS_WO) + (size_t)l * D * 512, RowIdent{});
        }
#pragma nounroll
        for (int i = 0; i < 2; ++i) convert_job_f8(F, PIN(I_DDOWN) + (size_t)i * FF * D, FF, D, (unsigned char*)(ws + WS_WDN) + (size_t)i * D * FF, RowIdent{});
        for (int m0 = gw; m0 < NB * NMEM; m0 += 4 * NGW) {
            f32x4 v[4][4];
#pragma unroll
            for (int u4 = 0; u4 < 4; ++u4) { const int m = m0 + u4 * NGW; const f32x4* xr = (const f32x4*)(PIN(I_MEM) + (size_t)(m < NB * NMEM ? m : gw) * D) + F.lane;
#pragma unroll
                for (int j = 0; j < 4; ++j) v[u4][j] = xr[64 * j]; }
#pragma unroll
            for (int u4 = 0; u4 < 4; ++u4) { const int m = m0 + u4 * NGW; if (m >= NB * NMEM) continue; float sm = 0.f;
#pragma unroll
                for (int j = 0; j < 4; ++j) sm += (v[u4][j].x * v[u4][j].x + v[u4][j].y * v[u4][j].y) + (v[u4][j].z * v[u4][j].z + v[u4][j].w * v[u4][j].w);
                const float rs = 1.0f / sqrtf(wave_sum(sm) * (1.f / D) + EPS);
#pragma nounroll
                for (int l = 0; l < DEPTH; ++l) { u32x2* o8 = (u32x2*)((bf16_t*)(ws + WS_PROJ + PJ_HM) + ((size_t)l * 8192 + m) * D) + F.lane;
#pragma unroll
                    for (int j = 0; j < 4; ++j) { const f32x4 g = ((const f32x4*)(PIN(I_NORM_MEM) + l * D))[64 * j + F.lane]; const f32x4 y = v[u4][j] * rs * g; u32x2 w; w.x = cvt_pk_bf16(y.x, y.y); w.y = cvt_pk_bf16(y.z, y.w); o8[64 * j] = w; } } }
        }
        { const float* x = PIN(I_X); bf16_t* xb = (bf16_t*)(ws + WS_XB); float* sq = ssq_slot(ws, 0); signed char* xq = (signed char*)(ws + WS_XQW); float* roww = (float*)(ws + WS_WSC + SC_ROWW);
          for (int m = gw; m < T; m += NGW) { const f32x4* xr = (const f32x4*)(x + (size_t)m * D) + F.lane; u32x2* o8 = (u32x2*)(xb + (size_t)m * D) + F.lane; float q = 0.f, mx = 0.f; f32x4 xv[4];
#pragma unroll
              for (int j = 0; j < 4; ++j) { xv[j] = xr[64 * j]; q += (xv[j].x * xv[j].x + xv[j].y * xv[j].y) + (xv[j].z * xv[j].z + xv[j].w * xv[j].w); mx = fmaxf(mx, fmaxf(fmaxf(fabsf(xv[j].x), fabsf(xv[j].y)), fmaxf(fabsf(xv[j].z), fabsf(xv[j].w))));
                  u32x2 w; w.x = cvt_pk_bf16(xv[j].x, xv[j].y); w.y = cvt_pk_bf16(xv[j].z, xv[j].w); o8[64 * j] = w; }
              q = wave_sum(q); mx = wave_max(mx); const float sc = mx > 0.f ? mx * (1.f / 127.f) : 1.f, inv = 1.0f / sc; unsigned* q8 = (unsigned*)(xq + (size_t)m * D) + F.lane;
#pragma unroll
              for (int j = 0; j < 4; ++j) q8[64 * j] = q4(xv[j].x, xv[j].y, xv[j].z, xv[j].w, inv);
              if (F.lane == 0) { *(f32x4*)(sq + (size_t)m * 4) = (f32x4){q, 0.f, 0.f, 0.f}; roww[m] = sc / sqrtf(q * (1.f / 1024.f) + EPS); } } }
        }
        SEAM(PH_PRO0);
    }
    if (IN(PH_PRO1)) {
        PHASE_FRAME; CParams* pp = get_params(); unsigned char* ws = pp->ws;
        SchedKV S{F.G, F.bx, ws};
        pg8::gemm_phase(F.lds, 2048, S, pg8::EpiStoreBf16{});
        SEAM(PH_PRO1);
    }

#pragma nounroll
    for (int l = 0; l < DEPTH; ++l) {
        const int pb = PH_L0 + l * NPL;
        const bool moe = (l & 1) != 0; const int fi = l >> 1;
        if (IN(pb + 0)) {
            if (l == 0) {
                PHASE_FRAME; CParams* pp = get_params(); unsigned char* ws = pp->ws; GWS;
                for (int rr0 = gw; rr0 < DEPTH * 8192; rr0 += 8 * NGW) { bf16x8 kraw8[8];
#pragma unroll
                  for (int u8 = 0; u8 < 8; ++u8) { const int rr = rr0 + u8 * NGW; kraw8[u8] = *(const bf16x8*)((const bf16_t*)(ws + WS_YS) + (size_t)(rr < DEPTH * 8192 ? rr : gw) * 512 + 8 * F.lane); }
#pragma unroll
                  for (int u8 = 0; u8 < 8; ++u8) { const int rr = rr0 + u8 * NGW; if (rr >= DEPTH * 8192) continue; const int ll = rr >> 13;
                    float kv[8]; unpack8(kraw8[u8], kv);
                    float ss = 0.f;
#pragma unroll
                    for (int j = 0; j < 8; ++j) ss += kv[j] * kv[j];
                    ss += lane_xor<1>(ss); ss += lane_xor<2>(ss); ss += lane_xor<4>(ss); ss += lane_xor<8>(ss);
                    const float rs = 1.0f / sqrtf(ss * (1.f / 128.f) + EPS);
                    const float* kg = PIN(I_XK_GAIN) + ll * 128 + 8 * (F.lane & 15);
#pragma unroll
                    for (int j = 0; j < 8; ++j) kv[j] = kv[j] * rs * kg[j];
                    *(bf16x8*)((bf16_t*)(ws + WS_KN) + (size_t)rr * 512 + 8 * F.lane) = pack8(kv); } }
            }
            if (l & 1) {
                PHASE_FRAME; CParams* pp = get_params(); unsigned char* ws = pp->ws; GWS; const bf16_t* xb = (const bf16_t*)(ws + WS_XB); const float* sq = ssq_slot(ws, 3 * l);
                signed char* xq = (signed char*)(ws + WS_XQW); float* roww = (float*)(ws + WS_WSC + SC_ROWW);
                quant_pass(F, xb, sq, xq, roww);
                xcd_barrier(bar);
            }
            PHASE_FRAME; CParams* pp = get_params(); unsigned char* ws = pp->ws;
            SchedWin S{F.G, F.bx, l, ws};
            pg8::gemm_phase(F.lds, 1024, S, pg8::EpiStoreI8{});
            SEAM(pb + 0);
        }
        if (IN(pb + 1)) {
            PHASE_FRAME; CParams* pp = get_params(); unsigned char* ws = pp->ws; char* proj = (char*)(ws + WS_PROJ); bf16_t* mixed = (bf16_t*)(ws + WS_YS);
            if (F.wave >= 4) __builtin_amdgcn_s_setprio(1);
            LAS float* bias = (LAS float*)(F.lds + SW_END); LAS float* part = (LAS float*)(F.lds + SW_END + 4096);
            LAS float* cst = (LAS float*)(F.lds + SW_END + 4096 + 2048);
            for (int i = F.tid; i < 1024; i += NTHR) { const int h = i >> 7, d = i & 127; bias[i] = PIN(I_REL_BIAS)[T5B[d] * 8 + h] * 1.4426950408889634f; }
            for (int i = F.tid; i < 1160; i += NTHR) cst[i] = (i < 512) ? PIN(I_SB_OUT_GAIN)[l * 512 + i] : (i < 1024) ? PIN(I_SWA_OUT_GAIN)[l * 512 + i - 512] : (i < 1088) ? PIN(I_SWA_Q_GAIN)[l * 64 + i - 1024] : (i < 1152) ? PIN(I_SWA_K_GAIN)[l * 64 + i - 1088] : PIN(I_SWA_SINKS)[l * 8 + i - 1152];
            __syncthreads();
#pragma nounroll
            for (int rep = 0; rep < ((PROBE_DUP >> 1) & 3 ? 2 : 1); ++rep)
#pragma nounroll
            for (int u = F.bx + ((rep == 1 && ((PROBE_DUP >> 2) & 1)) ? 1024 : 0); u < ((rep == 1 && ((PROBE_DUP >> 1) & 3) == 1) ? 1024 : 2048); u += F.G) {
                const int uu = u & 1023, b = uu >> 5, tq = uu & 31;
                if (u < 1024) sb_unit(F, b, tq, (const bf16_t*)(proj + PJ_SBQ), (const bf16_t*)(proj + PJ_SBK), (const bf16_t*)(proj + PJ_SBVT), cst, mixed, part, F.lds);
                else swa_unit(F, b, tq, (const bf16_t*)(proj + PJ_SWQ), (const bf16_t*)(proj + PJ_SWKV), cst + 1024, cst + 1088, cst + 1152, cst + 512, mixed, F.lds, bias, part);
            }
            __builtin_amdgcn_s_setprio(0);
            SEAM(pb + 1);
        }
        if (IN(pb + 2)) {
            PHASE_FRAME; CParams* pp = get_params(); unsigned char* ws = pp->ws;
            SchedRes S{F.G, F.bx, l, 0, ws};
            pg8::gemm_phase(F.lds, 2048, S, pg8::EpiResid{});
            SEAM(pb + 2);
        }
        if (IN(pb + 3)) {
            PHASE_FRAME; CParams* pp = get_params(); unsigned char* ws = pp->ws;
            SchedWq S{F.G, F.bx, l, ws};
            pg8::gemm_phase(F.lds, 2048, S, pg8::EpiStoreBf16{});
            SEAM(pb + 3);
        }
        if (IN(pb + 4)) {
            PHASE_FRAME; CParams* pp = get_params(); unsigned char* ws = pp->ws;
            if (F.wave >= 4) __builtin_amdgcn_s_setprio(1);
            LAS float* qg = (LAS float*)(F.lds + pg8::XL_OFF);
            if (F.tid < 128) qg[F.tid] = PIN(I_XQ_GAIN)[l * 128 + F.tid];
            __syncthreads();
#pragma nounroll
            for (int rep = 0; rep < ((PROBE_DUP >> 4) & 1) + 1; ++rep)
#pragma nounroll
            for (int hu = F.bx; hu < 256; hu += F.G) {
                const int p = hu >> 1;
                __syncthreads();
                xattn_stage(F, p >> 2, p & 3, (const bf16_t*)(ws + WS_KN) + (size_t)l * 8192 * 512, (const bf16_t*)(ws + WS_VT) + (size_t)l * 8192 * 512, F.lds);
                __syncthreads();
#pragma nounroll
                for (int i = 0; i < 4; ++i) xattn_tile(F, p >> 2, p & 3, 4 * (hu & 1) + i, (const bf16_t*)(ws + WS_PROJ + PJ_XQ), qg, (bf16_t*)(ws + WS_PROJ + PJ_XO), F.lds);
            }
            __builtin_amdgcn_s_setprio(0);
            SEAM(pb + 4);
        }
        if (IN(pb + 5)) {
            PHASE_FRAME; CParams* pp = get_params(); unsigned char* ws = pp->ws;
            SchedRes S{F.G, F.bx, l, 1, ws};
            pg8::gemm_phase(F.lds, 1024, S, pg8::EpiResid{});
            SEAM(pb + 5);
        }
        if (IN(pb + 6) && moe) {
            PHASE_FRAME; CParams* pp = get_params(); unsigned char* ws = pp->ws; const bf16_t* xb = (const bf16_t*)(ws + WS_XB); const float* sq = ssq_slot(ws, 3 * l + 2);
            unsigned* gcnt = (unsigned*)(ws + WS_CTL) + CW_CNT + fi * 8 * 64;
            int* mlist = (int*)(ws + WS_MOE + MO_LIST); int4* minfo = (int4*)(ws + WS_MOE + MO_INFO); float2* mgate = (float2*)(ws + WS_MOE + MO_GATE);
            const float* rw = PIN(I_ROUTER_W) + (size_t)fi * D * NE; const float* rb = PIN(I_ROUTER_B) + fi * NE; const float* gn = PIN(I_NORM_FFN) + l * D;
            LAS float* rwl = (LAS float*)(F.lds + 70 * 1024);
            for (int i = F.tid; i < D * NE; i += NTHR) rwl[i] = rw[i] * gn[i >> 3];
            float rbv[8];
#pragma unroll
            for (int e = 0; e < 8; ++e) rbv[e] = rb[e];
#pragma nounroll
            for (int grp = F.bx; grp < T / 256; grp += F.G) {
                if (F.tid < 8) lcnt[F.tid] = 0;
                __syncthreads();
                int me1 = 0, me2 = 0; float mg1 = 0.f, mg2 = 0.f;
                u32x2 xnext[4]; f32x4 sqnext;
                { const int m0 = grp * 256 + F.wave * 32; load_row4(xnext, xb + (size_t)m0 * D, F.lane); sqnext = *(const f32x4*)(sq + (size_t)m0 * 4); }
#pragma nounroll
                for (int i = 0; i < 32; ++i) {
                    const int m = grp * 256 + F.wave * 32 + i;
                    const int ln = F.lane;
                    u32x2 xcur[4];
#pragma unroll
                    for (int j = 0; j < 4; ++j) xcur[j] = xnext[j];
                    const float rs = 1.0f / sqrtf(((sqnext.x + sqnext.y) + (sqnext.z + sqnext.w)) * (1.f / 1024.f) + EPS);
                    if (i < 31) { load_row4(xnext, xb + (size_t)(m + 1) * D, ln); sqnext = *(const f32x4*)(sq + (size_t)(m + 1) * 4); }
                    float lg[8]; typedef float f32x2_ __attribute__((ext_vector_type(2)));
                    f32x2_ l2[4] = {{0.f, 0.f}, {0.f, 0.f}, {0.f, 0.f}, {0.f, 0.f}};
#pragma unroll
                    for (int j = 0; j < 4; ++j) { const u32x2 xw = xcur[j]; const f32x4 xv = {bf_lo(xw.x), bf_hi(xw.x), bf_lo(xw.y), bf_hi(xw.y)};
#pragma unroll
                        for (int cc = 0; cc < 4; ++cc) { const LAS float* wr_ = rwl + (256 * j + 4 * ln + cc) * 8; const f32x4 w0 = *(const LAS f32x4*)wr_, w1 = *(const LAS f32x4*)(wr_ + 4); const f32x2_ hv = {xv[cc], xv[cc]};
                            l2[0] = hv * (f32x2_){w0.x, w0.y} + l2[0]; l2[1] = hv * (f32x2_){w0.z, w0.w} + l2[1]; l2[2] = hv * (f32x2_){w1.x, w1.y} + l2[2]; l2[3] = hv * (f32x2_){w1.z, w1.w} + l2[3]; } }
#pragma unroll
                    for (int e = 0; e < 4; ++e) { lg[2 * e] = l2[e].x; lg[2 * e + 1] = l2[e].y; }
#pragma unroll
                    for (int e = 0; e < 8; ++e) lg[e] = wave_sum(lg[e]) * rs + rbv[e];
                    int e1 = 0; float v1 = lg[0];
#pragma unroll
                    for (int e = 1; e < 8; ++e) if (lg[e] > v1) { v1 = lg[e]; e1 = e; }
                    int e2 = -1; float v2 = -INFINITY;
#pragma unroll
                    for (int e = 0; e < 8; ++e) if (e != e1 && lg[e] > v2) { v2 = lg[e]; e2 = e; }
                    const float ex = __expf(v2 - v1), den = 1.0f / (1.0f + ex);
                    if (F.lane == i) { me1 = e1; me2 = e2; mg1 = den; mg2 = ex * den; }
                }
                int p1 = 0, p2 = 0;
                if (F.lane < 32) { p1 = __hip_atomic_fetch_add(&lcnt[me1], 1, __ATOMIC_RELAXED, __HIP_MEMORY_SCOPE_WORKGROUP); p2 = __hip_atomic_fetch_add(&lcnt[me2], 1, __ATOMIC_RELAXED, __HIP_MEMORY_SCOPE_WORKGROUP); }
                __syncthreads();
                if (F.tid < 8) lcnt[8 + F.tid] = (int)__hip_atomic_fetch_add(gcnt + 64 * F.tid, (unsigned)lcnt[F.tid], __ATOMIC_RELAXED, __HIP_MEMORY_SCOPE_AGENT);
                __syncthreads();
                if (F.lane < 32) { const int tok = grp * 256 + F.wave * 32 + F.lane; const int q1 = lcnt[8 + me1] + p1, q2 = lcnt[8 + me2] + p2;
                    mlist[(size_t)me1 * T + q1] = tok; mlist[(size_t)me2 * T + q2] = tok; minfo[tok] = make_int4(me1 | (me2 << 8), q1, q2, 0); mgate[tok] = make_float2(mg1, mg2); }
                __syncthreads();
            }
            __syncthreads();
#pragma nounroll
            for (int rep = 0; rep < ((PROBE_DUP >> 5) & 1) + 1; ++rep) {
                convert_strip_list(F, NE * 224, [&](int fs) -> StripDesc {
                    const int e = fs / 224, r = fs - e * 224, up = r / 112, st = r - up * 112, n0 = st * 32; const size_t eo = ((size_t)fi * NE + e) * D * FF;
                    return StripDesc{(up ? PIN(I_EUP) : PIN(I_EGATE)) + eo + n0, gn, (signed char*)(ws + WS_EGU) + (size_t)e * 7168 * D, (float*)(ws + WS_WSC + SC_WE) + e * 7168, FF, (n0 >> 7) * 256 + 128 * up + (n0 & 127)}; });
                __syncthreads();
#pragma nounroll
                for (int e = 0; e < NE; ++e) convert_job_f8(F, PIN(I_EDOWN) + ((size_t)fi * NE + e) * D * FF, FF, D, (unsigned char*)(ws + WS_EDN) + (size_t)e * D * FF, RowIdent{});
            }
            SEAM(pb + 6);
        }
        if (IN(pb + 6) && !moe) {
            PHASE_FRAME; CParams* pp = get_params(); unsigned char* ws = pp->ws; GWS; const bf16_t* xb = (const bf16_t*)(ws + WS_XB); const float* sq = ssq_slot(ws, 3 * l + 2);
            signed char* xq = (signed char*)(ws + WS_PROJ + PJ_XQ8); float* rowsc = (float*)(ws + WS_WSC + SC_ROW);
            quant_pass(F, xb, sq, xq, rowsc);
            SEAM(pb + 6);
        }
        if (IN(pb + 7)) {
            if (!moe) {
                constexpr int NCH = 256 / CHUNK_BLK;
#pragma nounroll
                for (int c = 0; c <= NCH; ++c) {
                    if (c > 0) { PHASE_FRAME; CParams* pp = get_params(); unsigned char* ws = pp->ws;
                      SchedDown S{F.G, F.bx, CHUNK_BLK, c - 1, l, ws, nullptr};
                      pg8::gemm_phase(F.lds, FF, S, pg8::EpiResidT<2>{}); }
                    if (c < NCH) { PHASE_FRAME; CParams* pp = get_params(); unsigned char* ws = pp->ws;
                      SchedGU S{F.G, F.bx, CHUNK_BLK, c, l, ws, nullptr};
                      pg8::gemm_phase(F.lds, 1024, S, pg8::EpiSwiGLU8{});
                      xcd_barrier(bar); }
                }
            } else {
                { PHASE_FRAME; CParams* pp = get_params(); unsigned char* ws = pp->ws; moe_meta(F, (unsigned*)(ws + WS_CTL) + CW_CNT + fi * 8 * 64, meta);
                  moe_gather(F, 0, meta[16], meta, (const int*)(ws + WS_MOE + MO_LIST), (const bf16_t*)(ws + WS_XB), ssq_slot(ws, 3 * l + 2), (float*)(ws + WS_WSC + SC_SROW), (char*)(ws + WS_PROJ)); }
                const LAS int* pblk = meta + 8; const int nbtot = meta[16], nchunk = (nbtot + CHUNK_BLK - 1) / CHUNK_BLK;
                xcd_barrier(bar);
#pragma nounroll
                for (int c = 0; c <= nchunk; ++c) {
                    if (c > 0) { PHASE_FRAME; CParams* pp = get_params(); unsigned char* ws = pp->ws;
                      SchedDown S{F.G, F.bx, min(CHUNK_BLK, nbtot - CHUNK_BLK * (c - 1)), c - 1, l, ws, pblk};
                      pg8::gemm_phase(F.lds, FF, S, pg8::EpiStoreBf16T<2>{});
                      if ((PROBE_DUP >> 7) & 1) pg8::gemm_phase(F.lds, FF, S, pg8::EpiStoreBf16T<2>{}); }
                    if (c < nchunk) { PHASE_FRAME; CParams* pp = get_params(); unsigned char* ws = pp->ws;
                      SchedGU S{F.G, F.bx, min(CHUNK_BLK, nbtot - CHUNK_BLK * c), c, l, ws, pblk};
                      pg8::gemm_phase(F.lds, 1024, S, pg8::EpiSwiGLU8{});
                      if ((PROBE_DUP >> 6) & 1) pg8::gemm_phase(F.lds, 1024, S, pg8::EpiSwiGLU8{});
                      if (c + 1 < nchunk) moe_gather(F, c + 1, nbtot, meta, (const int*)(ws + WS_MOE + MO_LIST), (const bf16_t*)(ws + WS_XB), ssq_slot(ws, 3 * l + 2), (float*)(ws + WS_WSC + SC_SROW), (char*)(ws + WS_PROJ));
                      xcd_barrier(bar); }
                }
            }
            SEAM(pb + 7);
        }
        if (IN(pb + 8) && moe) {
            PHASE_FRAME; CParams* pp = get_params(); unsigned char* ws = pp->ws; GWS; float* xo = pp->out; bf16_t* xb = (bf16_t*)(ws + WS_XB); float* sq = ssq_slot(ws, 3 * l + 3); const bool lastl = (l == DEPTH - 1);
            const int4* minfo = (const int4*)(ws + WS_MOE + MO_INFO); const float2* mgate = (const float2*)(ws + WS_MOE + MO_GATE);
            moe_meta(F, (unsigned*)(ws + WS_CTL) + CW_CNT + fi * 8 * 64, meta);
            const LAS int* pblk = meta + 8; const bf16_t* ys = (const bf16_t*)(ws + WS_YS);
            struct Rec { unsigned r1, r2; float g1, g2; };
#define CB_REC(R, mb_) do { R.r1 = 0u; R.r2 = 0u; R.g1 = 0.f; R.g2 = 0.f; if (F.lane < 8) { int mj_ = (mb_) + F.lane * NGW; mj_ = mj_ < T ? mj_ : gw; const int4 inf = minfo[mj_]; const float2 gt = mgate[mj_]; const int e1 = inf.x & 255, e2 = inf.x >> 8; \
                R.r1 = (unsigned)(pblk[e1] * 256 + inf.y); R.r2 = (unsigned)(pblk[e2] * 256 + inf.z); R.g1 = gt.x; R.g2 = gt.y; } } while (0)
#define CB_LOAD(XW, YA, YB, GA, GB, R, mb_, sub_) do { _Pragma("unroll") for (int i = 0; i < 2; ++i) { const int j = (sub_) * 2 + i; int m_ = (mb_) + j * NGW; m_ = m_ < T ? m_ : gw; \
                const size_t r1 = (size_t)(unsigned)__builtin_amdgcn_readlane((int)R.r1, j), r2 = (size_t)(unsigned)__builtin_amdgcn_readlane((int)R.r2, j); \
                GA[i] = __builtin_bit_cast(float, __builtin_amdgcn_readlane(__builtin_bit_cast(int, R.g1), j)); GB[i] = __builtin_bit_cast(float, __builtin_amdgcn_readlane(__builtin_bit_cast(int, R.g2), j)); \
                load_row4(XW[i], xb + (size_t)m_ * D, F.lane); load_row4(YA[i], ys + r1 * D, F.lane); load_row4(YB[i], ys + r2 * D, F.lane); } } while (0)
#define CB_PROC(XW, YA, YB, GA, GB, mb_, sub_) do { _Pragma("unroll") for (int i = 0; i < 2; ++i) { const int j = (sub_) * 2 + i, m = (mb_) + j * NGW; if (m < T) { \
                u32x2* xr = (u32x2*)(xb + (size_t)m * D) + F.lane; f32x4* o4 = (f32x4*)(xo + (size_t)m * D) + F.lane; float q = 0.f, mx = 0.f; f32x4 xs[4]; \
                _Pragma("unroll") for (int jj = 0; jj < 4; ++jj) { const u32x2 xw_ = XW[i][jj], a = YA[i][jj], bq = YB[i][jj]; f32x4 xv; \
                    xv.x = bf_lo(xw_.x) + GA[i] * bf_lo(a.x) + GB[i] * bf_lo(bq.x); xv.y = bf_hi(xw_.x) + GA[i] * bf_hi(a.x) + GB[i] * bf_hi(bq.x); xv.z = bf_lo(xw_.y) + GA[i] * bf_lo(a.y) + GB[i] * bf_lo(bq.y); xv.w = bf_hi(xw_.y) + GA[i] * bf_hi(a.y) + GB[i] * bf_hi(bq.y); \
                    xs[jj] = xv; \
                    if (lastl) o4[64 * jj] = xv; \
                    else { q += (xv.x * xv.x + xv.y * xv.y) + (xv.z * xv.z + xv.w * xv.w); mx = fmaxf(mx, fmaxf(fmaxf(fabsf(xv.x), fabsf(xv.y)), fmaxf(fabsf(xv.z), fabsf(xv.w)))); \
                        u32x2 w; w.x = cvt_pk_bf16(xv.x, xv.y); w.y = cvt_pk_bf16(xv.z, xv.w); xr[64 * jj] = w; } } \
                if (!lastl) { q = wave_sum(q); mx = wave_max(mx); const float sc = mx > 0.f ? mx * (1.f / 127.f) : 1.f, inv = 1.0f / sc; unsigned* q8 = (unsigned*)((signed char*)(ws + WS_XQW) + (size_t)m * D) + F.lane; \
                    _Pragma("unroll") for (int jj = 0; jj < 4; ++jj) q8[64 * jj] = q4(xs[jj].x, xs[jj].y, xs[jj].z, xs[jj].w, inv); \
                    if (F.lane == 0) { *(f32x4*)(sq + (size_t)m * 4) = (f32x4){q, 0.f, 0.f, 0.f}; ((float*)(ws + WS_WSC + SC_ROWW))[m] = sc / sqrtf(q * (1.f / 1024.f) + EPS); } } } } } while (0)
            if (gw < T) {
                u32x2 xwA[2][4], yaA[2][4], ybA[2][4], xwB[2][4], yaB[2][4], ybB[2][4]; float gaA[2], gbA[2], gaB[2], gbB[2];
                Rec R, Rn; int mb = gw; const int bstep = 8 * NGW;
                CB_REC(R, mb);
                CB_LOAD(xwA, yaA, ybA, gaA, gbA, R, mb, 0);
#pragma nounroll
                for (;;) {
                    CB_REC(Rn, mb + bstep);
                    CB_LOAD(xwB, yaB, ybB, gaB, gbB, R, mb, 1); CB_PROC(xwA, yaA, ybA, gaA, gbA, mb, 0);
                    CB_LOAD(xwA, yaA, ybA, gaA, gbA, R, mb, 2); CB_PROC(xwB, yaB, ybB, gaB, gbB, mb, 1);
                    CB_LOAD(xwB, yaB, ybB, gaB, gbB, R, mb, 3); CB_PROC(xwA, yaA, ybA, gaA, gbA, mb, 2);
                    CB_LOAD(xwA, yaA, ybA, gaA, gbA, Rn, mb + bstep, 0); CB_PROC(xwB, yaB, ybB, gaB, gbB, mb, 3);
                    mb += bstep; if (mb >= T) break;
                    R = Rn;
                }
            }
#undef CB_REC
#undef CB_LOAD
#undef CB_PROC
            SEAM(pb + 8);
        }
    }
#undef IN
#undef SEAM
#undef GWS
#undef PHASE_FRAME
}

extern "C" void kernel_launch(void* const* d_in, const int* in_sizes, int n_in, void* d_out, int out_size, void* d_ws, size_t ws_size, hipStream_t stream) {
    static int grid = 0;
    if (grid == 0) {
        if (n_in != 27 || in_sizes[0] != T * D || out_size != T * D || ws_size < WS_END) { fprintf(stderr, "kernel_launch: unexpected shapes (n_in %d, in0 %d, out %d, ws %zu < %zu)\n", n_in, n_in > 0 ? in_sizes[0] : -1, out_size, ws_size, (size_t)WS_END); grid = -1; return; }
        int dev = 0, cus = 0, per_cu = 0;
        if (hipGetDevice(&dev) != hipSuccess || hipDeviceGetAttribute(&cus, hipDeviceAttributeMultiprocessorCount, dev) != hipSuccess) { grid = -1; return; }
        if (hipFuncSetAttribute((const void*)fwd_kernel, hipFuncAttributeMaxDynamicSharedMemorySize, LDS_BYTES) != hipSuccess) { fprintf(stderr, "kernel_launch: hipFuncSetAttribute failed\n"); grid = -1; return; }
        if (hipOccupancyMaxActiveBlocksPerMultiprocessor(&per_cu, (const void*)fwd_kernel, NTHR, LDS_BYTES) != hipSuccess || per_cu < 1) { fprintf(stderr, "kernel_launch: occupancy query says %d blocks per CU\n", per_cu); }
        (void)hipGetLastError();
        grid = cus;
    }
    if (grid < 0) return;
    if (hipMemsetAsync((char*)d_ws + WS_CTL, 0, CTL_BYTES, stream) != hipSuccess) return;
    Params p{};
    for (int i = 0; i < 27; ++i) p.in[i] = (const float*)d_in[i];
    p.out = (float*)d_out; p.ws = (unsigned char*)d_ws; p.ph_lo = 0; p.ph_hi = N_PHASES;
    hipLaunchKernelGGL(fwd_kernel, dim3(grid), dim3(NTHR), LDS_BYTES, stream, p);
}
```

```cpp
#include <hip/hip_runtime.h>
#include <cstdio>
#include <cstdint>

#define GAS __attribute__((address_space(1)))
#define LAS __attribute__((address_space(3)))
typedef unsigned short bf16_t;
typedef short bf16x8 __attribute__((ext_vector_type(8)));
typedef float f32x4 __attribute__((ext_vector_type(4)));
typedef float f32x16 __attribute__((ext_vector_type(16)));
typedef unsigned u32x4 __attribute__((ext_vector_type(4)));
typedef unsigned u32x2 __attribute__((ext_vector_type(2)));
typedef int i32x4 __attribute__((ext_vector_type(4)));
typedef int i32x8 __attribute__((ext_vector_type(8)));

constexpr int D = 1024, NB = 32, SEQ = 2048, T = NB * SEQ, DEPTH = 4, FF = 3584, NE = 8, NMEM = 256;
constexpr float EPS = 1e-6f;
constexpr int NWAVES = 8, NTHR = 512;

constexpr size_t MiB = 1u << 20;
constexpr size_t WS_CTL = 0, CTL_BYTES = 1 * MiB;
constexpr size_t WS_WIN = 1 * MiB;
constexpr size_t WS_WOUT = 19 * MiB;
constexpr size_t WS_WQ = 27 * MiB;
constexpr size_t WS_WKV = 31 * MiB;
constexpr size_t WS_WO = 39 * MiB;
constexpr size_t WS_WGU = 43 * MiB;
constexpr size_t WS_WDN = 71 * MiB;
constexpr size_t WS_EGU = 85 * MiB;
constexpr size_t WS_EDN = 197 * MiB;
constexpr size_t WS_KN = 253 * MiB;
constexpr size_t WS_VT = 285 * MiB;
constexpr size_t WS_XB = 317 * MiB;
constexpr size_t WS_PROJ = 445 * MiB;
constexpr size_t WS_YS = 733 * MiB;
constexpr size_t WS_MOE = 993 * MiB;
constexpr size_t WS_SSQ = 1001 * MiB;
constexpr size_t WS_WSC = 1013 * MiB;
constexpr size_t WS_XQW = 1015 * MiB;
constexpr size_t WS_END = 1079 * MiB;
constexpr size_t SC_WD = 0, SC_WE = 64 * 1024, SC_ROW = 512 * 1024, SC_SROW = 1024 * 1024, SC_ROWW = 1568 * 1024, SC_WIN = 1856 * 1024;
constexpr size_t PJ_SBQ = 0, PJ_SBK = 64 * MiB, PJ_SBVT = 128 * MiB, PJ_SWQ = 192 * MiB, PJ_SWKV = 256 * MiB;
constexpr size_t PJ_XQ = 0, PJ_XO = 64 * MiB;
constexpr size_t PJ_H = 0;
constexpr size_t PJ_GB = 224 * MiB;
constexpr size_t PJ_XQ8 = 224 * MiB;
constexpr size_t PJ_HM = 0;
constexpr size_t MO_LIST = 0;
constexpr size_t MO_INFO = 2 * MiB;
constexpr size_t MO_GATE = 3 * MiB;
constexpr int CHUNK_BLK = 128;
constexpr size_t H_BUF = (size_t)CHUNK_BLK * 256 * FF, GB_BUF = (size_t)CHUNK_BLK * 256 * 1024;
constexpr int CW_BAR = 1024;
constexpr int CW_CNT = 8192;

__device__ __forceinline__ unsigned cvt_pk_bf16(float lo, float hi) { unsigned r; asm volatile("v_cvt_pk_bf16_f32 %0, %1, %2" : "=v"(r) : "v"(lo), "v"(hi)); return r; }
__device__ __forceinline__ float bf_lo(unsigned w) { return __uint_as_float(w << 16); }
__device__ __forceinline__ float bf_hi(unsigned w) { return __uint_as_float(w & 0xffff0000u); }
template <int K> __device__ __forceinline__ float lane_xor(float v) { return __int_as_float(__builtin_amdgcn_ds_swizzle(__float_as_int(v), (K << 10) | 0x1F)); }
__device__ __forceinline__ float xor32_add(float v) { const auto rr = __builtin_amdgcn_permlane32_swap(__float_as_uint(v), __float_as_uint(v), false, false); return __uint_as_float(rr[0]) + __uint_as_float(rr[1]); }
__device__ __forceinline__ float xor32_max(float v) { const auto rr = __builtin_amdgcn_permlane32_swap(__float_as_uint(v), __float_as_uint(v), false, false); return fmaxf(__uint_as_float(rr[0]), __uint_as_float(rr[1])); }
__device__ __forceinline__ float xor32_get(float v, int hi) { const auto rr = __builtin_amdgcn_permlane32_swap(__float_as_uint(v), __float_as_uint(v), false, false); return hi ? __uint_as_float(rr[0]) : __uint_as_float(rr[1]); }
__device__ __forceinline__ float wave_sum(float v) {
    v += lane_xor<1>(v); v += lane_xor<2>(v); v += lane_xor<4>(v); v += lane_xor<8>(v); v += lane_xor<16>(v); return xor32_add(v);
}
#define LDS_WAIT() asm volatile("s_waitcnt lgkmcnt(0)" ::: "memory")
__device__ __forceinline__ unsigned pk4_fp8(float a, float b, float c, float d) { int p = __builtin_amdgcn_cvt_pk_fp8_f32(a, b, 0, false); p = __builtin_amdgcn_cvt_pk_fp8_f32(c, d, p, true); return (unsigned)p; }
constexpr float WDN_SCALE = 256.f;

namespace pg8 {
constexpr int BM = 256, BK = 64, HALF = 128, HTB = HALF * BK * 2, STAGE_BYTES = 8 * HTB, NXCD = 8, WGM = 8;
constexpr int XL_OFF = STAGE_BYTES;
__host__ __device__ __forceinline__ int lds_byte(int r, int c) { const int st = (r >> 4) * 2 + (c >> 5), rr = r & 15, cc = c & 31, ob = rr * 64 + cc * 2; return st * 1024 + (ob ^ (((ob >> 9) & 1) << 5)); }
__host__ __device__ __forceinline__ void stage_rc(int b, int& R, int& C) { const int st = b / 1024, sb = b % 1024, swz = sb ^ (((sb >> 9) & 1) << 5); R = (st >> 1) * 16 + swz / 64; C = (st & 1) * 32 + (swz % 64) / 2; }
__host__ __device__ __forceinline__ int perm32(int rho) { const int n = rho >> 4, i = rho & 15; return 8 * (i >> 2) + 4 * n + (i & 3); }

struct Unit { const char* a; const char* b; const float* sc; const float* sc2; int pm, pn; };
__device__ __forceinline__ void tile_of(int L, int nM, int nN, int& pm, int& pn) {
    const int nwg = nM * nN; int wgid = L;
    { const int q = nwg / NXCD, r = nwg % NXCD, xcd = wgid % NXCD, off = wgid / NXCD; wgid = (xcd < r ? xcd * (q + 1) : r * (q + 1) + (xcd - r) * q) + off; }
    const int nig = WGM * nN, gid = wgid / nig, fm = gid * WGM, gsz = (nM - fm) < WGM ? (nM - fm) : WGM;
    pm = fm + ((wgid % nig) % gsz); pn = (wgid % nig) / gsz;
}
struct Out { char* o; const char* r; int ldo; bf16_t* xb; float* ssq; int scmode; };
__device__ __forceinline__ float rs_of(const float* p4) { const f32x4 q = *(const f32x4*)p4; return 1.0f / sqrtf(((q.x + q.y) + (q.z + q.w)) * (1.f / 1024.f) + 1e-6f); }
__device__ __forceinline__ float rs_lds(const LAS float* p4) { const f32x4 q = *(const LAS f32x4*)p4; return 1.0f / sqrtf(((q.x + q.y) + (q.z + q.w)) * (1.f / 1024.f) + 1e-6f); }

template <int MD> struct EpiStoreBf16T {
    static constexpr bool PERM = true; static constexpr int MODE = MD; typedef f32x4 acc_t; static constexpr float OSC = (MD == 2) ? 1.0f / WDN_SCALE : 1.0f;
    __device__ __forceinline__ void operator()(const f32x4 (&acc)[2][2][4][2], const Out& u, int wr, int wc, int fr, int fq, const LAS float* xl, LAS float* xr) const {
        asm volatile("" : "+v"(fr), "+v"(fq));
        bf16_t* base = (bf16_t*)u.o + wc * 32 + 8 * fq;
        float cs[2][8];
        if (u.scmode == 2) {
#pragma unroll
            for (int bj = 0; bj < 2; ++bj)
#pragma unroll
                for (int j = 0; j < 8; ++j) cs[bj][j] = rs_lds(xl + (bj * HALF + wc * 32 + 8 * fq + j) * 4);
        }
#pragma unroll
        for (int ai = 0; ai < 2; ++ai)
#pragma unroll
            for (int m = 0; m < 4; ++m) { const int row = ai * HALF + wr * 64 + m * 16 + fr; bf16_t* rowp = base + (size_t)row * u.ldo;
                float rsc = OSC; if (u.scmode == 1) rsc = rs_lds(xl + row * 4);
#pragma unroll
                for (int bj = 0; bj < 2; ++bj) { f32x4 v0 = acc[ai][bj][m][0] * rsc, v1 = acc[ai][bj][m][1] * rsc;
                    if (u.scmode == 2) { v0.x *= cs[bj][0]; v0.y *= cs[bj][1]; v0.z *= cs[bj][2]; v0.w *= cs[bj][3]; v1.x *= cs[bj][4]; v1.y *= cs[bj][5]; v1.z *= cs[bj][6]; v1.w *= cs[bj][7]; }
                    u32x4 w; w.x = cvt_pk_bf16(v0[0], v0[1]); w.y = cvt_pk_bf16(v0[2], v0[3]); w.z = cvt_pk_bf16(v1[0], v1[1]); w.w = cvt_pk_bf16(v1[2], v1[3]);
                    *(u32x4*)(rowp + bj * HALF) = w; } }
    }
};
typedef EpiStoreBf16T<0> EpiStoreBf16;
struct EpiStoreI8 {
    static constexpr bool PERM = true; static constexpr int MODE = 1; typedef i32x4 acc_t;
    __device__ __forceinline__ void operator()(const i32x4 (&acc)[2][2][4][2], const Out& u, int wr, int wc, int fr, int fq, const LAS float* xl, LAS float* xr) const {
        asm volatile("" : "+v"(fr), "+v"(fq));
        bf16_t* base = (bf16_t*)u.o + wc * 32 + 8 * fq;
        float cs[2][8];
#pragma unroll
        for (int bj = 0; bj < 2; ++bj) { const f32x4 c0 = *(const LAS f32x4*)(xl + 256 + bj * HALF + wc * 32 + 8 * fq), c1 = *(const LAS f32x4*)(xl + 256 + bj * HALF + wc * 32 + 8 * fq + 4);
            cs[bj][0] = c0.x; cs[bj][1] = c0.y; cs[bj][2] = c0.z; cs[bj][3] = c0.w; cs[bj][4] = c1.x; cs[bj][5] = c1.y; cs[bj][6] = c1.z; cs[bj][7] = c1.w; }
#pragma unroll
        for (int ai = 0; ai < 2; ++ai)
#pragma unroll
            for (int m = 0; m < 4; ++m) { const int row = ai * HALF + wr * 64 + m * 16 + fr; bf16_t* rowp = base + (size_t)row * u.ldo; const float rsc = xl[row];
#pragma unroll
                for (int bj = 0; bj < 2; ++bj) { float v[8];
#pragma unroll
                    for (int n = 0; n < 2; ++n)
#pragma unroll
                        for (int j = 0; j < 4; ++j) v[n * 4 + j] = (float)acc[ai][bj][m][n][j] * (rsc * cs[bj][n * 4 + j]);
                    u32x4 w; w.x = cvt_pk_bf16(v[0], v[1]); w.y = cvt_pk_bf16(v[2], v[3]); w.z = cvt_pk_bf16(v[4], v[5]); w.w = cvt_pk_bf16(v[6], v[7]);
                    *(u32x4*)(rowp + bj * HALF) = w; } }
    }
};
struct EpiSwiGLU8 {
    static constexpr bool PERM = true; static constexpr int MODE = 1; typedef i32x4 acc_t;
    __device__ __forceinline__ void operator()(const i32x4 (&acc)[2][2][4][2], const Out& u, int wr, int wc, int fr, int fq, const LAS float* xl, LAS float* xr) const {
        asm volatile("" : "+v"(fr), "+v"(fq));
        unsigned char* base = (unsigned char*)u.o + wc * 32 + 8 * fq;
        const f32x4 cg0 = *(const LAS f32x4*)(xl + 256 + wc * 32 + 8 * fq), cg1 = *(const LAS f32x4*)(xl + 256 + wc * 32 + 8 * fq + 4);
        const f32x4 cu0 = *(const LAS f32x4*)(xl + 256 + HALF + wc * 32 + 8 * fq), cu1 = *(const LAS f32x4*)(xl + 256 + HALF + wc * 32 + 8 * fq + 4);
        const float cg[8] = {cg0.x, cg0.y, cg0.z, cg0.w, cg1.x, cg1.y, cg1.z, cg1.w}, cu[8] = {cu0.x, cu0.y, cu0.z, cu0.w, cu1.x, cu1.y, cu1.z, cu1.w};
#pragma unroll
        for (int ai = 0; ai < 2; ++ai)
#pragma unroll
            for (int m = 0; m < 4; ++m) { const int row = ai * HALF + wr * 64 + m * 16 + fr; unsigned char* rowp = base + (size_t)row * u.ldo;
                float nl2e = -1.4426950408889634f; asm volatile("" : "+s"(nl2e));
                const float rsc = xl[row], r2 = rsc * nl2e, rs2 = rsc * rsc;
                float h[8];
                typedef float f32x2_ __attribute__((ext_vector_type(2)));
#pragma unroll
                for (int n = 0; n < 2; ++n) { f32x2_ p[2], q[2], e[2];
#pragma unroll
                    for (int j = 0; j < 2; ++j) { p[j] = (f32x2_){(float)acc[ai][0][m][n][2 * j], (float)acc[ai][0][m][n][2 * j + 1]} * (f32x2_){cg[n * 4 + 2 * j], cg[n * 4 + 2 * j + 1]};
                                                  q[j] = (f32x2_){(float)acc[ai][1][m][n][2 * j], (float)acc[ai][1][m][n][2 * j + 1]} * (f32x2_){cu[n * 4 + 2 * j], cu[n * 4 + 2 * j + 1]}; }
#pragma unroll
                    for (int j = 0; j < 2; ++j) { const f32x2_ t = p[j] * r2; e[j].x = __builtin_amdgcn_exp2f(t.x); e[j].y = __builtin_amdgcn_exp2f(t.y); }
#pragma unroll
                    for (int j = 0; j < 2; ++j) { e[j] = e[j] + 1.0f; q[j] = p[j] * q[j]; }
#pragma unroll
                    for (int j = 0; j < 2; ++j) { e[j].x = __builtin_amdgcn_rcpf(e[j].x); e[j].y = __builtin_amdgcn_rcpf(e[j].y); }
#pragma unroll
                    for (int j = 0; j < 2; ++j) { const f32x2_ hh = q[j] * (e[j] * rs2); h[n * 4 + 2 * j] = hh.x; h[n * 4 + 2 * j + 1] = hh.y; } }
                u32x2 w; w.x = pk4_fp8(h[0], h[1], h[2], h[3]); w.y = pk4_fp8(h[4], h[5], h[6], h[7]);
                *(u32x2*)rowp = w; }
    }
};
template <int MD> struct EpiResidT {
    static constexpr bool PERM = true; static constexpr int MODE = MD; typedef f32x4 acc_t; static constexpr float OSC = (MD == 2) ? 1.0f / WDN_SCALE : 1.0f;
    __device__ __forceinline__ void operator()(const f32x4 (&acc)[2][2][4][2], const Out& u, int wr, int wc, int fr, int fq, const LAS float* xl_unused, LAS float* xl) const {
        asm volatile("" : "+v"(fr), "+v"(fq));
        bf16_t* base = u.xb + wc * 32 + 8 * fq;
        float ps[8];
        u32x4 rv[2][4][2];
#pragma unroll
        for (int ai = 0; ai < 2; ++ai)
#pragma unroll
            for (int m = 0; m < 4; ++m)
#pragma unroll
                for (int bj = 0; bj < 2; ++bj) rv[ai][m][bj] = *(const u32x4*)(base + (size_t)(ai * HALF + wr * 64 + m * 16 + fr) * 1024 + bj * HALF);
#pragma unroll
        for (int ai = 0; ai < 2; ++ai)
#pragma unroll
            for (int m = 0; m < 4; ++m) { bf16_t* rowp = base + (size_t)(ai * HALF + wr * 64 + m * 16 + fr) * 1024; float q = 0.f;
#pragma unroll
                for (int bj = 0; bj < 2; ++bj) { const u32x4 r = rv[ai][m][bj]; const f32x4 a0 = acc[ai][bj][m][0] * OSC, a1 = acc[ai][bj][m][1] * OSC;
                    const float x0 = bf_lo(r.x) + a0.x, x1 = bf_hi(r.x) + a0.y, x2 = bf_lo(r.y) + a0.z, x3 = bf_hi(r.y) + a0.w, x4 = bf_lo(r.z) + a1.x, x5 = bf_hi(r.z) + a1.y, x6 = bf_lo(r.w) + a1.z, x7 = bf_hi(r.w) + a1.w;
                    q += ((x0 * x0 + x1 * x1) + (x2 * x2 + x3 * x3)) + ((x4 * x4 + x5 * x5) + (x6 * x6 + x7 * x7));
                    u32x4 w; w.x = cvt_pk_bf16(x0, x1); w.y = cvt_pk_bf16(x2, x3); w.z = cvt_pk_bf16(x4, x5); w.w = cvt_pk_bf16(x6, x7);
                    *(u32x4*)(rowp + bj * HALF) = w; }
                q += lane_xor<16>(q); q = xor32_add(q); ps[ai * 4 + m] = q; }
        if (fq == 0) {
#pragma unroll
            for (int ai = 0; ai < 2; ++ai)
#pragma unroll
                for (int m = 0; m < 4; ++m) xl[(ai * HALF + wr * 64 + m * 16 + fr) * 4 + wc] = ps[ai * 4 + m]; }
        asm volatile("s_waitcnt lgkmcnt(0)" ::: "memory"); __builtin_amdgcn_s_barrier(); asm volatile("" ::: "memory");
        const int t = wr * 256 + wc * 64 + fq * 16 + fr;
        if (t < 256) { const f32x4 q4 = *(const LAS f32x4*)(xl + t * 4); u.ssq[(size_t)t * 4] = (q4.x + q4.y) + (q4.z + q4.w); }
        asm volatile("s_waitcnt lgkmcnt(0)" ::: "memory"); __builtin_amdgcn_s_barrier(); asm volatile("" ::: "memory");
    }
};

typedef EpiResidT<0> EpiResid;
template <class Epi, class Sched>
__device__ __forceinline__ void gemm_phase(LAS unsigned char* lds, const int KB, const Sched& S, const Epi& E) {
    int tid = threadIdx.x; asm volatile("" : "+v"(tid));
    const int wid = __builtin_amdgcn_readfirstlane(tid >> 6), lane = tid & 63, wr = wid >> 2, wc = wid & 3, fr = lane & 15, fq = lane >> 4;
    const int nt = KB / 128;
    unsigned voffA[2], voffB[2];
#pragma unroll
    for (int i = 0; i < 2; ++i) { int R, C; stage_rc(tid * 16 + i * 8192, R, C); const int Rb = Epi::PERM ? ((R & ~31) + perm32(R & 31)) : R;
        voffA[i] = (unsigned)(R * KB + C * 2); voffB[i] = (unsigned)(Rb * KB + C * 2); }
    const size_t kstep = (size_t)(BK * 2);
    const size_t hstep = (size_t)HALF * KB;
    const unsigned ldsw = (unsigned)wid * 1024u;
    const unsigned ldsb_ = (unsigned)(size_t)lds;
    const int aoff = lds_byte(wr * 64 + fr, fq * 8), boff = lds_byte(wc * 32 + fr, fq * 8);
#define PG8_SA(b, h) (((b) * 2 + (h)) * HTB)
#define PG8_SB(b, h) ((4 + (b) * 2 + (h)) * HTB)
#define PG8_STAGE(bufoff, gbase, voff) do { const unsigned so_ = (unsigned)(size_t)(gbase) - (unsigned)(size_t)S.ws; \
        const __amdgpu_buffer_rsrc_t srd_ = __builtin_amdgcn_make_buffer_rsrc((void*)S.ws, (short)0, 0x7FFFFFFF, 0x00020000); \
        _Pragma("unroll") for (int _i = 0; _i < 2; ++_i) \
        asm volatile("s_mov_b32 m0, %0\n\ts_nop 0\n\tbuffer_load_dwordx4 %1, %2, %3 offen lds" :: "s"(ldsb_ + (unsigned)(bufoff) + ldsw + (unsigned)(_i * 8192)), "v"((voff)[_i]), "s"(srd_), "s"(so_) : "m0", "memory"); } while (0)
#define PG8_LDA(dst, b, h) do { _Pragma("unroll") for (int m = 0; m < 4; ++m) { if constexpr (Epi::MODE == 2) { const i32x4 lo_ = *(const LAS i32x4*)(lds + PG8_SA(b, h) + aoff + m * 2048), hi_ = *(const LAS i32x4*)(lds + PG8_SA(b, h) + aoff + m * 2048 + 1024); \
            dst##8[m] = __builtin_shufflevector(lo_, hi_, 0, 1, 2, 3, 4, 5, 6, 7); } else { _Pragma("unroll") for (int k = 0; k < 2; ++k) dst[m][k] = *(const LAS bf16x8*)(lds + PG8_SA(b, h) + aoff + m * 2048 + k * 1024); } } } while (0)
#define PG8_LDB(dst, b, h) do { _Pragma("unroll") for (int n = 0; n < 2; ++n) { if constexpr (Epi::MODE == 2) { const i32x4 lo_ = *(const LAS i32x4*)(lds + PG8_SB(b, h) + boff + n * 2048), hi_ = *(const LAS i32x4*)(lds + PG8_SB(b, h) + boff + n * 2048 + 1024); \
            dst##8[n] = __builtin_shufflevector(lo_, hi_, 0, 1, 2, 3, 4, 5, 6, 7); } else { _Pragma("unroll") for (int k = 0; k < 2; ++k) dst[n][k] = *(const LAS bf16x8*)(lds + PG8_SB(b, h) + boff + n * 2048 + k * 1024); } } } while (0)
#define PG8_MMA(ai, bj, At, Bt, Z) do { __builtin_amdgcn_s_setprio(1); _Pragma("unroll") for (int m = 0; m < 4; ++m) _Pragma("unroll") for (int n = 0; n < 2; ++n) { \
        if constexpr (Epi::MODE == 2) { \
            if constexpr ((Z) != 0) asm volatile("s_nop 1\n\tv_mfma_scale_f32_16x16x128_f8f6f4 %0, %1, %2, 0, %3, %3 op_sel_hi:[0,0,0]" : "=&v"(acc[ai][bj][m][n]) : "v"(Bt##8[n]), "v"(At##8[m]), "v"(f8one)); \
            else asm volatile("s_nop 1\n\tv_mfma_scale_f32_16x16x128_f8f6f4 %0, %1, %2, %0, %3, %3 op_sel_hi:[0,0,0]" : "+v"(acc[ai][bj][m][n]) : "v"(Bt##8[n]), "v"(At##8[m]), "v"(f8one)); } \
        else { _Pragma("unroll") for (int k = 0; k < 2; ++k) { const typename Epi::acc_t c_ = ((Z) != 0 && k == 0 && Epi::MODE == 1) ? (typename Epi::acc_t){0, 0, 0, 0} : acc[ai][bj][m][n]; \
            if constexpr (Epi::MODE == 1) acc[ai][bj][m][n] = __builtin_amdgcn_mfma_i32_16x16x64_i8(__builtin_bit_cast(i32x4, Bt[n][k]), __builtin_bit_cast(i32x4, At[m][k]), c_, 0, 0, 0); \
            else acc[ai][bj][m][n] = __builtin_amdgcn_mfma_f32_16x16x32_bf16(Bt[n][k], At[m][k], c_, 0, 0, 0); } } } __builtin_amdgcn_s_setprio(0); } while (0)
#define PG8_WAIT_V(n) asm volatile("s_waitcnt vmcnt(" #n ")" ::: "memory")
#define PG8_WAIT_L(n) asm volatile("s_waitcnt lgkmcnt(" #n ")" ::: "memory")
#define PG8_BAR __builtin_amdgcn_s_barrier()
#define PG8_SCHED __builtin_amdgcn_sched_barrier(0)
    Unit cur, nxt; int ui = 0;
    if (!__builtin_amdgcn_readfirstlane((int)S.next(0, cur))) return;
    typename Epi::acc_t acc[2][2][4][2];
#define PG8_ZERO_ACC do { if constexpr (Epi::MODE == 0) { _Pragma("unroll") for (int a = 0; a < 2; ++a) _Pragma("unroll") for (int b = 0; b < 2; ++b) _Pragma("unroll") for (int m = 0; m < 4; ++m) _Pragma("unroll") for (int n = 0; n < 2; ++n) \
        acc[a][b][m][n] = (typename Epi::acc_t){0, 0, 0, 0}; } } while (0)
    PG8_ZERO_ACC;
    bf16x8 At[4][2], B0[2][2], B1[2][2];
    i32x8 At8[4], B08[2], B18[2];
    const int f8one = 0x7F7F7F7F;
    const char* cA = cur.a; const char* cB = cur.b;
#define PG8_SCALES(un, buf) do { if ((un).sc != nullptr && wid < 4) { unsigned lane; asm volatile("v_mbcnt_lo_u32_b32 %0, -1, 0\n\tv_mbcnt_hi_u32_b32 %0, -1, %0" : "=v"(lane));        \
        if constexpr (Epi::MODE == 1) { __builtin_amdgcn_global_load_lds((const unsigned*)((un).sc + wid * 64 + lane), (LAS unsigned*)(lds + XL_OFF + (buf) * 4096 + wid * 256), 4, 0, 0); \
                                 __builtin_amdgcn_global_load_lds((const unsigned*)((un).sc2 + wid * 64 + lane), (LAS unsigned*)(lds + XL_OFF + (buf) * 4096 + 1024 + wid * 256), 4, 0, 0); } \
        else __builtin_amdgcn_global_load_lds((const unsigned*)((un).sc + (wid * 64 + lane) * 4), (LAS unsigned*)(lds + XL_OFF + (buf) * 4096 + wid * 1024), 16, 0, 0); } } while (0)
    PG8_SCALES(cur, 0);
    PG8_STAGE(PG8_SB(0, 0), cB, voffB); PG8_STAGE(PG8_SB(0, 1), cB + hstep, voffB); PG8_STAGE(PG8_SA(0, 0), cA, voffA); PG8_STAGE(PG8_SA(0, 1), cA + hstep, voffA);
    if (wr == 1) PG8_BAR;
    PG8_WAIT_V(2); PG8_BAR;
    PG8_STAGE(PG8_SB(1, 0), cB + kstep, voffB); PG8_STAGE(PG8_SA(1, 0), cA + kstep, voffA); PG8_STAGE(PG8_SB(1, 1), cB + hstep + kstep, voffB);
    PG8_WAIT_V(6); PG8_BAR;
    for (;;) {
        const bool has_next = S.next(ui + 1, nxt);
        const char* nA = has_next ? nxt.a : cA; const char* nB = has_next ? nxt.b : cB;
#define PG8_ITER(Z) do { \
            const bool last = (t == nt - 2); \
            const char* a1 = cA + (size_t)(t + 1) * kstep; \
            const char* a2 = last ? nA : cA + (size_t)(t + 2) * kstep; const char* b2 = last ? nB : cB + (size_t)(t + 2) * kstep; \
            const char* a3 = a2 + kstep; const char* b3 = b2 + kstep; \
            PG8_LDB(B0, 0, 0); PG8_LDB(B1, 0, 1); PG8_SCHED; PG8_LDA(At, 0, 0); PG8_STAGE(PG8_SA(1, 1), a1 + hstep, voffA); \
            PG8_WAIT_V(8); PG8_WAIT_L(0); PG8_BAR; PG8_MMA(0, 0, At, B0, Z); PG8_MMA(0, 1, At, B1, Z); PG8_BAR; PG8_SCHED; \
            PG8_LDA(At, 0, 1); PG8_STAGE(PG8_SB(0, 0), b2, voffB); PG8_STAGE(PG8_SB(0, 1), b2 + hstep, voffB); PG8_STAGE(PG8_SA(0, 0), a2, voffA); \
            PG8_WAIT_V(8); PG8_WAIT_L(0); PG8_BAR; PG8_MMA(1, 0, At, B0, Z); PG8_MMA(1, 1, At, B1, Z); PG8_BAR; PG8_SCHED; \
            PG8_LDB(B0, 1, 0); PG8_LDB(B1, 1, 1); PG8_SCHED; PG8_LDA(At, 1, 0); PG8_STAGE(PG8_SA(0, 1), a2 + hstep, voffA); \
            PG8_WAIT_V(8); PG8_WAIT_L(0); PG8_BAR; PG8_MMA(0, 0, At, B0, 0); PG8_MMA(0, 1, At, B1, 0); PG8_BAR; PG8_SCHED; \
            PG8_LDA(At, 1, 1); PG8_STAGE(PG8_SB(1, 0), b3, voffB); PG8_STAGE(PG8_SB(1, 1), b3 + hstep, voffB); PG8_STAGE(PG8_SA(1, 0), a3, voffA); \
            PG8_WAIT_V(8); PG8_WAIT_L(0); PG8_BAR; PG8_MMA(1, 0, At, B0, 0); PG8_MMA(1, 1, At, B1, 0); PG8_BAR; PG8_SCHED; } while (0)
        if constexpr (Epi::MODE == 0) { for (int t = 0; t < nt; t += 2) PG8_ITER(0); }
        else { { const int t = 0; PG8_ITER(1); }
               for (int t = 2; t < nt; t += 2) PG8_ITER(0); }
#undef PG8_ITER
        if (has_next) PG8_SCALES(nxt, (ui + 1) & 1);
        if (wr == 0) PG8_BAR;
        if constexpr (Epi::MODE == 2) asm volatile("s_nop 15\n\ts_nop 15\n\ts_nop 15" ::: "memory");
        { Out eo; S.out(cur, eo); unsigned le_; asm volatile("v_mbcnt_lo_u32_b32 %0, -1, 0\n\tv_mbcnt_hi_u32_b32 %0, -1, %0" : "=v"(le_));
          E(acc, eo, wr, wc, (int)(le_ & 15u), (int)(le_ >> 4), (LAS float*)(lds + XL_OFF + (ui & 1) * 4096), (LAS float*)(lds + XL_OFF + 8192)); }
        if (!has_next) break;
        PG8_ZERO_ACC;
        cur = nxt; cA = nA; cB = nB; ++ui;
        if (wr == 1) PG8_BAR;
    }
    PG8_WAIT_V(0);
    PG8_BAR;
#undef PG8_SCALES
#undef PG8_SA
#undef PG8_SB
#undef PG8_STAGE
#undef PG8_LDA
#undef PG8_LDB
#undef PG8_MMA
#undef PG8_WAIT_V
#undef PG8_WAIT_L
#undef PG8_BAR
#undef PG8_SCHED
}
}

#define XB_TMO      128
#define XB_XCNT(j)  (256  + 64 * (j))
#define XB_XSUB(j)  (1280 + 64 * (j))
#define XB_XGEN(j)  (2304 + 64 * (j))
#define XB_TOP      3328
#define XB_TOPGEN   3392
#define XCD_BAR_WORDS 3456
#define XB_SPIN_CAP (1u << 18)
__device__ __forceinline__ unsigned xb_ld(unsigned* p)              { return __hip_atomic_load(p, __ATOMIC_RELAXED, __HIP_MEMORY_SCOPE_AGENT); }
__device__ __forceinline__ unsigned xb_add(unsigned* p, unsigned v) { return __hip_atomic_fetch_add(p, v, __ATOMIC_RELAXED, __HIP_MEMORY_SCOPE_AGENT); }
__device__ __forceinline__ unsigned xb_xcc_id() { return (unsigned)__builtin_amdgcn_s_getreg((3 << 11) | 20) & 0xFu; }
#define XB_SPIN(cond, bar) do { unsigned _sp = 0; while (cond) { __builtin_amdgcn_s_sleep(1); \
    if ((++_sp & 255u) == 0u) { if (xb_ld(&(bar)[XB_TMO])) break; if (_sp > XB_SPIN_CAP) { atomicAdd(&(bar)[XB_TMO], 1u); break; } } } } while (0)
struct XcdBarrier { unsigned* bar; unsigned x; volatile LAS unsigned* st; };
__device__ __forceinline__ XcdBarrier xcd_barrier_post(unsigned* bar, volatile LAS unsigned* st) {
    XcdBarrier b; b.bar = bar; b.x = xb_xcc_id(); b.st = st;
    if (threadIdx.x == 0) (void)xb_add(&bar[XB_XCNT(b.x)], 1u);
    return b;
}
__device__ __forceinline__ void xcd_barrier_complete(unsigned* bar, unsigned x, unsigned& nloc, unsigned& nx) {
    const unsigned G = gridDim.x * gridDim.y * gridDim.z;
    unsigned sum, cnt, mine, sp = 0u;
    for (;;) {
        sum = 0u; cnt = 0u; mine = 0u;
#pragma unroll
        for (unsigned j = 0; j < 16; ++j) { const unsigned c = xb_ld(&bar[XB_XCNT(j)]); sum += c; cnt += (c > 0u) ? 1u : 0u; mine = (j == x) ? c : mine; }
        if (sum == G) break;
        __builtin_amdgcn_s_sleep(1);
        if ((++sp & 255u) == 0u) { if (xb_ld(&bar[XB_TMO])) break; if (sp > XB_SPIN_CAP) { atomicAdd(&bar[XB_TMO], 1u); break; } }
    }
    nloc = mine > 0u ? mine : 1u; nx = cnt > 0u ? cnt : 1u;
}
__device__ __forceinline__ void xcd_barrier(const XcdBarrier& b) {
    asm volatile("s_waitcnt vmcnt(0)" ::: "memory");
    __syncthreads();
    if (threadIdx.x == 0) {
        unsigned* bar = b.bar; asm volatile("" : "+s"(bar)); unsigned bx_ = b.x; asm volatile("" : "+s"(bx_));
        __builtin_amdgcn_s_waitcnt(0);
        unsigned nloc = b.st[0], nx = b.st[1];
        if (nloc == 0u) { xcd_barrier_complete(bar, bx_, nloc, nx); b.st[0] = nloc; b.st[1] = nx; }
        const unsigned old = xb_add(&bar[XB_XSUB(bx_)], 1u);
        const unsigned gen = old / nloc;
        if (old + 1u == (gen + 1u) * nloc) {
            __builtin_amdgcn_fence(__ATOMIC_RELEASE, "agent");
            asm volatile("s_waitcnt vmcnt(0)" ::: "memory");
            const unsigned og = xb_add(&bar[XB_TOP], 1u);
            const unsigned tg = og / nx;
            if (og + 1u == (tg + 1u) * nx) xb_add(&bar[XB_TOPGEN], 1u);
            else XB_SPIN(xb_ld(&bar[XB_TOPGEN]) == tg, bar);
            __builtin_amdgcn_fence(__ATOMIC_ACQUIRE, "agent");
            xb_add(&bar[XB_XGEN(bx_)], 1u);
            asm volatile("s_waitcnt vmcnt(0)" ::: "memory");
        } else {
            XB_SPIN(xb_ld(&bar[XB_XGEN(bx_)]) == gen, bar);
            __builtin_amdgcn_fence(__ATOMIC_ACQUIRE, "agent");
            asm volatile("s_waitcnt vmcnt(0)" ::: "memory");
        }
    }
    __syncthreads();
}

constexpr int RING_BYTES = 131072;
constexpr int MISC_OFF = RING_BYTES + 12288;
constexpr int LDS_BYTES = RING_BYTES + 4096 + 12288;

struct Params {
    const float* in[27];
    float* out;
    unsigned char* ws;
    int ph_lo, ph_hi;
};
enum { I_X = 0, I_MEM, I_NORM_MIX, I_W_IN, I_SB_OUT_GAIN, I_SWA_Q_GAIN, I_SWA_K_GAIN, I_SWA_SINKS, I_SWA_OUT_GAIN, I_REL_BIAS, I_W_OUT, I_NORM_XATTN, I_NORM_MEM,
       I_XWQ, I_XWKV, I_XQ_GAIN, I_XK_GAIN, I_XWO, I_NORM_FFN, I_DGATE, I_DUP, I_DDOWN, I_ROUTER_W, I_ROUTER_B, I_EGATE, I_EUP, I_EDOWN };

struct Frame {
    LAS unsigned char* lds;
    int tid, lane, wave;
    int G, bx;
};

template <class RowMap>
__device__ __forceinline__ void transpose_item(const float* W, int K, int N, bf16_t* WT, const RowMap& rm, LAS float* scr, int item, int lane) {
    const int nblk = N / 32, kb = item / nblk, nb = item % nblk, k0 = 64 * kb, n0 = 32 * nb;
    { f32x4 wv[8]; const int n4 = (lane & 7) * 4;
#pragma unroll
      for (int i = 0; i < 8; ++i) wv[i] = *(const f32x4*)(W + (size_t)(k0 + 8 * i + (lane >> 3)) * N + n0 + n4);
#pragma unroll
      for (int i = 0; i < 8; ++i) { const int kk = 8 * i + (lane >> 3); const float gk = rm.gain ? rm.gain[k0 + kk] : 1.0f; LAS float* d = scr + kk * 33 + n4; d[0] = wv[i].x * gk; d[1] = wv[i].y * gk; d[2] = wv[i].z * gk; d[3] = wv[i].w * gk; } }
    LDS_WAIT(); asm volatile("" ::: "memory");
    const int c = lane & 7; const int r0 = rm(n0);
#pragma unroll
    for (int j = 0; j < 4; ++j) { const int n = (lane >> 3) + 8 * j; const LAS float* s = scr + (8 * c) * 33 + n;
        u32x4 o; o.x = cvt_pk_bf16(s[0 * 33], s[1 * 33]); o.y = cvt_pk_bf16(s[2 * 33], s[3 * 33]); o.z = cvt_pk_bf16(s[4 * 33], s[5 * 33]); o.w = cvt_pk_bf16(s[6 * 33], s[7 * 33]);
        *(u32x4*)(WT + (size_t)(r0 + n) * K + k0 + 8 * c) = o; }
    LDS_WAIT(); asm volatile("" ::: "memory");
}
template <class RowMap>
__device__ __forceinline__ void transpose_item_f8(const float* W, int K, int N, unsigned char* WT, const RowMap& rm, LAS float* scr, int item, int lane) {
    const int nblk = N / 32, kb = item / nblk, nb = item % nblk, k0 = 64 * kb, n0 = 32 * nb;
    { f32x4 wv[8]; const int n4 = (lane & 7) * 4;
#pragma unroll
      for (int i = 0; i < 8; ++i) wv[i] = *(const f32x4*)(W + (size_t)(k0 + 8 * i + (lane >> 3)) * N + n0 + n4);
#pragma unroll
      for (int i = 0; i < 8; ++i) { LAS float* d = scr + (8 * i + (lane >> 3)) * 33 + n4; d[0] = wv[i].x * WDN_SCALE; d[1] = wv[i].y * WDN_SCALE; d[2] = wv[i].z * WDN_SCALE; d[3] = wv[i].w * WDN_SCALE; } }
    LDS_WAIT(); asm volatile("" ::: "memory");
    const int c = lane & 7; const int r0 = rm(n0);
#pragma unroll
    for (int j = 0; j < 4; ++j) { const int n = (lane >> 3) + 8 * j; const LAS float* sp = scr + (8 * c) * 33 + n;
        u32x2 o; o.x = pk4_fp8(sp[0 * 33], sp[1 * 33], sp[2 * 33], sp[3 * 33]); o.y = pk4_fp8(sp[4 * 33], sp[5 * 33], sp[6 * 33], sp[7 * 33]);
        *(u32x2*)(WT + (size_t)(r0 + n) * K + k0 + 8 * c) = o; }
    LDS_WAIT(); asm volatile("" ::: "memory");
}
struct RowIdent { const float* gain = nullptr; __device__ __forceinline__ int operator()(int n0) const { return n0; } };
struct RowGate { const float* gain = nullptr; __device__ __forceinline__ int operator()(int n0) const { return (n0 >> 7) * 256 + (n0 & 127); } };
struct RowUp { const float* gain = nullptr; __device__ __forceinline__ int operator()(int n0) const { return (n0 >> 7) * 256 + 128 + (n0 & 127); } };

__device__ __forceinline__ void norm_row(const float* xrow, bf16_t* orow, const f32x4 (&g)[4], f32x4 (&v)[4], int lane) {
    const f32x4* xr = (const f32x4*)xrow + lane; float s = 0.f;
#pragma unroll
    for (int j = 0; j < 4; ++j) { v[j] = xr[64 * j]; s += (v[j].x * v[j].x + v[j].y * v[j].y) + (v[j].z * v[j].z + v[j].w * v[j].w); }
    const float rs = 1.0f / sqrtf(wave_sum(s) * (1.f / D) + EPS);
    u32x2* o8 = (u32x2*)orow + lane;
#pragma unroll
    for (int j = 0; j < 4; ++j) { v[j] = v[j] * rs * g[j]; u32x2 w; w.x = cvt_pk_bf16(v[j].x, v[j].y); w.y = cvt_pk_bf16(v[j].z, v[j].w); o8[64 * j] = w; }
}

__device__ __forceinline__ int pi32(int i) { return 16 * ((i >> 2) & 1) + 4 * (i >> 3) + (i & 3); }
__device__ __forceinline__ bf16x8 pack8(const float* p) {
    u32x4 w; w.x = cvt_pk_bf16(p[0], p[1]); w.y = cvt_pk_bf16(p[2], p[3]); w.z = cvt_pk_bf16(p[4], p[5]); w.w = cvt_pk_bf16(p[6], p[7]);
    return __builtin_bit_cast(bf16x8, w);
}
__device__ __forceinline__ void unpack8(bf16x8 v, float* f) {
    const u32x4 w = __builtin_bit_cast(u32x4, v);
    f[0] = bf_lo(w.x); f[1] = bf_hi(w.x); f[2] = bf_lo(w.y); f[3] = bf_hi(w.y); f[4] = bf_lo(w.z); f[5] = bf_hi(w.z); f[6] = bf_lo(w.w); f[7] = bf_hi(w.w);
}
#define MFMA32(a, b, c) __builtin_amdgcn_mfma_f32_32x32x16_bf16((a), (b), (c), 0, 0, 0)
__device__ __forceinline__ u32x4 pair_halves(u32x2 even, u32x2 odd) {
    const auto x = __builtin_amdgcn_permlane32_swap(even.x, odd.x, false, false), y = __builtin_amdgcn_permlane32_swap(even.y, odd.y, false, false);
    return (u32x4){x[0], y[0], x[1], y[1]};
}

__device__ __forceinline__ void group_norm_store(const f32x16 (&o)[2], int h, int r32, int hi, const LAS float* gain, bf16_t* outrow0, LAS float* part  ) {
    float a = 0.f;
#pragma unroll
    for (int dd = 0; dd < 2; ++dd)
#pragma unroll
        for (int r = 0; r < 16; ++r) a += o[dd][r] * o[dd][r];
    a = xor32_add(a);
    if (hi == 0) part[h * 32 + r32] = a;
    __syncthreads();
    float tot = 0.f;
#pragma unroll
    for (int hh = 0; hh < 8; ++hh) tot += part[hh * 32 + r32];
    const float rs = 1.0f / sqrtf(tot * (1.f / 512.f) + EPS);
    bf16_t* orow = outrow0 + (size_t)r32 * 1024 + h * 64 + 8 * hi;
#pragma unroll
    for (int dd = 0; dd < 2; ++dd)
#pragma unroll
        for (int k = 0; k < 2; ++k) { u32x2 w[2];
#pragma unroll
            for (int e = 0; e < 2; ++e) { const int gq = 2 * k + e; const f32x4 gv = *(const LAS f32x4*)(gain + h * 64 + 32 * dd + 8 * gq + 4 * hi);
                w[e].x = cvt_pk_bf16(o[dd][4 * gq] * rs * gv.x, o[dd][4 * gq + 1] * rs * gv.y); w[e].y = cvt_pk_bf16(o[dd][4 * gq + 2] * rs * gv.z, o[dd][4 * gq + 3] * rs * gv.w); }
            *(u32x4*)(orow + 32 * dd + 16 * k) = pair_halves(w[0], w[1]); }
}

constexpr float SB_THR = -40.f * 1.4426950408889634f;
__device__ __forceinline__ void sb_block(const bf16x8 (&kf)[4], const bf16x8 (&vf)[2][2], const LAS bf16x8* qp  , f32x16 (&o)[2], float& C, int key0, int tq0  , int r32, int hi) {
    f32x16 s;
#pragma unroll
    for (int r = 0; r < 16; ++r) s[r] = 0.f;
#pragma unroll
    for (int d0 = 0; d0 < 4; ++d0) s = MFMA32(kf[d0], qp[64 * d0], s);
    const int tqr = tq0 + r32, kk0 = key0 + 16 * hi;
    float pre[16]; float run = 0.f; float p[16];
    if (key0 + 31 >= tq0) {
#pragma unroll
        for (int r = 15; r >= 0; --r) {
            const float z = s[r] * (0.125f * 1.4426950408889634f);
            const float sp = fmaxf(z, 0.f) + __builtin_amdgcn_logf(1.0f + __builtin_amdgcn_exp2f(-fabsf(z)));
            pre[r] = (z - sp) + run;
            run += ((kk0 + r) < tqr) ? -sp : 0.f;
        }
        const float other = xor32_get(run, hi);
        const float base = C + (hi == 0 ? other : 0.f);
#pragma unroll
        for (int r = 0; r < 16; ++r) p[r] = ((kk0 + r) < tqr) ? __builtin_amdgcn_exp2f(pre[r] + base) : 0.f;
        C += run + other;
    } else {
#pragma unroll
        for (int r = 15; r >= 0; --r) {
            const float z = s[r] * (0.125f * 1.4426950408889634f);
            const float sp = fmaxf(z, 0.f) + __builtin_amdgcn_logf(1.0f + __builtin_amdgcn_exp2f(-fabsf(z)));
            pre[r] = (z - sp) + run;
            run -= sp;
        }
        const float other = xor32_get(run, hi);
        const float base = C + (hi == 0 ? other : 0.f);
#pragma unroll
        for (int r = 0; r < 16; ++r) p[r] = __builtin_amdgcn_exp2f(pre[r] + base);
        C += run + other;
    }
    const bf16x8 pa0 = pack8(p), pa1 = pack8(p + 8);
#pragma unroll
    for (int dd = 0; dd < 2; ++dd) { o[dd] = MFMA32(vf[dd][0], pa0, o[dd]); o[dd] = MFMA32(vf[dd][1], pa1, o[dd]); }
}
__device__ __forceinline__ void sb_unit(const Frame& F, int b, int tq, const bf16_t* sbq, const bf16_t* sbk, const bf16_t* sbvT, const LAS float* gain, bf16_t* mixed, LAS float* part, LAS unsigned char* lds) {
    int lane = F.lane; asm volatile("" : "+v"(lane));
    const int r32 = lane & 31, hi = lane >> 5, h = F.wave;
    const size_t rowbase = (size_t)b * SEQ; const int t0 = tq * 64;
    LAS bf16x8* qlds = (LAS bf16x8*)(lds + h * 8192) + lane;
    { bf16x8 qt[8];
#pragma unroll
      for (int i = 0; i < 8; ++i) qt[i] = *(const bf16x8*)(sbq + (rowbase + t0 + 32 * (i >> 2) + r32) * 512 + h * 64 + 16 * (i & 3) + 8 * hi);
#pragma unroll
      for (int i = 0; i < 8; ++i) qlds[64 * i] = qt[i]; }
    f32x16 o[2][2];
#pragma unroll
    for (int g = 0; g < 2; ++g)
#pragma unroll
        for (int dd = 0; dd < 2; ++dd)
#pragma unroll
            for (int r = 0; r < 16; ++r) o[g][dd][r] = 0.f;
    float C[2] = {0.f, 0.f};
    const bf16_t* kbase = sbk + (rowbase + pi32(r32)) * 512 + h * 64 + 8 * hi;
    const bf16_t* vbase = sbvT + ((size_t)(b * 8 + h) * 64 + r32) * SEQ + 16 * hi;
#define SB_LOAD(KF, VF, kb_) do { const int k0_ = (kb_) * 32; \
        _Pragma("unroll") for (int d0 = 0; d0 < 4; ++d0) KF[d0] = *(const bf16x8*)(kbase + (size_t)k0_ * 512 + 16 * d0); \
        _Pragma("unroll") for (int dd = 0; dd < 2; ++dd) _Pragma("unroll") for (int s_ = 0; s_ < 2; ++s_) VF[dd][s_] = *(const bf16x8*)(vbase + (size_t)(32 * dd) * SEQ + k0_ + 8 * s_); } while (0)
#define SB_STEP(KF, VF, kb_) do { const int k0_ = (kb_) * 32; \
        _Pragma("unroll") for (int g = 0; g < 2; ++g) { if (k0_ > t0 + 32 * g + 31) continue; if (__all(C[g] < SB_THR)) continue; sb_block(KF, VF, qlds + 256 * g, o[g], C[g], k0_, t0 + 32 * g, r32, hi); } } while (0)
    bf16x8 kfA[4], vfA[2][2], kfB[4], vfB[2][2];
    int kb = 2 * tq + 1;
    SB_LOAD(kfA, vfA, kb);
    for (;;) {
        SB_LOAD(kfB, vfB, kb >= 1 ? kb - 1 : 0);
        SB_STEP(kfA, vfA, kb);
        if (kb == 0 || __all(C[0] < SB_THR && C[1] < SB_THR)) break;
        SB_LOAD(kfA, vfA, kb >= 2 ? kb - 2 : 0);
        SB_STEP(kfB, vfB, kb - 1);
        if (kb == 1 || __all(C[0] < SB_THR && C[1] < SB_THR)) break;
        kb -= 2;
    }
#undef SB_LOAD
#undef SB_STEP
    group_norm_store(o[0], h, r32, hi, gain, mixed + (rowbase + t0) * 1024, part);
    group_norm_store(o[1], h, r32, hi, gain, mixed + (rowbase + t0 + 32) * 1024, part + 256);
}

constexpr int SW_KROW = 144, SW_VROW = 400;
constexpr int SW_KS = 0, SW_VT = 2 * 192 * SW_KROW, SW_END = SW_VT + 2 * 64 * SW_VROW;
template <bool INTERIOR>
__device__ __forceinline__ void swa_groups(const bf16x8 (&qraw0)[4], const bf16x8 (&qraw1)[4], int h, int kvh, int r32, int hi, int kstart, size_t rowbase, int t0, const LAS float* qgain, float sink, const LAS float* ogain,
                                           bf16_t* mixed, LAS unsigned char* lds, const LAS float* bias, LAS float* part) {
#pragma nounroll
    for (int g = 0; g < 2; ++g) {
        f32x16 o[2];
        bf16x8 qf[4];
        { float qv[4][8]; float ss = 0.f;
#pragma unroll
          for (int d0 = 0; d0 < 4; ++d0) { unpack8(g ? qraw1[d0] : qraw0[d0], qv[d0]);
#pragma unroll
              for (int jj = 0; jj < 8; ++jj) ss += qv[d0][jj] * qv[d0][jj]; }
          ss = xor32_add(ss);
          const float rs = (0.125f * 1.4426950408889634f) / sqrtf(ss * (1.f / 64.f) + EPS);
#pragma unroll
          for (int d0 = 0; d0 < 4; ++d0) { const f32x4 g0 = *(const LAS f32x4*)(qgain + 16 * d0 + 8 * hi), g1 = *(const LAS f32x4*)(qgain + 16 * d0 + 8 * hi + 4);
              float qn[8] = {qv[d0][0] * rs * g0.x, qv[d0][1] * rs * g0.y, qv[d0][2] * rs * g0.z, qv[d0][3] * rs * g0.w, qv[d0][4] * rs * g1.x, qv[d0][5] * rs * g1.y, qv[d0][6] * rs * g1.z, qv[d0][7] * rs * g1.w};
              qf[d0] = pack8(qn); } }
        f32x16 sc[5];
        const int qw = 128 + 32 * g + r32;
#pragma unroll
        for (int jb = 0; jb < 5; ++jb) {
            const LAS unsigned char* kp = lds + SW_KS + (kvh * 192 + 32 * (g + jb) + pi32(r32)) * SW_KROW + 16 * hi;
#pragma unroll
            for (int r = 0; r < 16; ++r) sc[jb][r] = 0.f;
#pragma unroll
            for (int d0 = 0; d0 < 4; ++d0) sc[jb] = MFMA32(*(const LAS bf16x8*)(kp + 32 * d0), qf[d0], sc[jb]);
        }
        float m = sink;
#pragma unroll
        for (int jb = 0; jb < 5; ++jb) {
            const int kb = g + jb;
            const LAS float* bt = bias + h * 128 + (qw - 32 * kb - 16 * hi - 15);
            float bv[16];
#pragma unroll
            for (int r = 0; r < 16; ++r) bv[r] = bt[15 - r];
            const int d0_ = qw - 32 * kb - 16 * hi;
            if constexpr (INTERIOR) {
#pragma unroll
                for (int r = 0; r < 16; ++r) { const bool valid = (jb == 0) ? (d0_ - r < 128) : (jb == 4) ? (d0_ - r >= 0) : true;
                    const float v = valid ? sc[jb][r] + bv[r] : -INFINITY; sc[jb][r] = v; m = fmaxf(m, v); }
            } else {
#pragma unroll
                for (int r = 0; r < 16; ++r) { const int kw = 32 * kb + 16 * hi + r, dist = d0_ - r; const bool valid = (dist >= 0) && (dist < 128) && (kstart + kw >= 0);
                    const float v = valid ? sc[jb][r] + bv[r] : -INFINITY; sc[jb][r] = v; m = fmaxf(m, v); }
            }
        }
        m = xor32_max(m);
        float l = 0.f;
#pragma unroll
        for (int jb = 0; jb < 5; ++jb)
#pragma unroll
            for (int r = 0; r < 16; ++r) { const float p = __builtin_amdgcn_exp2f(sc[jb][r] - m); sc[jb][r] = p; l += p; }
        l = xor32_add(l); l += __builtin_amdgcn_exp2f(sink - m);
#pragma unroll
        for (int dd = 0; dd < 2; ++dd)
#pragma unroll
            for (int r = 0; r < 16; ++r) o[dd][r] = 0.f;
#pragma unroll
        for (int jb = 0; jb < 5; ++jb) {
            const int kb = g + jb;
            float p[16];
#pragma unroll
            for (int r = 0; r < 16; ++r) p[r] = sc[jb][r];
            const bf16x8 pa0 = pack8(p), pa1 = pack8(p + 8);
#pragma unroll
            for (int dd = 0; dd < 2; ++dd) { const LAS unsigned char* vp = lds + SW_VT + (kvh * 64 + 32 * dd + r32) * SW_VROW; const int vsw = (4 * dd + (r32 >> 3)) & 7, vc = 4 * kb + 2 * hi;
                o[dd] = MFMA32(*(const LAS bf16x8*)(vp + ((vc ^ vsw) << 4)), pa0, o[dd]); o[dd] = MFMA32(*(const LAS bf16x8*)(vp + (((vc + 1) ^ vsw) << 4)), pa1, o[dd]); }
        }
        const float inv = 1.0f / l;
#pragma unroll
        for (int dd = 0; dd < 2; ++dd)
#pragma unroll
            for (int r = 0; r < 16; ++r) o[dd][r] *= inv;
        group_norm_store(o, h, r32, hi, ogain, mixed + (rowbase + t0 + 32 * g) * 1024 + 512, part + 256 * g);
    }
}
__device__ __forceinline__ void swa_unit(const Frame& F, int b, int tq, const bf16_t* swq, const bf16_t* swkv, const LAS float* qgain, const LAS float* kgain, const LAS float* sinks, const LAS float* ogain,
                                         bf16_t* mixed, LAS unsigned char* lds, const LAS float* bias, LAS float* part) {
    int tid = F.tid; asm volatile("" : "+v"(tid));
    const int lane = tid & 63, r32 = lane & 31, hi = lane >> 5, h = F.wave, kvh = h >> 2;
    const size_t rowbase = (size_t)b * SEQ; const int t0 = tq * 64, kstart = t0 - 128;
    bf16x8 qraw0[4], qraw1[4];
#pragma unroll
    for (int d0 = 0; d0 < 4; ++d0) { qraw0[d0] = *(const bf16x8*)(swq + (rowbase + t0 + r32) * 512 + h * 64 + 16 * d0 + 8 * hi); qraw1[d0] = *(const bf16x8*)(swq + (rowbase + t0 + 32 + r32) * 512 + h * 64 + 16 * d0 + 8 * hi); }
    bf16x8 kraw[6], vraw[6];
#pragma unroll
    for (int i = 0; i < 6; ++i) {
        const int c = tid + 512 * i, row = c >> 3, p8 = c & 7, kv = row / 192, j = row - kv * 192, spos = kstart + j;
        const bf16_t* src = swkv + (rowbase + (spos > 0 ? spos : 0)) * 256 + kv * 64 + 8 * p8; kraw[i] = *(const bf16x8*)src; vraw[i] = *(const bf16x8*)(src + 128);
    }
#pragma unroll
    for (int i = 0; i < 6; ++i) {
        const int c = tid + 512 * i, row = c >> 3, p8 = c & 7, kv = row / 192, j = row - kv * 192, spos = kstart + j;
        float kfv[8]; unpack8(kraw[i], kfv); bf16x8 vr = vraw[i];
        if (spos < 0) {
#pragma unroll
            for (int jj = 0; jj < 8; ++jj) { kfv[jj] = 0.f; vr[jj] = 0; } }
        float ss = 0.f;
#pragma unroll
        for (int jj = 0; jj < 8; ++jj) ss += kfv[jj] * kfv[jj];
        ss += lane_xor<1>(ss); ss += lane_xor<2>(ss); ss += lane_xor<4>(ss);
        const float rs = 1.0f / sqrtf(ss * (1.f / 64.f) + EPS);
        const f32x4 g0 = *(const LAS f32x4*)(kgain + 8 * p8), g1 = *(const LAS f32x4*)(kgain + 8 * p8 + 4);
        float kn[8] = {kfv[0] * rs * g0.x, kfv[1] * rs * g0.y, kfv[2] * rs * g0.z, kfv[3] * rs * g0.w, kfv[4] * rs * g1.x, kfv[5] * rs * g1.y, kfv[6] * rs * g1.z, kfv[7] * rs * g1.w};
        *(LAS bf16x8*)(lds + SW_KS + (kv * 192 + j) * SW_KROW + 16 * p8) = pack8(kn);
#pragma unroll
        for (int jj = 0; jj < 8; ++jj) *(LAS short*)(lds + SW_VT + (kv * 64 + 8 * p8 + jj) * SW_VROW + ((((j >> 3) ^ p8) << 4) + 2 * (j & 7))) = vr[jj];
    }
    __syncthreads();
    const float sink = sinks[h] * 1.4426950408889634f;
    if (kstart >= 0) swa_groups<true>(qraw0, qraw1, h, kvh, r32, hi, kstart, rowbase, t0, qgain, sink, ogain, mixed, lds, bias, part);
    else             swa_groups<false>(qraw0, qraw1, h, kvh, r32, hi, kstart, rowbase, t0, qgain, sink, ogain, mixed, lds, bias, part);
}

__device__ __forceinline__ void xattn_stage(const Frame& F, int b, int hx, const bf16_t* kn, const bf16_t* vt, LAS unsigned char* lds) {
    int tid = F.tid; asm volatile("" : "+v"(tid));
    { const bf16_t* ksrc = kn + (size_t)(b * NMEM) * 512 + hx * 128; const bf16_t* vsrc = vt + (size_t)((b * 4 + hx) * 128) * NMEM;
#pragma unroll
      for (int half = 0; half < 2; ++half) { u32x4 kv[4], vv[4];
#pragma unroll
          for (int i = 0; i < 4; ++i) { const int c = tid + 512 * (half * 4 + i);
              const int krow = c >> 4, kch = c & 15; kv[i] = *(const u32x4*)(ksrc + (size_t)krow * 512 + kch * 8);
              const int vrow = c >> 5, vch = c & 31; vv[i] = *(const u32x4*)(vsrc + (size_t)vrow * NMEM + vch * 8); }
#pragma unroll
          for (int i = 0; i < 4; ++i) { const int c = tid + 512 * (half * 4 + i);
              const int krow = c >> 4, kch = c & 15; *(LAS u32x4*)(lds + krow * 256 + ((kch ^ (krow & 15)) << 4)) = kv[i];
              const int vrow = c >> 5, vch = c & 31; *(LAS u32x4*)(lds + 65536 + vrow * 512 + ((vch ^ (vrow & 31)) << 4)) = vv[i]; } } }
}
__device__ __forceinline__ void xattn_tile(const Frame& F, int b, int hx, int qt, const bf16_t* xq, const LAS float* qgain  , bf16_t* xo, LAS unsigned char* lds) {
    int tid = F.tid; asm volatile("" : "+v"(tid));
    const int lane = tid & 63, r32 = lane & 31, hi = lane >> 5, w = F.wave;
    const size_t row = (size_t)b * SEQ + qt * 256 + 32 * w + r32;
    bf16x8 qf[8];
    { float ss = 0.f; float qv[8][8];
#pragma unroll
      for (int d0 = 0; d0 < 8; ++d0) { unpack8(*(const bf16x8*)(xq + row * 512 + hx * 128 + 16 * d0 + 8 * hi), qv[d0]);
#pragma unroll
          for (int jj = 0; jj < 8; ++jj) ss += qv[d0][jj] * qv[d0][jj]; }
      ss = xor32_add(ss);
      const float rs = (0.08838834764831845f * 1.4426950408889634f) / sqrtf(ss * (1.f / 128.f) + EPS);
#pragma unroll
      for (int d0 = 0; d0 < 8; ++d0) { const f32x4 g0 = *(const LAS f32x4*)(qgain + 16 * d0 + 8 * hi), g1 = *(const LAS f32x4*)(qgain + 16 * d0 + 8 * hi + 4);
          float qn[8] = {qv[d0][0] * rs * g0.x, qv[d0][1] * rs * g0.y, qv[d0][2] * rs * g0.z, qv[d0][3] * rs * g0.w, qv[d0][4] * rs * g1.x, qv[d0][5] * rs * g1.y, qv[d0][6] * rs * g1.z, qv[d0][7] * rs * g1.w};
          qf[d0] = pack8(qn); } }
    f32x16 o[4];
#pragma unroll
    for (int dd = 0; dd < 4; ++dd)
#pragma unroll
        for (int r = 0; r < 16; ++r) o[dd][r] = 0.f;
    float m = -INFINITY, l = 0.f;
    const int pk = pi32(r32);
#define XA_QK(S_, kb_) do { const int krow = 32 * (kb_) + pk; const LAS unsigned char* kp = lds + krow * 256; const int ksw = krow & 15; \
        _Pragma("unroll") for (int r = 0; r < 16; ++r) S_[r] = 0.f; \
        _Pragma("unroll") for (int d0 = 0; d0 < 8; ++d0) S_ = MFMA32(*(const LAS bf16x8*)(kp + (((2 * d0 + hi) ^ ksw) << 4)), qf[d0], S_); } while (0)
    f32x16 s, sn;
    XA_QK(s, 0);
#pragma nounroll
    for (int kb = 0; kb < 8; ++kb) {
        XA_QK(sn, (kb < 7 ? kb + 1 : 7));
        float rm = s[0];
#pragma unroll
        for (int r = 1; r < 16; ++r) rm = fmaxf(rm, s[r]);
        rm = xor32_max(rm);
        const bool resc = __any(rm > m + 8.0f);
        float f = 1.0f;
        if (resc) { const float mn = fmaxf(m, rm); f = __builtin_amdgcn_exp2f(m - mn); m = mn; l *= f; }
        float p[16]; float ls = 0.f;
#pragma unroll
        for (int r = 0; r < 16; ++r) { p[r] = __builtin_amdgcn_exp2f(s[r] - m); ls += p[r]; }
        l += ls;
        const bf16x8 pa0 = pack8(p), pa1 = pack8(p + 8);
#pragma unroll
        for (int dd = 0; dd < 4; ++dd) {
            if (resc) {
#pragma unroll
                for (int r = 0; r < 16; ++r) o[dd][r] *= f; }
            const int vrow = 32 * dd + r32; const LAS unsigned char* vp = lds + 65536 + vrow * 512; const int vsw = vrow & 31, vc = 4 * kb + 2 * hi;
            o[dd] = MFMA32(*(const LAS bf16x8*)(vp + ((vc ^ vsw) << 4)), pa0, o[dd]); o[dd] = MFMA32(*(const LAS bf16x8*)(vp + (((vc + 1) ^ vsw) << 4)), pa1, o[dd]); }
        s = sn;
    }
#undef XA_QK
    l = xor32_add(l);
    const float inv = 1.0f / l;
    bf16_t* orow = xo + row * 512 + hx * 128 + 8 * hi;
#pragma unroll
    for (int dd = 0; dd < 4; ++dd)
#pragma unroll
        for (int k = 0; k < 2; ++k) { u32x2 w[2];
#pragma unroll
            for (int e = 0; e < 2; ++e) { const int gq = 2 * k + e; w[e].x = cvt_pk_bf16(o[dd][4 * gq] * inv, o[dd][4 * gq + 1] * inv); w[e].y = cvt_pk_bf16(o[dd][4 * gq + 2] * inv, o[dd][4 * gq + 3] * inv); }
            *(u32x4*)(orow + 32 * dd + 16 * k) = pair_halves(w[0], w[1]); }
}

using pg8::Unit; using pg8::Out;
__device__ __forceinline__ float* ssq_slot(unsigned char* ws, int s) { return (float*)(ws + WS_SSQ) + (size_t)s * T * 4; }
struct SchedWin {
    int G, c, l; unsigned char* ws;
    __device__ __forceinline__ bool next(int i, Unit& u) const {
        const int L = i * G + c; if (L >= 256 * 9) return false; int pm, pn; pg8::tile_of(L, 256, 9, pm, pn); u.pm = pm; u.pn = pn;
        const char* arow = (const char*)(ws + WS_XQW) + (size_t)pm * 256 * 1024; const char* brow = (const char*)(ws + WS_WIN) + ((size_t)l * 2304 + pn * 256) * 1024;
        const float* asc = (const float*)(ws + WS_WSC + SC_ROWW) + (size_t)pm * 256; const float* bsc = (const float*)(ws + WS_WSC + SC_WIN) + (size_t)l * 2304 + pn * 256;
        if ((pn >> 1) == 2) { u.a = brow; u.b = arow; u.sc = bsc; u.sc2 = asc; } else { u.a = arow; u.b = brow; u.sc = asc; u.sc2 = bsc; }
        return true;
    }
    __device__ __forceinline__ void out(const Unit& u, Out& e) const {
        const int pm = u.pm, pn = u.pn; char* proj = (char*)(ws + WS_PROJ); e.r = nullptr; e.xb = nullptr; e.ssq = nullptr; e.scmode = 1;
        if (pn == 4 || pn == 5) { const int b = pm >> 3, t0 = (pm & 7) * 256; e.o = proj + PJ_SBVT + ((size_t)((b * 8 + 4 * (pn - 4)) * 64) * SEQ + t0) * 2; e.ldo = SEQ; }
        else if (pn < 2) { e.o = proj + PJ_SBQ + ((size_t)pm * 256 * 512 + pn * 256) * 2; e.ldo = 512; }
        else if (pn < 4) { e.o = proj + PJ_SBK + ((size_t)pm * 256 * 512 + (pn - 2) * 256) * 2; e.ldo = 512; }
        else if (pn < 8) { e.o = proj + PJ_SWQ + ((size_t)pm * 256 * 512 + (pn - 6) * 256) * 2; e.ldo = 512; }
        else             { e.o = proj + PJ_SWKV + ((size_t)pm * 256 * 256) * 2; e.ldo = 256; }
    }
};
struct SchedRes {
    int G, c, l, which; unsigned char* ws;
    __device__ __forceinline__ bool next(int i, Unit& u) const {
        const int L = i * G + c; if (L >= 1024) return false; int pm, pn; pg8::tile_of(L, 256, 4, pm, pn); u.pm = pm; u.pn = pn; u.sc = nullptr; u.sc2 = nullptr;
        if (which == 0) { u.a = (const char*)(ws + WS_YS) + (size_t)pm * 256 * 1024 * 2; u.b = (const char*)(ws + WS_WOUT) + ((size_t)l * 1024 + pn * 256) * 1024 * 2; }
        else            { u.a = (const char*)(ws + WS_PROJ + PJ_XO) + (size_t)pm * 256 * 512 * 2; u.b = (const char*)(ws + WS_WO) + ((size_t)l * 1024 + pn * 256) * 512 * 2; }
        return true;
    }
    __device__ __forceinline__ void out(const Unit& u, Out& e) const {
        const size_t eoff = (size_t)u.pm * 256 * 1024 + u.pn * 256; e.o = nullptr; e.r = nullptr; e.ldo = 1024; e.scmode = 0;
        e.xb = (bf16_t*)(ws + WS_XB) + eoff; e.ssq = ssq_slot(ws, 3 * l + 1 + which) + (size_t)u.pm * 256 * 4 + u.pn;
    }
};
struct SchedWq {
    int G, c, l; unsigned char* ws;
    __device__ __forceinline__ bool next(int i, Unit& u) const {
        const int L = i * G + c; if (L >= 512) return false; int pm, pn; pg8::tile_of(L, 256, 2, pm, pn); u.pm = pm; u.pn = pn;
        u.a = (const char*)(ws + WS_XB) + (size_t)pm * 256 * 1024 * 2; u.b = (const char*)(ws + WS_WQ) + ((size_t)l * 512 + pn * 256) * 1024 * 2; u.sc = ssq_slot(ws, 3 * l + 1) + (size_t)pm * 256 * 4; u.sc2 = nullptr; return true;
    }
    __device__ __forceinline__ void out(const Unit& u, Out& e) const { e.o = (char*)(ws + WS_PROJ + PJ_XQ) + ((size_t)u.pm * 256 * 512 + u.pn * 256) * 2; e.r = nullptr; e.ldo = 512; e.xb = nullptr; e.ssq = nullptr; e.scmode = 1; }
};
struct SchedKV {
    int G, c; unsigned char* ws;
    __device__ __forceinline__ bool next(int i, Unit& u) const {
        const int L = i * G + c; if (L >= 512) return false; const int l = L >> 7, rem = L & 127; u.pm = L; u.pn = 0; u.sc = nullptr; u.sc2 = nullptr;
        const char* hml = (const char*)(ws + WS_PROJ + PJ_HM) + (size_t)l * 8192 * 1024 * 2; const char* wl = (const char*)(ws + WS_WKV) + (size_t)l * 1024 * 1024 * 2;
        if (rem < 64) { const int pm = rem >> 1, pn = rem & 1; u.a = hml + (size_t)pm * 256 * 1024 * 2; u.b = wl + (size_t)pn * 256 * 1024 * 2; }
        else { const int r2 = rem - 64, bb = r2 >> 1, dt = r2 & 1; u.a = wl + (size_t)(512 + dt * 256) * 1024 * 2; u.b = hml + (size_t)bb * 256 * 1024 * 2; }
        return true;
    }
    __device__ __forceinline__ void out(const Unit& u, Out& e) const {
        const int L = u.pm, l = L >> 7, rem = L & 127; e.r = nullptr; e.xb = nullptr; e.ssq = nullptr; e.scmode = 0;
        if (rem < 64) { const int pm = rem >> 1, pn = rem & 1; e.o = (char*)(ws + WS_YS) + (size_t)l * 8192 * 512 * 2 + ((size_t)pm * 256 * 512 + pn * 256) * 2; e.ldo = 512; }
        else { const int r2 = rem - 64, bb = r2 >> 1, dt = r2 & 1; e.o = (char*)(ws + WS_VT) + (size_t)l * 8192 * 512 * 2 + ((size_t)(bb * 4 + 2 * dt) * 128 * 256) * 2; e.ldo = 256; }
    }
};
struct SchedGU {
    int G, c, nM, ch, l; unsigned char* ws; const LAS int* pblk;
    __device__ __forceinline__ bool next(int i, Unit& u) const {
        const int L = i * G + c; if (L >= nM * 28) return false; int pm, pn; pg8::tile_of(L, nM, 28, pm, pn); u.pm = pm; u.pn = pn;
        if (pblk) { const int blk = ch * CHUNK_BLK + pm; int e = 0;
#pragma unroll
            for (int k = 1; k < 8; ++k) e += (pblk[k] <= blk) ? 1 : 0;
            e = __builtin_amdgcn_readfirstlane(e);
            u.a = (const char*)(ws + WS_PROJ + PJ_GB) + (size_t)(ch & 1) * GB_BUF + (size_t)pm * 256 * 1024; u.b = (const char*)(ws + WS_EGU) + ((size_t)e * 7168 + pn * 256) * 1024;
            u.sc = (const float*)(ws + WS_WSC + SC_SROW) + ((size_t)ch * CHUNK_BLK + pm) * 256; u.sc2 = (const float*)(ws + WS_WSC + SC_WE) + (size_t)e * 7168 + pn * 256; }
        else { const size_t row0 = ((size_t)ch * CHUNK_BLK + pm) * 256;
            u.a = (const char*)(ws + WS_PROJ + PJ_XQ8) + row0 * 1024; u.b = (const char*)(ws + WS_WGU) + ((size_t)(l >> 1) * 7168 + pn * 256) * 1024;
            u.sc = (const float*)(ws + WS_WSC + SC_ROW) + row0; u.sc2 = (const float*)(ws + WS_WSC + SC_WD) + (size_t)(l >> 1) * 7168 + pn * 256; }
        return true;
    }
    __device__ __forceinline__ void out(const Unit& u, Out& e) const { e.o = (char*)(ws + WS_PROJ + PJ_H) + (size_t)(ch & 1) * H_BUF + ((size_t)u.pm * 256 * FF + u.pn * 128); e.r = nullptr; e.ldo = FF; e.xb = nullptr; e.ssq = nullptr; e.scmode = 1; }
};
struct SchedDown {
    int G, c, nM, ch, l; unsigned char* ws; const LAS int* pblk;
    __device__ __forceinline__ bool next(int i, Unit& u) const {
        const int L = i * G + c; if (L >= nM * 4) return false; int pm, pn; pg8::tile_of(L, nM, 4, pm, pn); u.pm = pm; u.pn = pn; u.sc = nullptr; u.sc2 = nullptr;
        int e = 0; if (pblk) { const int blk = ch * CHUNK_BLK + pm;
#pragma unroll
            for (int k = 1; k < 8; ++k) e += (pblk[k] <= blk) ? 1 : 0;
            e = __builtin_amdgcn_readfirstlane(e); }
        u.a = (const char*)(ws + WS_PROJ + PJ_H) + (size_t)(ch & 1) * H_BUF + (size_t)pm * 256 * FF;
        u.b = (pblk ? (const char*)(ws + WS_EDN) + (size_t)e * 1024 * FF : (const char*)(ws + WS_WDN) + (size_t)(l >> 1) * 1024 * FF) + (size_t)pn * 256 * FF; return true;
    }
    __device__ __forceinline__ void out(const Unit& u, Out& e) const {
        const size_t eoff = ((size_t)ch * CHUNK_BLK + u.pm) * 256 * 1024 + u.pn * 256; e.ldo = 1024; e.scmode = 0;
        if (pblk) { e.o = (char*)((bf16_t*)(ws + WS_YS) + eoff); e.r = nullptr; e.xb = nullptr; e.ssq = nullptr; }
        else { e.o = nullptr; e.r = nullptr; e.xb = (bf16_t*)(ws + WS_XB) + eoff; e.ssq = ssq_slot(ws, 3 * l + 3) + ((size_t)ch * CHUNK_BLK + u.pm) * 256 * 4 + u.pn; }
    }
};

__constant__ unsigned char T5B[128] = {0,1,2,3,4,5,6,7,8,9,10,11,12,13,14,15,16,16,16,17,17,18,18,18,19,19,19,20,20,20,20,21,21,21,21,22,22,22,22,22,23,23,23,23,23,23,24,24,24,24,24,24,25,25,25,25,25,25,25,26,26,26,26,26,26,26,26,27,27,27,27,27,27,27,27,27,27,28,28,28,28,28,28,28,28,28,28,29,29,29,29,29,29,29,29,29,29,29,29,30,30,30,30,30,30,30,30,30,30,30,30,30,30,31,31,31,31,31,31,31,31,31,31,31,31,31,31,31};

__device__ __forceinline__ void moe_meta(const Frame& F, unsigned* gcnt, LAS int* meta) {
    __syncthreads();
    if (F.tid < 8) meta[F.tid] = (int)__hip_atomic_load(gcnt + 64 * F.tid, __ATOMIC_RELAXED, __HIP_MEMORY_SCOPE_AGENT);
    __syncthreads();
    if (F.tid == 0) { int pre = 0;
        for (int e = 0; e < 8; ++e) { meta[8 + e] = pre; pre += (meta[e] + 255) >> 8; }
        meta[16] = pre; }
    __syncthreads();
}
__device__ __forceinline__ int expert_of_blk(const LAS int* pblk, int blk) { int e = 0;
#pragma unroll
    for (int k = 1; k < 8; ++k) e += (pblk[k] <= blk) ? 1 : 0;
    return e; }

__device__ __forceinline__ float lane_max16(float v) { v = fmaxf(v, lane_xor<1>(v)); v = fmaxf(v, lane_xor<2>(v)); v = fmaxf(v, lane_xor<4>(v)); return fmaxf(v, lane_xor<8>(v)); }
__device__ __forceinline__ float wave_max(float v) { v = lane_max16(v); v = fmaxf(v, lane_xor<16>(v)); return xor32_max(v); }
__device__ __forceinline__ unsigned q4(float a, float b, float c, float d, float inv) {
    const int qa = (int)rintf(a * inv), qb = (int)rintf(b * inv), qc = (int)rintf(c * inv), qd = (int)rintf(d * inv);
    return (unsigned)(qa & 255) | ((unsigned)(qb & 255) << 8) | ((unsigned)(qc & 255) << 16) | ((unsigned)(qd & 255) << 24);
}
struct StripDesc { const float* src; const float* gain; signed char* W8; float* wscale; int N, dr0; };
__device__ __forceinline__ void strip_issue(const Frame& F, const StripDesc& d, f32x4 (&wv)[16], float (&gk)[16]) {
    const int kk = F.tid >> 3, n4 = (F.tid & 7) * 4;
#pragma unroll
    for (int p = 0; p < 16; ++p) wv[p] = *(const f32x4*)(d.src + (size_t)(p * 64 + kk) * d.N + n4);
#pragma unroll
    for (int p = 0; p < 16; ++p) gk[p] = d.gain[p * 64 + kk];
}
__device__ __forceinline__ void strip_to_lds(const Frame& F, const f32x4 (&wv)[16], const float (&gk)[16]) {
    constexpr int SP = 1028; LAS float* st = (LAS float*)F.lds; const int kk = F.tid >> 3, n4 = (F.tid & 7) * 4;
#pragma unroll
    for (int p = 0; p < 16; ++p) { const int k = p * 64 + kk; const float g = gk[p];
        st[(n4 + 0) * SP + k] = wv[p].x * g; st[(n4 + 1) * SP + k] = wv[p].y * g; st[(n4 + 2) * SP + k] = wv[p].z * g; st[(n4 + 3) * SP + k] = wv[p].w * g; }
}
__device__ __forceinline__ void strip_quant(const Frame& F, const StripDesc& d) {
    constexpr int SP = 1028; LAS float* st = (LAS float*)F.lds;
    const int n = F.tid >> 4, cch = F.tid & 15; const LAS f32x4* row = (const LAS f32x4*)(st + n * SP + cch * 64);
    f32x4 v[16]; float mx = 0.f;
#pragma unroll
    for (int j = 0; j < 16; ++j) { v[j] = row[j]; mx = fmaxf(mx, fmaxf(fmaxf(fabsf(v[j].x), fabsf(v[j].y)), fmaxf(fabsf(v[j].z), fabsf(v[j].w)))); }
    mx = lane_max16(mx);
    const float sc = mx > 0.f ? mx * (1.f / 127.f) : 1.f, inv = 1.0f / sc; const int dr = d.dr0 + n;
    u32x4* dst = (u32x4*)(d.W8 + (size_t)dr * 1024 + cch * 64);
#pragma unroll
    for (int j = 0; j < 4; ++j) { u32x4 w; w.x = q4(v[4 * j].x, v[4 * j].y, v[4 * j].z, v[4 * j].w, inv); w.y = q4(v[4 * j + 1].x, v[4 * j + 1].y, v[4 * j + 1].z, v[4 * j + 1].w, inv);
        w.z = q4(v[4 * j + 2].x, v[4 * j + 2].y, v[4 * j + 2].z, v[4 * j + 2].w, inv); w.w = q4(v[4 * j + 3].x, v[4 * j + 3].y, v[4 * j + 3].z, v[4 * j + 3].w, inv); dst[j] = w; }
    if (cch == 0) d.wscale[dr] = sc;
}
template <class DescFn>
__device__ __forceinline__ void convert_strip_list(const Frame& F, int nstrips, DescFn desc) {
    int fs = F.bx; if (fs >= nstrips) return;
    StripDesc d = desc(fs); f32x4 wv[16]; float gk[16]; strip_issue(F, d, wv, gk);
#pragma nounroll
    for (;;) {
        strip_to_lds(F, wv, gk);
        __syncthreads();
        const int nx = fs + F.G; const bool more = nx < nstrips; StripDesc dn = d;
        if (more) { dn = desc(nx); strip_issue(F, dn, wv, gk); }
        strip_quant(F, d);
        __syncthreads();
        if (!more) break;
        d = dn; fs = nx;
    }
}
__device__ __forceinline__ float quant_regs_i8(const u32x2 (&xw)[4], signed char* qrow, int lane) {
    f32x4 v[4]; float mx = 0.f;
#pragma unroll
    for (int j = 0; j < 4; ++j) { const u32x2 w = xw[j]; v[j] = (f32x4){bf_lo(w.x), bf_hi(w.x), bf_lo(w.y), bf_hi(w.y)}; mx = fmaxf(mx, fmaxf(fmaxf(fabsf(v[j].x), fabsf(v[j].y)), fmaxf(fabsf(v[j].z), fabsf(v[j].w)))); }
    mx = wave_max(mx);
    const float sc = mx > 0.f ? mx * (1.f / 127.f) : 1.f, inv = 1.0f / sc;
    unsigned* q = (unsigned*)qrow + lane;
#pragma unroll
    for (int j = 0; j < 4; ++j) q[64 * j] = q4(v[j].x, v[j].y, v[j].z, v[j].w, inv);
    return sc;
}
__device__ __forceinline__ void load_row4(u32x2 (&xw)[4], const bf16_t* xrow, int lane) { const u32x2* xr = (const u32x2*)xrow + lane;
#pragma unroll
    for (int j = 0; j < 4; ++j) xw[j] = xr[64 * j]; }
__device__ __forceinline__ void quant_pass(const Frame& F, const bf16_t* xb, const float* sq, signed char* xq, float* rowsc) {
    const int gw = F.bx * NWAVES + F.wave, NGW = F.G * NWAVES;
    if (gw >= T) return;
#define QP_LOAD(XW, SP, m0_) do { _Pragma("unroll") for (int i = 0; i < 4; ++i) { const int m_ = (m0_) + i * NGW, mm_ = m_ < T ? m_ : gw; load_row4(XW[i], xb + (size_t)mm_ * D, F.lane); SP[i] = *(const f32x4*)(sq + (size_t)mm_ * 4); } } while (0)
#define QP_DO(XW, SP, m0_) do { _Pragma("unroll") for (int i = 0; i < 4; ++i) { const int m_ = (m0_) + i * NGW; if (m_ < T) { const float sc_ = quant_regs_i8(XW[i], xq + (size_t)m_ * D, F.lane); \
            if (F.lane == 0) rowsc[m_] = sc_ / sqrtf(((SP[i].x + SP[i].y) + (SP[i].z + SP[i].w)) * (1.f / 1024.f) + EPS); } } } while (0)
    u32x2 xa[4][4], xb2[4][4]; f32x4 spa[4], spb[4];
    int m0 = gw; const int step = 4 * NGW;
    QP_LOAD(xa, spa, m0);
    for (;;) {
        QP_LOAD(xb2, spb, m0 + step);
        QP_DO(xa, spa, m0);
        m0 += step; if (m0 >= T) break;
        QP_LOAD(xa, spa, m0 + step);
        QP_DO(xb2, spb, m0);
        m0 += step; if (m0 >= T) break;
    }
#undef QP_LOAD
#undef QP_DO
}
__device__ __forceinline__ void moe_gather(const Frame& F0, int c, int nbtot, const LAS int* meta, const int* mlist, const bf16_t* xb, const float* ssq, float* srow, char* proj) {
    const LAS int* pblk = meta + 8; const int gw = F0.bx * NWAVES + F0.wave, NGW = F0.G * NWAVES;
    const int r0 = c * CHUNK_BLK * 256, r1 = min((c + 1) * CHUNK_BLK * 256, nbtot * 256); signed char* dst0 = (signed char*)(proj + PJ_GB + (size_t)(c & 1) * GB_BUF);
    for (int rb = r0 + gw; rb < r1; rb += 8 * NGW) {
        int tokj = -1; int ln_ = F0.lane; asm volatile("" : "+v"(ln_)); Frame F = F0; F.lane = ln_;
        { const int r = rb + (F.lane & 7) * NGW; if (F.lane < 8 && r < r1) { const int blk = r >> 8, e = expert_of_blk(pblk, blk), pos = r - pblk[e] * 256; if (pos < meta[e]) tokj = mlist[(size_t)e * T + pos]; } }
#pragma unroll
        for (int h4 = 0; h4 < 2; ++h4) {
            u32x2 xw[4][4]; int tk[4]; f32x4 sp[4];
#pragma unroll
            for (int i = 0; i < 4; ++i) { tk[i] = __builtin_amdgcn_readlane(tokj, h4 * 4 + i); if (tk[i] >= 0) { load_row4(xw[i], xb + (size_t)tk[i] * D, F.lane); sp[i] = *(const f32x4*)(ssq + (size_t)tk[i] * 4); } }
#pragma unroll
            for (int i = 0; i < 4; ++i) { const int j = h4 * 4 + i, r = rb + j * NGW; if (r < r1) { signed char* d = dst0 + (size_t)(r - r0) * D;
                if (tk[i] >= 0) { const float sc = quant_regs_i8(xw[i], d, F.lane); if (F.lane == 0) srow[r] = sc / sqrtf(((sp[i].x + sp[i].y) + (sp[i].z + sp[i].w)) * (1.f / 1024.f) + EPS); }
                else { unsigned* q = (unsigned*)d + F.lane;
#pragma unroll
                    for (int jj = 0; jj < 4; ++jj) q[64 * jj] = 0u;
                    if (F.lane == 0) srow[r] = 0.f; } } }
        }
    }
}

template <class RowMap>
__device__ __forceinline__ void convert_job_f8(const Frame& F, const float* W, int K, int N, unsigned char* WT, const RowMap& rm) {
    LAS float* scr = (LAS float*)(F.lds + F.wave * 8448);
    const int gw = F.bx * NWAVES + F.wave, NGW = F.G * NWAVES, nitems = (K / 64) * (N / 32);
    int ln = F.lane; asm volatile("" : "+v"(ln));
#pragma nounroll
    for (int it = gw; it < nitems; it += NGW) transpose_item_f8(W, K, N, WT, rm, scr, it, ln);
}
template <class RowMap>
__device__ __forceinline__ void convert_job(const Frame& F, const float* W, int K, int N, bf16_t* WT, const RowMap& rm) {
    LAS float* scr = (LAS float*)(F.lds + F.wave * 8448);
    const int gw = F.bx * NWAVES + F.wave, NGW = F.G * NWAVES, nitems = (K / 64) * (N / 32);
    int ln = F.lane; asm volatile("" : "+v"(ln));
#pragma nounroll
    for (int it = gw; it < nitems; it += NGW) transpose_item(W, K, N, WT, rm, scr, it, ln);
}

constexpr int PH_PRO0 = 0, PH_PRO1 = 1, PH_L0 = 2, NPL = 9, N_PHASES = PH_L0 + DEPTH * NPL;
#ifndef PROBE_DUP
#define PROBE_DUP 0
#endif
typedef const Params __attribute__((address_space(4))) CParams;
__device__ __forceinline__ CParams* get_params() { CParams* p = (CParams*)__builtin_amdgcn_kernarg_segment_ptr(); asm volatile("" : "+s"(p)); return p; }
#define PIN(i) ((const float*)pp->in[i])

__global__ void __launch_bounds__(NTHR, 2) fwd_kernel(Params P_unused) {
    extern __shared__ __attribute__((aligned(16))) unsigned char lds_raw[];
    Frame F; F.lds = (LAS unsigned char*)lds_raw; F.tid = threadIdx.x; F.lane = F.tid & 63; F.wave = __builtin_amdgcn_readfirstlane(F.tid >> 6); F.G = gridDim.x; F.bx = blockIdx.x;
#define PHASE_FRAME Frame F; { int t_ = threadIdx.x; asm volatile("" : "+v"(t_)); F.lds = (LAS unsigned char*)lds_raw; F.tid = t_; F.lane = t_ & 63; F.wave = __builtin_amdgcn_readfirstlane(t_ >> 6); F.G = gridDim.x; int b_ = blockIdx.x; asm volatile("" : "+s"(b_)); F.bx = b_; }
    volatile LAS unsigned* MISC = (volatile LAS unsigned*)(F.lds + MISC_OFF);
    LAS int* meta = (LAS int*)(F.lds + MISC_OFF + 64);
    LAS int* lcnt = (LAS int*)(F.lds + MISC_OFF + 256);
    for (int u = F.tid; u < 1024; u += NTHR) ((LAS unsigned*)(F.lds + MISC_OFF))[u] = 0u;
    __syncthreads();
    XcdBarrier bar;
    { CParams* pp = get_params(); bar = xcd_barrier_post((unsigned*)(pp->ws + WS_CTL) + CW_BAR, MISC); }
#define IN(k) true
#define SEAM(k) do { if ((k) + 1 < N_PHASES) xcd_barrier(bar); } while (0)
#define GWS const int gw = F.bx * NWAVES + F.wave, NGW = F.G * NWAVES

    if (IN(PH_PRO0)) {
        PHASE_FRAME; CParams* pp = get_params(); unsigned char* ws = pp->ws; GWS;
#pragma nounroll
        for (int rep = 0; rep < ((PROBE_DUP >> 8) & 1) + 1; ++rep) {
        convert_strip_list(F, 4 * 72 + 4 * 112, [&](int fs) -> StripDesc {
            if (fs < 288) { const int l = fs / 72, st = fs - l * 72;
                return StripDesc{PIN(I_W_IN) + (size_t)l * D * 2304 + st * 32, PIN(I_NORM_MIX) + l * D, (signed char*)(ws + WS_WIN) + (size_t)l * 2304 * D, (float*)(ws + WS_WSC + SC_WIN) + l * 2304, 2304, st * 32}; }
            const int r = fs - 288, up = r / 224, r2 = r - up * 224, i = r2 / 112, st = r2 - i * 112, n0 = st * 32;
            return StripDesc{(up ? PIN(I_DUP) : PIN(I_DGATE)) + (size_t)i * D * FF + n0, PIN(I_NORM_FFN) + (2 * i) * D, (signed char*)(ws + WS_WGU) + (size_t)i * 7168 * D, (float*)(ws + WS_WSC + SC_WD) + i * 7168, FF,
                             (n0 >> 7) * 256 + 128 * up + (n0 & 127)}; });
        __syncthreads();
#pragma nounroll
        for (int l = 0; l < DEPTH; ++l) {
            convert_job(F, PIN(I_W_OUT) + (size_t)l * D * D, D, D, (bf16_t*)(ws + WS_WOUT) + (size_t)l * D * D, RowIdent{});
            convert_job(F, PIN(I_XWQ) + (size_t)l * D * 512, D, 512, (bf16_t*)(ws + WS_WQ) + (size_t)l * 512 * D, RowIdent{PIN(I_NORM_XATTN) + l * D});
            convert_job(F, PIN(I_XWKV) + (size_t)l * D * 1024, D, 1024, (bf16_t*)(ws + WS_WKV) + (size_t)l * 1024 * D, RowIdent{});
            convert_job(F, PIN(I_XWO) + (size_t)l * 512 * D, 512, D, (bf16_t*)(ws + WS_WO) + (size_t)l * D * 512, RowIdent{});
        }
#pragma nounroll
        for (int i = 0; i < 2; ++i) convert_job_f8(F, PIN(I_DDOWN) + (size_t)i * FF * D, FF, D, (unsigned char*)(ws + WS_WDN) + (size_t)i * D * FF, RowIdent{});
#pragma nounroll
        for (int l = 0; l < DEPTH; ++l) {
            f32x4 g[4], v[4];
#pragma unroll
            for (int j = 0; j < 4; ++j) g[j] = ((const f32x4*)(PIN(I_NORM_MEM) + l * D))[64 * j + F.lane];
            for (int m = gw; m < NB * NMEM; m += NGW) norm_row(PIN(I_MEM) + (size_t)m * D, (bf16_t*)(ws + WS_PROJ + PJ_HM) + ((size_t)l * 8192 + m) * D, g, v, F.lane);
        }
        { const float* x = PIN(I_X); bf16_t* xb = (bf16_t*)(ws + WS_XB); float* sq = ssq_slot(ws, 0); signed char* xq = (signed char*)(ws + WS_XQW); float* roww = (float*)(ws + WS_WSC + SC_ROWW);
          for (int m = gw; m < T; m += NGW) { const f32x4* xr = (const f32x4*)(x + (size_t)m * D) + F.lane; u32x2* o8 = (u32x2*)(xb + (size_t)m * D) + F.lane; float q = 0.f, mx = 0.f; f32x4 xv[4];
#pragma unroll
              for (int j = 0; j < 4; ++j) { xv[j] = xr[64 * j]; q += (xv[j].x * xv[j].x + xv[j].y * xv[j].y) + (xv[j].z * xv[j].z + xv[j].w * xv[j].w); mx = fmaxf(mx, fmaxf(fmaxf(fabsf(xv[j].x), fabsf(xv[j].y)), fmaxf(fabsf(xv[j].z), fabsf(xv[j].w))));
                  u32x2 w; w.x = cvt_pk_bf16(xv[j].x, xv[j].y); w.y = cvt_pk_bf16(xv[j].z, xv[j].w); o8[64 * j] = w; }
              q = wave_sum(q); mx = wave_max(mx); const float sc = mx > 0.f ? mx * (1.f / 127.f) : 1.f, inv = 1.0f / sc; unsigned* q8 = (unsigned*)(xq + (size_t)m * D) + F.lane;
#pragma unroll
              for (int j = 0; j < 4; ++j) q8[64 * j] = q4(xv[j].x, xv[j].y, xv[j].z, xv[j].w, inv);
              if (F.lane == 0) { *(f32x4*)(sq + (size_t)m * 4) = (f32x4){q, 0.f, 0.f, 0.f}; roww[m] = sc / sqrtf(q * (1.f / 1024.f) + EPS); } } }
        }
        SEAM(PH_PRO0);
    }
    if (IN(PH_PRO1)) {
        PHASE_FRAME; CParams* pp = get_params(); unsigned char* ws = pp->ws;
        SchedKV S{F.G, F.bx, ws};
        pg8::gemm_phase(F.lds, 2048, S, pg8::EpiStoreBf16{});
        SEAM(PH_PRO1);
    }

#pragma nounroll
    for (int l = 0; l < DEPTH; ++l) {
        const int pb = PH_L0 + l * NPL;
        const bool moe = (l & 1) != 0; const int fi = l >> 1;
        if (IN(pb + 0)) {
            if (l == 0) {
                PHASE_FRAME; CParams* pp = get_params(); unsigned char* ws = pp->ws; GWS;
                for (int rr = gw; rr < DEPTH * 8192; rr += NGW) { const int ll = rr >> 13;
                    float kv[8]; unpack8(*(const bf16x8*)((const bf16_t*)(ws + WS_YS) + (size_t)rr * 512 + 8 * F.lane), kv);
                    float ss = 0.f;
#pragma unroll
                    for (int j = 0; j < 8; ++j) ss += kv[j] * kv[j];
                    ss += lane_xor<1>(ss); ss += lane_xor<2>(ss); ss += lane_xor<4>(ss); ss += lane_xor<8>(ss);
                    const float rs = 1.0f / sqrtf(ss * (1.f / 128.f) + EPS);
                    const float* kg = PIN(I_XK_GAIN) + ll * 128 + 8 * (F.lane & 15);
#pragma unroll
                    for (int j = 0; j < 8; ++j) kv[j] = kv[j] * rs * kg[j];
                    *(bf16x8*)((bf16_t*)(ws + WS_KN) + (size_t)rr * 512 + 8 * F.lane) = pack8(kv); }
            }
            if (l & 1) {
                PHASE_FRAME; CParams* pp = get_params(); unsigned char* ws = pp->ws; GWS; const bf16_t* xb = (const bf16_t*)(ws + WS_XB); const float* sq = ssq_slot(ws, 3 * l);
                signed char* xq = (signed char*)(ws + WS_XQW); float* roww = (float*)(ws + WS_WSC + SC_ROWW);
                quant_pass(F, xb, sq, xq, roww);
                xcd_barrier(bar);
            }
            PHASE_FRAME; CParams* pp = get_params(); unsigned char* ws = pp->ws;
            SchedWin S{F.G, F.bx, l, ws};
            pg8::gemm_phase(F.lds, 1024, S, pg8::EpiStoreI8{});
            SEAM(pb + 0);
        }
        if (IN(pb + 1)) {
            PHASE_FRAME; CParams* pp = get_params(); unsigned char* ws = pp->ws; char* proj = (char*)(ws + WS_PROJ); bf16_t* mixed = (bf16_t*)(ws + WS_YS);
            if (F.wave >= 4) __builtin_amdgcn_s_setprio(1);
            LAS float* bias = (LAS float*)(F.lds + SW_END); LAS float* part = (LAS float*)(F.lds + SW_END + 4096);
            LAS float* cst = (LAS float*)(F.lds + SW_END + 4096 + 2048);
            for (int i = F.tid; i < 1024; i += NTHR) { const int h = i >> 7, d = i & 127; bias[i] = PIN(I_REL_BIAS)[T5B[d] * 8 + h] * 1.4426950408889634f; }
            for (int i = F.tid; i < 1160; i += NTHR) cst[i] = (i < 512) ? PIN(I_SB_OUT_GAIN)[l * 512 + i] : (i < 1024) ? PIN(I_SWA_OUT_GAIN)[l * 512 + i - 512] : (i < 1088) ? PIN(I_SWA_Q_GAIN)[l * 64 + i - 1024] : (i < 1152) ? PIN(I_SWA_K_GAIN)[l * 64 + i - 1088] : PIN(I_SWA_SINKS)[l * 8 + i - 1152];
            __syncthreads();
#pragma nounroll
            for (int rep = 0; rep < ((PROBE_DUP >> 1) & 3 ? 2 : 1); ++rep)
#pragma nounroll
            for (int u = F.bx + ((rep == 1 && ((PROBE_DUP >> 2) & 1)) ? 1024 : 0); u < ((rep == 1 && ((PROBE_DUP >> 1) & 3) == 1) ? 1024 : 2048); u += F.G) {
                const int uu = u & 1023, b = uu >> 5, tq = uu & 31;
                if (u < 1024) sb_unit(F, b, tq, (const bf16_t*)(proj + PJ_SBQ), (const bf16_t*)(proj + PJ_SBK), (const bf16_t*)(proj + PJ_SBVT), cst, mixed, part, F.lds);
                else swa_unit(F, b, tq, (const bf16_t*)(proj + PJ_SWQ), (const bf16_t*)(proj + PJ_SWKV), cst + 1024, cst + 1088, cst + 1152, cst + 512, mixed, F.lds, bias, part);
            }
            __builtin_amdgcn_s_setprio(0);
            SEAM(pb + 1);
        }
        if (IN(pb + 2)) {
            PHASE_FRAME; CParams* pp = get_params(); unsigned char* ws = pp->ws;
            SchedRes S{F.G, F.bx, l, 0, ws};
            pg8::gemm_phase(F.lds, 2048, S, pg8::EpiResid{});
            SEAM(pb + 2);
        }
        if (IN(pb + 3)) {
            PHASE_FRAME; CParams* pp = get_params(); unsigned char* ws = pp->ws;
            SchedWq S{F.G, F.bx, l, ws};
            pg8::gemm_phase(F.lds, 2048, S, pg8::EpiStoreBf16{});
            SEAM(pb + 3);
        }
        if (IN(pb + 4)) {
            PHASE_FRAME; CParams* pp = get_params(); unsigned char* ws = pp->ws;
            if (F.wave >= 4) __builtin_amdgcn_s_setprio(1);
            LAS float* qg = (LAS float*)(F.lds + pg8::XL_OFF);
            if (F.tid < 128) qg[F.tid] = PIN(I_XQ_GAIN)[l * 128 + F.tid];
            __syncthreads();
#pragma nounroll
            for (int rep = 0; rep < ((PROBE_DUP >> 4) & 1) + 1; ++rep)
#pragma nounroll
            for (int hu = F.bx; hu < 256; hu += F.G) {
                const int p = hu >> 1;
                __syncthreads();
                xattn_stage(F, p >> 2, p & 3, (const bf16_t*)(ws + WS_KN) + (size_t)l * 8192 * 512, (const bf16_t*)(ws + WS_VT) + (size_t)l * 8192 * 512, F.lds);
                __syncthreads();
#pragma nounroll
                for (int i = 0; i < 4; ++i) xattn_tile(F, p >> 2, p & 3, 4 * (hu & 1) + i, (const bf16_t*)(ws + WS_PROJ + PJ_XQ), qg, (bf16_t*)(ws + WS_PROJ + PJ_XO), F.lds);
            }
            __builtin_amdgcn_s_setprio(0);
            SEAM(pb + 4);
        }
        if (IN(pb + 5)) {
            PHASE_FRAME; CParams* pp = get_params(); unsigned char* ws = pp->ws;
            SchedRes S{F.G, F.bx, l, 1, ws};
            pg8::gemm_phase(F.lds, 1024, S, pg8::EpiResid{});
            SEAM(pb + 5);
        }
        if (IN(pb + 6) && moe) {
            PHASE_FRAME; CParams* pp = get_params(); unsigned char* ws = pp->ws; const bf16_t* xb = (const bf16_t*)(ws + WS_XB); const float* sq = ssq_slot(ws, 3 * l + 2);
            unsigned* gcnt = (unsigned*)(ws + WS_CTL) + CW_CNT + fi * 8 * 64;
            int* mlist = (int*)(ws + WS_MOE + MO_LIST); int4* minfo = (int4*)(ws + WS_MOE + MO_INFO); float2* mgate = (float2*)(ws + WS_MOE + MO_GATE);
            const float* rw = PIN(I_ROUTER_W) + (size_t)fi * D * NE; const float* rb = PIN(I_ROUTER_B) + fi * NE; const float* gn = PIN(I_NORM_FFN) + l * D;
            LAS float* rwl = (LAS float*)(F.lds + 70 * 1024);
            for (int i = F.tid; i < D * NE; i += NTHR) rwl[i] = rw[i] * gn[i >> 3];
            float rbv[8];
#pragma unroll
            for (int e = 0; e < 8; ++e) rbv[e] = rb[e];
#pragma nounroll
            for (int grp = F.bx; grp < T / 256; grp += F.G) {
                if (F.tid < 8) lcnt[F.tid] = 0;
                __syncthreads();
                int me1 = 0, me2 = 0; float mg1 = 0.f, mg2 = 0.f;
                u32x2 xnext[4]; f32x4 sqnext;
                { const int m0 = grp * 256 + F.wave * 32; load_row4(xnext, xb + (size_t)m0 * D, F.lane); sqnext = *(const f32x4*)(sq + (size_t)m0 * 4); }
#pragma nounroll
                for (int i = 0; i < 32; ++i) {
                    const int m = grp * 256 + F.wave * 32 + i;
                    const int ln = F.lane;
                    u32x2 xcur[4];
#pragma unroll
                    for (int j = 0; j < 4; ++j) xcur[j] = xnext[j];
                    const float rs = 1.0f / sqrtf(((sqnext.x + sqnext.y) + (sqnext.z + sqnext.w)) * (1.f / 1024.f) + EPS);
                    if (i < 31) { load_row4(xnext, xb + (size_t)(m + 1) * D, ln); sqnext = *(const f32x4*)(sq + (size_t)(m + 1) * 4); }
                    float lg[8]; typedef float f32x2_ __attribute__((ext_vector_type(2)));
                    f32x2_ l2[4] = {{0.f, 0.f}, {0.f, 0.f}, {0.f, 0.f}, {0.f, 0.f}};
#pragma unroll
                    for (int j = 0; j < 4; ++j) { const u32x2 xw = xcur[j]; const f32x4 xv = {bf_lo(xw.x), bf_hi(xw.x), bf_lo(xw.y), bf_hi(xw.y)};
#pragma unroll
                        for (int cc = 0; cc < 4; ++cc) { const LAS float* wr_ = rwl + (256 * j + 4 * ln + cc) * 8; const f32x4 w0 = *(const LAS f32x4*)wr_, w1 = *(const LAS f32x4*)(wr_ + 4); const f32x2_ hv = {xv[cc], xv[cc]};
                            l2[0] = hv * (f32x2_){w0.x, w0.y} + l2[0]; l2[1] = hv * (f32x2_){w0.z, w0.w} + l2[1]; l2[2] = hv * (f32x2_){w1.x, w1.y} + l2[2]; l2[3] = hv * (f32x2_){w1.z, w1.w} + l2[3]; } }
#pragma unroll
                    for (int e = 0; e < 4; ++e) { lg[2 * e] = l2[e].x; lg[2 * e + 1] = l2[e].y; }
#pragma unroll
                    for (int e = 0; e < 8; ++e) lg[e] = wave_sum(lg[e]) * rs + rbv[e];
                    int e1 = 0; float v1 = lg[0];
#pragma unroll
                    for (int e = 1; e < 8; ++e) if (lg[e] > v1) { v1 = lg[e]; e1 = e; }
                    int e2 = -1; float v2 = -INFINITY;
#pragma unroll
                    for (int e = 0; e < 8; ++e) if (e != e1 && lg[e] > v2) { v2 = lg[e]; e2 = e; }
                    const float ex = __expf(v2 - v1), den = 1.0f / (1.0f + ex);
                    if (F.lane == i) { me1 = e1; me2 = e2; mg1 = den; mg2 = ex * den; }
                }
                int p1 = 0, p2 = 0;
                if (F.lane < 32) { p1 = __hip_atomic_fetch_add(&lcnt[me1], 1, __ATOMIC_RELAXED, __HIP_MEMORY_SCOPE_WORKGROUP); p2 = __hip_atomic_fetch_add(&lcnt[me2], 1, __ATOMIC_RELAXED, __HIP_MEMORY_SCOPE_WORKGROUP); }
                __syncthreads();
                if (F.tid < 8) lcnt[8 + F.tid] = (int)__hip_atomic_fetch_add(gcnt + 64 * F.tid, (unsigned)lcnt[F.tid], __ATOMIC_RELAXED, __HIP_MEMORY_SCOPE_AGENT);
                __syncthreads();
                if (F.lane < 32) { const int tok = grp * 256 + F.wave * 32 + F.lane; const int q1 = lcnt[8 + me1] + p1, q2 = lcnt[8 + me2] + p2;
                    mlist[(size_t)me1 * T + q1] = tok; mlist[(size_t)me2 * T + q2] = tok; minfo[tok] = make_int4(me1 | (me2 << 8), q1, q2, 0); mgate[tok] = make_float2(mg1, mg2); }
                __syncthreads();
            }
            __syncthreads();
#pragma nounroll
            for (int rep = 0; rep < ((PROBE_DUP >> 5) & 1) + 1; ++rep) {
                convert_strip_list(F, NE * 224, [&](int fs) -> StripDesc {
                    const int e = fs / 224, r = fs - e * 224, up = r / 112, st = r - up * 112, n0 = st * 32; const size_t eo = ((size_t)fi * NE + e) * D * FF;
                    return StripDesc{(up ? PIN(I_EUP) : PIN(I_EGATE)) + eo + n0, gn, (signed char*)(ws + WS_EGU) + (size_t)e * 7168 * D, (float*)(ws + WS_WSC + SC_WE) + e * 7168, FF, (n0 >> 7) * 256 + 128 * up + (n0 & 127)}; });
                __syncthreads();
#pragma nounroll
                for (int e = 0; e < NE; ++e) convert_job_f8(F, PIN(I_EDOWN) + ((size_t)fi * NE + e) * D * FF, FF, D, (unsigned char*)(ws + WS_EDN) + (size_t)e * D * FF, RowIdent{});
            }
            SEAM(pb + 6);
        }
        if (IN(pb + 6) && !moe) {
            PHASE_FRAME; CParams* pp = get_params(); unsigned char* ws = pp->ws; GWS; const bf16_t* xb = (const bf16_t*)(ws + WS_XB); const float* sq = ssq_slot(ws, 3 * l + 2);
            signed char* xq = (signed char*)(ws + WS_PROJ + PJ_XQ8); float* rowsc = (float*)(ws + WS_WSC + SC_ROW);
            quant_pass(F, xb, sq, xq, rowsc);
            SEAM(pb + 6);
        }
        if (IN(pb + 7)) {
            if (!moe) {
                constexpr int NCH = 256 / CHUNK_BLK;
#pragma nounroll
                for (int c = 0; c <= NCH; ++c) {
                    if (c > 0) { PHASE_FRAME; CParams* pp = get_params(); unsigned char* ws = pp->ws;
                      SchedDown S{F.G, F.bx, CHUNK_BLK, c - 1, l, ws, nullptr};
                      pg8::gemm_phase(F.lds, FF, S, pg8::EpiResidT<2>{}); }
                    if (c < NCH) { PHASE_FRAME; CParams* pp = get_params(); unsigned char* ws = pp->ws;
                      SchedGU S{F.G, F.bx, CHUNK_BLK, c, l, ws, nullptr};
                      pg8::gemm_phase(F.lds, 1024, S, pg8::EpiSwiGLU8{});
                      xcd_barrier(bar); }
                }
            } else {
                { PHASE_FRAME; CParams* pp = get_params(); unsigned char* ws = pp->ws; moe_meta(F, (unsigned*)(ws + WS_CTL) + CW_CNT + fi * 8 * 64, meta);
                  moe_gather(F, 0, meta[16], meta, (const int*)(ws + WS_MOE + MO_LIST), (const bf16_t*)(ws + WS_XB), ssq_slot(ws, 3 * l + 2), (float*)(ws + WS_WSC + SC_SROW), (char*)(ws + WS_PROJ)); }
                const LAS int* pblk = meta + 8; const int nbtot = meta[16], nchunk = (nbtot + CHUNK_BLK - 1) / CHUNK_BLK;
                xcd_barrier(bar);
#pragma nounroll
                for (int c = 0; c <= nchunk; ++c) {
                    if (c > 0) { PHASE_FRAME; CParams* pp = get_params(); unsigned char* ws = pp->ws;
                      SchedDown S{F.G, F.bx, min(CHUNK_BLK, nbtot - CHUNK_BLK * (c - 1)), c - 1, l, ws, pblk};
                      pg8::gemm_phase(F.lds, FF, S, pg8::EpiStoreBf16T<2>{});
                      if ((PROBE_DUP >> 7) & 1) pg8::gemm_phase(F.lds, FF, S, pg8::EpiStoreBf16T<2>{}); }
                    if (c < nchunk) { PHASE_FRAME; CParams* pp = get_params(); unsigned char* ws = pp->ws;
                      SchedGU S{F.G, F.bx, min(CHUNK_BLK, nbtot - CHUNK_BLK * c), c, l, ws, pblk};
                      pg8::gemm_phase(F.lds, 1024, S, pg8::EpiSwiGLU8{});
                      if ((PROBE_DUP >> 6) & 1) pg8::gemm_phase(F.lds, 1024, S, pg8::EpiSwiGLU8{});
                      if (c + 1 < nchunk) moe_gather(F, c + 1, nbtot, meta, (const int*)(ws + WS_MOE + MO_LIST), (const bf16_t*)(ws + WS_XB), ssq_slot(ws, 3 * l + 2), (float*)(ws + WS_WSC + SC_SROW), (char*)(ws + WS_PROJ));
                      xcd_barrier(bar); }
                }
            }
            SEAM(pb + 7);
        }
        if (IN(pb + 8) && moe) {
            PHASE_FRAME; CParams* pp = get_params(); unsigned char* ws = pp->ws; GWS; float* xo = pp->out; bf16_t* xb = (bf16_t*)(ws + WS_XB); float* sq = ssq_slot(ws, 3 * l + 3); const bool lastl = (l == DEPTH - 1);
            const int4* minfo = (const int4*)(ws + WS_MOE + MO_INFO); const float2* mgate = (const float2*)(ws + WS_MOE + MO_GATE);
            moe_meta(F, (unsigned*)(ws + WS_CTL) + CW_CNT + fi * 8 * 64, meta);
            const LAS int* pblk = meta + 8; const bf16_t* ys = (const bf16_t*)(ws + WS_YS);
            struct Rec { unsigned r1, r2; float g1, g2; };
#define CB_REC(R, mb_) do { R.r1 = 0u; R.r2 = 0u; R.g1 = 0.f; R.g2 = 0.f; if (F.lane < 8) { int mj_ = (mb_) + F.lane * NGW; mj_ = mj_ < T ? mj_ : gw; const int4 inf = minfo[mj_]; const float2 gt = mgate[mj_]; const int e1 = inf.x & 255, e2 = inf.x >> 8; \
                R.r1 = (unsigned)(pblk[e1] * 256 + inf.y); R.r2 = (unsigned)(pblk[e2] * 256 + inf.z); R.g1 = gt.x; R.g2 = gt.y; } } while (0)
#define CB_LOAD(XW, YA, YB, GA, GB, R, mb_, sub_) do { _Pragma("unroll") for (int i = 0; i < 2; ++i) { const int j = (sub_) * 2 + i; int m_ = (mb_) + j * NGW; m_ = m_ < T ? m_ : gw; \
                const size_t r1 = (size_t)(unsigned)__builtin_amdgcn_readlane((int)R.r1, j), r2 = (size_t)(unsigned)__builtin_amdgcn_readlane((int)R.r2, j); \
                GA[i] = __builtin_bit_cast(float, __builtin_amdgcn_readlane(__builtin_bit_cast(int, R.g1), j)); GB[i] = __builtin_bit_cast(float, __builtin_amdgcn_readlane(__builtin_bit_cast(int, R.g2), j)); \
                load_row4(XW[i], xb + (size_t)m_ * D, F.lane); load_row4(YA[i], ys + r1 * D, F.lane); load_row4(YB[i], ys + r2 * D, F.lane); } } while (0)
#define CB_PROC(XW, YA, YB, GA, GB, mb_, sub_) do { _Pragma("unroll") for (int i = 0; i < 2; ++i) { const int j = (sub_) * 2 + i, m = (mb_) + j * NGW; if (m < T) { \
                u32x2* xr = (u32x2*)(xb + (size_t)m * D) + F.lane; f32x4* o4 = (f32x4*)(xo + (size_t)m * D) + F.lane; float q = 0.f, mx = 0.f; f32x4 xs[4]; \
                _Pragma("unroll") for (int jj = 0; jj < 4; ++jj) { const u32x2 xw_ = XW[i][jj], a = YA[i][jj], bq = YB[i][jj]; f32x4 xv; \
                    xv.x = bf_lo(xw_.x) + GA[i] * bf_lo(a.x) + GB[i] * bf_lo(bq.x); xv.y = bf_hi(xw_.x) + GA[i] * bf_hi(a.x) + GB[i] * bf_hi(bq.x); xv.z = bf_lo(xw_.y) + GA[i] * bf_lo(a.y) + GB[i] * bf_lo(bq.y); xv.w = bf_hi(xw_.y) + GA[i] * bf_hi(a.y) + GB[i] * bf_hi(bq.y); \
                    xs[jj] = xv; \
                    if (lastl) o4[64 * jj] = xv; \
                    else { q += (xv.x * xv.x + xv.y * xv.y) + (xv.z * xv.z + xv.w * xv.w); mx = fmaxf(mx, fmaxf(fmaxf(fabsf(xv.x), fabsf(xv.y)), fmaxf(fabsf(xv.z), fabsf(xv.w)))); \
                        u32x2 w; w.x = cvt_pk_bf16(xv.x, xv.y); w.y = cvt_pk_bf16(xv.z, xv.w); xr[64 * jj] = w; } } \
                if (!lastl) { q = wave_sum(q); mx = wave_max(mx); const float sc = mx > 0.f ? mx * (1.f / 127.f) : 1.f, inv = 1.0f / sc; unsigned* q8 = (unsigned*)((signed char*)(ws + WS_XQW) + (size_t)m * D) + F.lane; \
                    _Pragma("unroll") for (int jj = 0; jj < 4; ++jj) q8[64 * jj] = q4(xs[jj].x, xs[jj].y, xs[jj].z, xs[jj].w, inv); \
                    if (F.lane == 0) { *(f32x4*)(sq + (size_t)m * 4) = (f32x4){q, 0.f, 0.f, 0.f}; ((float*)(ws + WS_WSC + SC_ROWW))[m] = sc / sqrtf(q * (1.f / 1024.f) + EPS); } } } } } while (0)
            if (gw < T) {
                u32x2 xwA[2][4], yaA[2][4], ybA[2][4], xwB[2][4], yaB[2][4], ybB[2][4]; float gaA[2], gbA[2], gaB[2], gbB[2];
                Rec R, Rn; int mb = gw; const int bstep = 8 * NGW;
                CB_REC(R, mb);
                CB_LOAD(xwA, yaA, ybA, gaA, gbA, R, mb, 0);
#pragma nounroll
                for (;;) {
                    CB_REC(Rn, mb + bstep);
                    CB_LOAD(xwB, yaB, ybB, gaB, gbB, R, mb, 1); CB_PROC(xwA, yaA, ybA, gaA, gbA, mb, 0);
                    CB_LOAD(xwA, yaA, ybA, gaA, gbA, R, mb, 2); CB_PROC(xwB, yaB, ybB, gaB, gbB, mb, 1);
                    CB_LOAD(xwB, yaB, ybB, gaB, gbB, R, mb, 3); CB_PROC(xwA, yaA, ybA, gaA, gbA, mb, 2);
                    CB_LOAD(xwA, yaA, ybA, gaA, gbA, Rn, mb + bstep, 0); CB_PROC(xwB, yaB, ybB, gaB, gbB, mb, 3);
                    mb += bstep; if (mb >= T) break;
                    R = Rn;
                }
            }
#undef CB_REC
#undef CB_LOAD
#undef CB_PROC
            SEAM(pb + 8);
        }
    }
#undef IN
#undef SEAM
#undef GWS
#undef PHASE_FRAME
}

extern "C" void kernel_launch(void* const* d_in, const int* in_sizes, int n_in, void* d_out, int out_size, void* d_ws, size_t ws_size, hipStream_t stream) {
    static int grid = 0;
    if (grid == 0) {
        if (n_in != 27 || in_sizes[0] != T * D || out_size != T * D || ws_size < WS_END) { fprintf(stderr, "kernel_launch: unexpected shapes (n_in %d, in0 %d, out %d, ws %zu < %zu)\n", n_in, n_in > 0 ? in_sizes[0] : -1, out_size, ws_size, (size_t)WS_END); grid = -1; return; }
        int dev = 0, cus = 0, per_cu = 0;
        if (hipGetDevice(&dev) != hipSuccess || hipDeviceGetAttribute(&cus, hipDeviceAttributeMultiprocessorCount, dev) != hipSuccess) { grid = -1; return; }
        if (hipFuncSetAttribute((const void*)fwd_kernel, hipFuncAttributeMaxDynamicSharedMemorySize, LDS_BYTES) != hipSuccess) { fprintf(stderr, "kernel_launch: hipFuncSetAttribute failed\n"); grid = -1; return; }
        if (hipOccupancyMaxActiveBlocksPerMultiprocessor(&per_cu, (const void*)fwd_kernel, NTHR, LDS_BYTES) != hipSuccess || per_cu < 1) { fprintf(stderr, "kernel_launch: occupancy query says %d blocks per CU\n", per_cu); }
        (void)hipGetLastError();
        grid = cus;
    }
    if (grid < 0) return;
    if (hipMemsetAsync((char*)d_ws + WS_CTL, 0, CTL_BYTES, stream) != hipSuccess) return;
    Params p{};
    for (int i = 0; i < 27; ++i) p.in[i] = (const float*)d_in[i];
    p.out = (float*)d_out; p.ws = (unsigned char*)d_ws; p.ph_lo = 0; p.ph_hi = N_PHASES;
    hipLaunchKernelGGL(fwd_kernel, dim3(grid), dim3(NTHR), LDS_BYTES, stream, p);
}
```

```cpp
#include <hip/hip_runtime.h>
#include <cstdio>
#include <cstdint>

#define GAS __attribute__((address_space(1)))
#define LAS __attribute__((address_space(3)))
typedef unsigned short bf16_t;
typedef short bf16x8 __attribute__((ext_vector_type(8)));
typedef float f32x4 __attribute__((ext_vector_type(4)));
typedef float f32x16 __attribute__((ext_vector_type(16)));
typedef unsigned u32x4 __attribute__((ext_vector_type(4)));
typedef unsigned u32x2 __attribute__((ext_vector_type(2)));
typedef int i32x4 __attribute__((ext_vector_type(4)));
typedef int i32x8 __attribute__((ext_vector_type(8)));

constexpr int D = 1024, NB = 32, SEQ = 2048, T = NB * SEQ, DEPTH = 4, FF = 3584, NE = 8, NMEM = 256;
constexpr float EPS = 1e-6f;
constexpr int NWAVES = 8, NTHR = 512;

constexpr size_t MiB = 1u << 20;
constexpr size_t WS_CTL = 0, CTL_BYTES = 1 * MiB;
constexpr size_t WS_WIN = 1 * MiB;
constexpr size_t WS_WOUT = 19 * MiB;
constexpr size_t WS_WQ = 27 * MiB;
constexpr size_t WS_WKV = 31 * MiB;
constexpr size_t WS_WO = 39 * MiB;
constexpr size_t WS_WGU = 43 * MiB;
constexpr size_t WS_WDN = 71 * MiB;
constexpr size_t WS_EGU = 85 * MiB;
constexpr size_t WS_EDN = 197 * MiB;
constexpr size_t WS_KN = 253 * MiB;
constexpr size_t WS_VT = 285 * MiB;
constexpr size_t WS_XB = 317 * MiB;
constexpr size_t WS_PROJ = 445 * MiB;
constexpr size_t WS_YS = 733 * MiB;
constexpr size_t WS_MOE = 993 * MiB;
constexpr size_t WS_SSQ = 1001 * MiB;
constexpr size_t WS_WSC = 1013 * MiB;
constexpr size_t WS_XQW = 1015 * MiB;
constexpr size_t WS_END = 1079 * MiB;
constexpr size_t SC_WD = 0, SC_WE = 64 * 1024, SC_ROW = 512 * 1024, SC_SROW = 1024 * 1024, SC_ROWW = 1568 * 1024, SC_WIN = 1856 * 1024;
constexpr size_t PJ_SBQ = 0, PJ_SBK = 64 * MiB, PJ_SBVT = 128 * MiB, PJ_SWQ = 192 * MiB, PJ_SWKV = 256 * MiB;
constexpr size_t PJ_XQ = 0, PJ_XO = 64 * MiB;
constexpr size_t PJ_H = 0;
constexpr size_t PJ_GB = 224 * MiB;
constexpr size_t PJ_XQ8 = 224 * MiB;
constexpr size_t PJ_HM = 0;
constexpr size_t MO_LIST = 0;
constexpr size_t MO_INFO = 2 * MiB;
constexpr size_t MO_GATE = 3 * MiB;
constexpr int CHUNK_BLK = 128;
constexpr size_t H_BUF = (size_t)CHUNK_BLK * 256 * FF, GB_BUF = (size_t)CHUNK_BLK * 256 * 1024;
constexpr int CW_BAR = 1024;
constexpr int CW_CNT = 8192;

__device__ __forceinline__ unsigned cvt_pk_bf16(float lo, float hi) { unsigned r; asm volatile("v_cvt_pk_bf16_f32 %0, %1, %2" : "=v"(r) : "v"(lo), "v"(hi)); return r; }
__device__ __forceinline__ float bf_lo(unsigned w) { return __uint_as_float(w << 16); }
__device__ __forceinline__ float bf_hi(unsigned w) { return __uint_as_float(w & 0xffff0000u); }
template <int K> __device__ __forceinline__ float lane_xor(float v) { return __int_as_float(__builtin_amdgcn_ds_swizzle(__float_as_int(v), (K << 10) | 0x1F)); }
__device__ __forceinline__ float xor32_add(float v) { const auto rr = __builtin_amdgcn_permlane32_swap(__float_as_uint(v), __float_as_uint(v), false, false); return __uint_as_float(rr[0]) + __uint_as_float(rr[1]); }
__device__ __forceinline__ float xor32_max(float v) { const auto rr = __builtin_amdgcn_permlane32_swap(__float_as_uint(v), __float_as_uint(v), false, false); return fmaxf(__uint_as_float(rr[0]), __uint_as_float(rr[1])); }
__device__ __forceinline__ float xor32_get(float v, int hi) { const auto rr = __builtin_amdgcn_permlane32_swap(__float_as_uint(v), __float_as_uint(v), false, false); return hi ? __uint_as_float(rr[0]) : __uint_as_float(rr[1]); }
__device__ __forceinline__ float wave_sum(float v) {
    v += lane_xor<1>(v); v += lane_xor<2>(v); v += lane_xor<4>(v); v += lane_xor<8>(v); v += lane_xor<16>(v); return xor32_add(v);
}
#define LDS_WAIT() asm volatile("s_waitcnt lgkmcnt(0)" ::: "memory")
__device__ __forceinline__ unsigned pk4_fp8(float a, float b, float c, float d) { int p = __builtin_amdgcn_cvt_pk_fp8_f32(a, b, 0, false); p = __builtin_amdgcn_cvt_pk_fp8_f32(c, d, p, true); return (unsigned)p; }
constexpr float WDN_SCALE = 256.f;

namespace pg8 {
constexpr int BM = 256, BK = 64, HALF = 128, HTB = HALF * BK * 2, STAGE_BYTES = 8 * HTB, NXCD = 8, WGM = 8;
constexpr int XL_OFF = STAGE_BYTES;
__host__ __device__ __forceinline__ int lds_byte(int r, int c) { const int st = (r >> 4) * 2 + (c >> 5), rr = r & 15, cc = c & 31, ob = rr * 64 + cc * 2; return st * 1024 + (ob ^ (((ob >> 9) & 1) << 5)); }
__host__ __device__ __forceinline__ void stage_rc(int b, int& R, int& C) { const int st = b / 1024, sb = b % 1024, swz = sb ^ (((sb >> 9) & 1) << 5); R = (st >> 1) * 16 + swz / 64; C = (st & 1) * 32 + (swz % 64) / 2; }
__host__ __device__ __forceinline__ int perm32(int rho) { const int n = rho >> 4, i = rho & 15; return 8 * (i >> 2) + 4 * n + (i & 3); }

struct Unit { const char* a; const char* b; const float* sc; const float* sc2; int pm, pn; };
__device__ __forceinline__ void tile_of(int L, int nM, int nN, int& pm, int& pn) {
    const int nwg = nM * nN; int wgid = L;
    { const int q = nwg / NXCD, r = nwg % NXCD, xcd = wgid % NXCD, off = wgid / NXCD; wgid = (xcd < r ? xcd * (q + 1) : r * (q + 1) + (xcd - r) * q) + off; }
    const int nig = WGM * nN, gid = wgid / nig, fm = gid * WGM, gsz = (nM - fm) < WGM ? (nM - fm) : WGM;
    pm = fm + ((wgid % nig) % gsz); pn = (wgid % nig) / gsz;
}
struct Out { char* o; const char* r; int ldo; bf16_t* xb; float* ssq; int scmode; };
__device__ __forceinline__ float rs_of(const float* p4) { const f32x4 q = *(const f32x4*)p4; return 1.0f / sqrtf(((q.x + q.y) + (q.z + q.w)) * (1.f / 1024.f) + 1e-6f); }
__device__ __forceinline__ float rs_lds(const LAS float* p4) { const f32x4 q = *(const LAS f32x4*)p4; return 1.0f / sqrtf(((q.x + q.y) + (q.z + q.w)) * (1.f / 1024.f) + 1e-6f); }

template <int MD> struct EpiStoreBf16T {
    static constexpr bool PERM = true; static constexpr int MODE = MD; typedef f32x4 acc_t; static constexpr float OSC = (MD == 2) ? 1.0f / WDN_SCALE : 1.0f;
    __device__ __forceinline__ void operator()(const f32x4 (&acc)[2][2][4][2], const Out& u, int wr, int wc, int fr, int fq, const LAS float* xl, LAS float* xr) const {
        asm volatile("" : "+v"(fr), "+v"(fq));
        bf16_t* base = (bf16_t*)u.o + wc * 32 + 8 * fq;
        float cs[2][8];
        if (u.scmode == 2) {
#pragma unroll
            for (int bj = 0; bj < 2; ++bj)
#pragma unroll
                for (int j = 0; j < 8; ++j) cs[bj][j] = rs_lds(xl + (bj * HALF + wc * 32 + 8 * fq + j) * 4);
        }
#pragma unroll
        for (int ai = 0; ai < 2; ++ai)
#pragma unroll
            for (int m = 0; m < 4; ++m) { const int row = ai * HALF + wr * 64 + m * 16 + fr; bf16_t* rowp = base + (size_t)row * u.ldo;
                float rsc = OSC; if (u.scmode == 1) rsc = rs_lds(xl + row * 4);
#pragma unroll
                for (int bj = 0; bj < 2; ++bj) { f32x4 v0 = acc[ai][bj][m][0] * rsc, v1 = acc[ai][bj][m][1] * rsc;
                    if (u.scmode == 2) { v0.x *= cs[bj][0]; v0.y *= cs[bj][1]; v0.z *= cs[bj][2]; v0.w *= cs[bj][3]; v1.x *= cs[bj][4]; v1.y *= cs[bj][5]; v1.z *= cs[bj][6]; v1.w *= cs[bj][7]; }
                    u32x4 w; w.x = cvt_pk_bf16(v0[0], v0[1]); w.y = cvt_pk_bf16(v0[2], v0[3]); w.z = cvt_pk_bf16(v1[0], v1[1]); w.w = cvt_pk_bf16(v1[2], v1[3]);
                    *(u32x4*)(rowp + bj * HALF) = w; } }
    }
};
typedef EpiStoreBf16T<0> EpiStoreBf16;
struct EpiStoreI8 {
    static constexpr bool PERM = true; static constexpr int MODE = 1; typedef i32x4 acc_t;
    __device__ __forceinline__ void operator()(const i32x4 (&acc)[2][2][4][2], const Out& u, int wr, int wc, int fr, int fq, const LAS float* xl, LAS float* xr) const {
        asm volatile("" : "+v"(fr), "+v"(fq));
        bf16_t* base = (bf16_t*)u.o + wc * 32 + 8 * fq;
        float cs[2][8];
#pragma unroll
        for (int bj = 0; bj < 2; ++bj) { const f32x4 c0 = *(const LAS f32x4*)(xl + 256 + bj * HALF + wc * 32 + 8 * fq), c1 = *(const LAS f32x4*)(xl + 256 + bj * HALF + wc * 32 + 8 * fq + 4);
            cs[bj][0] = c0.x; cs[bj][1] = c0.y; cs[bj][2] = c0.z; cs[bj][3] = c0.w; cs[bj][4] = c1.x; cs[bj][5] = c1.y; cs[bj][6] = c1.z; cs[bj][7] = c1.w; }
#pragma unroll
        for (int ai = 0; ai < 2; ++ai)
#pragma unroll
            for (int m = 0; m < 4; ++m) { const int row = ai * HALF + wr * 64 + m * 16 + fr; bf16_t* rowp = base + (size_t)row * u.ldo; const float rsc = xl[row];
#pragma unroll
                for (int bj = 0; bj < 2; ++bj) { float v[8];
#pragma unroll
                    for (int n = 0; n < 2; ++n)
#pragma unroll
                        for (int j = 0; j < 4; ++j) v[n * 4 + j] = (float)acc[ai][bj][m][n][j] * (rsc * cs[bj][n * 4 + j]);
                    u32x4 w; w.x = cvt_pk_bf16(v[0], v[1]); w.y = cvt_pk_bf16(v[2], v[3]); w.z = cvt_pk_bf16(v[4], v[5]); w.w = cvt_pk_bf16(v[6], v[7]);
                    *(u32x4*)(rowp + bj * HALF) = w; } }
    }
};
struct EpiSwiGLU8 {
    static constexpr bool PERM = true; static constexpr int MODE = 1; typedef i32x4 acc_t;
    __device__ __forceinline__ void operator()(const i32x4 (&acc)[2][2][4][2], const Out& u, int wr, int wc, int fr, int fq, const LAS float* xl, LAS float* xr) const {
        asm volatile("" : "+v"(fr), "+v"(fq));
        unsigned char* base = (unsigned char*)u.o + wc * 32 + 8 * fq;
        const f32x4 cg0 = *(const LAS f32x4*)(xl + 256 + wc * 32 + 8 * fq), cg1 = *(const LAS f32x4*)(xl + 256 + wc * 32 + 8 * fq + 4);
        const f32x4 cu0 = *(const LAS f32x4*)(xl + 256 + HALF + wc * 32 + 8 * fq), cu1 = *(const LAS f32x4*)(xl + 256 + HALF + wc * 32 + 8 * fq + 4);
        const float cg[8] = {cg0.x, cg0.y, cg0.z, cg0.w, cg1.x, cg1.y, cg1.z, cg1.w}, cu[8] = {cu0.x, cu0.y, cu0.z, cu0.w, cu1.x, cu1.y, cu1.z, cu1.w};
#pragma unroll
        for (int ai = 0; ai < 2; ++ai)
#pragma unroll
            for (int m = 0; m < 4; ++m) { const int row = ai * HALF + wr * 64 + m * 16 + fr; unsigned char* rowp = base + (size_t)row * u.ldo;
                float nl2e = -1.4426950408889634f; asm volatile("" : "+s"(nl2e));
                const float rsc = xl[row], r2 = rsc * nl2e, rs2 = rsc * rsc;
                float h[8];
                typedef float f32x2_ __attribute__((ext_vector_type(2)));
#pragma unroll
                for (int n = 0; n < 2; ++n) { f32x2_ p[2], q[2], e[2];
#pragma unroll
                    for (int j = 0; j < 2; ++j) { p[j] = (f32x2_){(float)acc[ai][0][m][n][2 * j], (float)acc[ai][0][m][n][2 * j + 1]} * (f32x2_){cg[n * 4 + 2 * j], cg[n * 4 + 2 * j + 1]};
                                                  q[j] = (f32x2_){(float)acc[ai][1][m][n][2 * j], (float)acc[ai][1][m][n][2 * j + 1]} * (f32x2_){cu[n * 4 + 2 * j], cu[n * 4 + 2 * j + 1]}; }
#pragma unroll
                    for (int j = 0; j < 2; ++j) { const f32x2_ t = p[j] * r2; e[j].x = __builtin_amdgcn_exp2f(t.x); e[j].y = __builtin_amdgcn_exp2f(t.y); }
#pragma unroll
                    for (int j = 0; j < 2; ++j) { e[j] = e[j] + 1.0f; q[j] = p[j] * q[j]; }
#pragma unroll
                    for (int j = 0; j < 2; ++j) { e[j].x = __builtin_amdgcn_rcpf(e[j].x); e[j].y = __builtin_amdgcn_rcpf(e[j].y); }
#pragma unroll
                    for (int j = 0; j < 2; ++j) { const f32x2_ hh = q[j] * (e[j] * rs2); h[n * 4 + 2 * j] = hh.x; h[n * 4 + 2 * j + 1] = hh.y; } }
                u32x2 w; w.x = pk4_fp8(h[0], h[1], h[2], h[3]); w.y = pk4_fp8(h[4], h[5], h[6], h[7]);
                *(u32x2*)rowp = w; }
    }
};
template <int MD> struct EpiResidT {
    static constexpr bool PERM = true; static constexpr int MODE = MD; typedef f32x4 acc_t; static constexpr float OSC = (MD == 2) ? 1.0f / WDN_SCALE : 1.0f;
    __device__ __forceinline__ void operator()(const f32x4 (&acc)[2][2][4][2], const Out& u, int wr, int wc, int fr, int fq, const LAS float* xl_unused, LAS float* xl) const {
        asm volatile("" : "+v"(fr), "+v"(fq));
        bf16_t* base = u.xb + wc * 32 + 8 * fq;
        float ps[8];
        u32x4 rv[2][4][2];
#pragma unroll
        for (int ai = 0; ai < 2; ++ai)
#pragma unroll
            for (int m = 0; m < 4; ++m)
#pragma unroll
                for (int bj = 0; bj < 2; ++bj) rv[ai][m][bj] = *(const u32x4*)(base + (size_t)(ai * HALF + wr * 64 + m * 16 + fr) * 1024 + bj * HALF);
#pragma unroll
        for (int ai = 0; ai < 2; ++ai)
#pragma unroll
            for (int m = 0; m < 4; ++m) { bf16_t* rowp = base + (size_t)(ai * HALF + wr * 64 + m * 16 + fr) * 1024; float q = 0.f;
                typedef float f32x2_ __attribute__((ext_vector_type(2))); f32x2_ qq = {0.f, 0.f};
#pragma unroll
                for (int bj = 0; bj < 2; ++bj) { const u32x4 r = rv[ai][m][bj]; const f32x4 a0 = acc[ai][bj][m][0] * OSC, a1 = acc[ai][bj][m][1] * OSC;
                    const f32x2_ xa = (f32x2_){bf_lo(r.x), bf_hi(r.x)} + (f32x2_){a0.x, a0.y}, xb_ = (f32x2_){bf_lo(r.y), bf_hi(r.y)} + (f32x2_){a0.z, a0.w},
                                 xc = (f32x2_){bf_lo(r.z), bf_hi(r.z)} + (f32x2_){a1.x, a1.y}, xd = (f32x2_){bf_lo(r.w), bf_hi(r.w)} + (f32x2_){a1.z, a1.w};
                    qq = xa * xa + qq; qq = xb_ * xb_ + qq; qq = xc * xc + qq; qq = xd * xd + qq;
                    u32x4 w; w.x = cvt_pk_bf16(xa.x, xa.y); w.y = cvt_pk_bf16(xb_.x, xb_.y); w.z = cvt_pk_bf16(xc.x, xc.y); w.w = cvt_pk_bf16(xd.x, xd.y);
                    *(u32x4*)(rowp + bj * HALF) = w; }
                q = qq.x + qq.y;
                q += lane_xor<16>(q); q = xor32_add(q); ps[ai * 4 + m] = q; }
        if (fq == 0) {
#pragma unroll
            for (int ai = 0; ai < 2; ++ai)
#pragma unroll
                for (int m = 0; m < 4; ++m) xl[(ai * HALF + wr * 64 + m * 16 + fr) * 4 + wc] = ps[ai * 4 + m]; }
        asm volatile("s_waitcnt lgkmcnt(0)" ::: "memory"); __builtin_amdgcn_s_barrier(); asm volatile("" ::: "memory");
        const int t = wr * 256 + wc * 64 + fq * 16 + fr;
        if (t < 256) { const f32x4 q4 = *(const LAS f32x4*)(xl + t * 4); u.ssq[(size_t)t * 4] = (q4.x + q4.y) + (q4.z + q4.w); }
        asm volatile("s_waitcnt lgkmcnt(0)" ::: "memory"); __builtin_amdgcn_s_barrier(); asm volatile("" ::: "memory");
    }
};

typedef EpiResidT<0> EpiResid;
template <class Epi, class Sched>
__device__ __forceinline__ void gemm_phase(LAS unsigned char* lds, const int KB, const Sched& S, const Epi& E) {
    int tid = threadIdx.x; asm volatile("" : "+v"(tid));
    const int wid = __builtin_amdgcn_readfirstlane(tid >> 6), lane = tid & 63, wr = wid >> 2, wc = wid & 3, fr = lane & 15, fq = lane >> 4;
    const int nt = KB / 128;
    unsigned voffA[2], voffB[2];
#pragma unroll
    for (int i = 0; i < 2; ++i) { int R, C; stage_rc(tid * 16 + i * 8192, R, C); const int Rb = Epi::PERM ? ((R & ~31) + perm32(R & 31)) : R;
        voffA[i] = (unsigned)(R * KB + C * 2); voffB[i] = (unsigned)(Rb * KB + C * 2); }
    const size_t kstep = (size_t)(BK * 2);
    const size_t hstep = (size_t)HALF * KB;
    const unsigned ldsw = (unsigned)wid * 1024u;
    const unsigned ldsb_ = (unsigned)(size_t)lds;
    const int aoff = lds_byte(wr * 64 + fr, fq * 8), boff = lds_byte(wc * 32 + fr, fq * 8);
#define PG8_SA(b, h) (((b) * 2 + (h)) * HTB)
#define PG8_SB(b, h) ((4 + (b) * 2 + (h)) * HTB)
#define PG8_STAGE(bufoff, gbase, voff) do { const unsigned so_ = (unsigned)(size_t)(gbase) - (unsigned)(size_t)S.ws; \
        const __amdgpu_buffer_rsrc_t srd_ = __builtin_amdgcn_make_buffer_rsrc((void*)S.ws, (short)0, 0x7FFFFFFF, 0x00020000); \
        _Pragma("unroll") for (int _i = 0; _i < 2; ++_i) \
        asm volatile("s_mov_b32 m0, %0\n\ts_nop 0\n\tbuffer_load_dwordx4 %1, %2, %3 offen lds" :: "s"(ldsb_ + (unsigned)(bufoff) + ldsw + (unsigned)(_i * 8192)), "v"((voff)[_i]), "s"(srd_), "s"(so_) : "m0", "memory"); } while (0)
#define PG8_LDA(dst, b, h) do { _Pragma("unroll") for (int m = 0; m < 4; ++m) { if constexpr (Epi::MODE == 2) { const i32x4 lo_ = *(const LAS i32x4*)(lds + PG8_SA(b, h) + aoff + m * 2048), hi_ = *(const LAS i32x4*)(lds + PG8_SA(b, h) + aoff + m * 2048 + 1024); \
            dst##8[m] = __builtin_shufflevector(lo_, hi_, 0, 1, 2, 3, 4, 5, 6, 7); } else { _Pragma("unroll") for (int k = 0; k < 2; ++k) dst[m][k] = *(const LAS bf16x8*)(lds + PG8_SA(b, h) + aoff + m * 2048 + k * 1024); } } } while (0)
#define PG8_LDB(dst, b, h) do { _Pragma("unroll") for (int n = 0; n < 2; ++n) { if constexpr (Epi::MODE == 2) { const i32x4 lo_ = *(const LAS i32x4*)(lds + PG8_SB(b, h) + boff + n * 2048), hi_ = *(const LAS i32x4*)(lds + PG8_SB(b, h) + boff + n * 2048 + 1024); \
            dst##8[n] = __builtin_shufflevector(lo_, hi_, 0, 1, 2, 3, 4, 5, 6, 7); } else { _Pragma("unroll") for (int k = 0; k < 2; ++k) dst[n][k] = *(const LAS bf16x8*)(lds + PG8_SB(b, h) + boff + n * 2048 + k * 1024); } } } while (0)
#define PG8_MMA(ai, bj, At, Bt, Z) do { __builtin_amdgcn_s_setprio(1); _Pragma("unroll") for (int m = 0; m < 4; ++m) _Pragma("unroll") for (int n = 0; n < 2; ++n) { \
        if constexpr (Epi::MODE == 2) { \
            if constexpr ((Z) != 0) asm volatile("s_nop 1\n\tv_mfma_scale_f32_16x16x128_f8f6f4 %0, %1, %2, 0, %3, %3 op_sel_hi:[0,0,0]" : "=&v"(acc[ai][bj][m][n]) : "v"(Bt##8[n]), "v"(At##8[m]), "v"(f8one)); \
            else asm volatile("s_nop 1\n\tv_mfma_scale_f32_16x16x128_f8f6f4 %0, %1, %2, %0, %3, %3 op_sel_hi:[0,0,0]" : "+v"(acc[ai][bj][m][n]) : "v"(Bt##8[n]), "v"(At##8[m]), "v"(f8one)); } \
        else { _Pragma("unroll") for (int k = 0; k < 2; ++k) { const typename Epi::acc_t c_ = ((Z) != 0 && k == 0 && Epi::MODE == 1) ? (typename Epi::acc_t){0, 0, 0, 0} : acc[ai][bj][m][n]; \
            if constexpr (Epi::MODE == 1) acc[ai][bj][m][n] = __builtin_amdgcn_mfma_i32_16x16x64_i8(__builtin_bit_cast(i32x4, Bt[n][k]), __builtin_bit_cast(i32x4, At[m][k]), c_, 0, 0, 0); \
            else acc[ai][bj][m][n] = __builtin_amdgcn_mfma_f32_16x16x32_bf16(Bt[n][k], At[m][k], c_, 0, 0, 0); } } } __builtin_amdgcn_s_setprio(0); } while (0)
#define PG8_WAIT_V(n) asm volatile("s_waitcnt vmcnt(" #n ")" ::: "memory")
#define PG8_WAIT_L(n) asm volatile("s_waitcnt lgkmcnt(" #n ")" ::: "memory")
#define PG8_BAR __builtin_amdgcn_s_barrier()
#define PG8_SCHED __builtin_amdgcn_sched_barrier(0)
    Unit cur, nxt; int ui = 0;
    if (!__builtin_amdgcn_readfirstlane((int)S.next(0, cur))) return;
    typename Epi::acc_t acc[2][2][4][2];
#define PG8_ZERO_ACC do { if constexpr (Epi::MODE == 0) { _Pragma("unroll") for (int a = 0; a < 2; ++a) _Pragma("unroll") for (int b = 0; b < 2; ++b) _Pragma("unroll") for (int m = 0; m < 4; ++m) _Pragma("unroll") for (int n = 0; n < 2; ++n) \
        acc[a][b][m][n] = (typename Epi::acc_t){0, 0, 0, 0}; } } while (0)
    PG8_ZERO_ACC;
    bf16x8 At[4][2], B0[2][2], B1[2][2];
    i32x8 At8[4], B08[2], B18[2];
    const int f8one = 0x7F7F7F7F;
    const char* cA = cur.a; const char* cB = cur.b;
#define PG8_SCALES(un, buf) do { if ((un).sc != nullptr && wid < 4) { unsigned lane; asm volatile("v_mbcnt_lo_u32_b32 %0, -1, 0\n\tv_mbcnt_hi_u32_b32 %0, -1, %0" : "=v"(lane));        \
        if constexpr (Epi::MODE == 1) { __builtin_amdgcn_global_load_lds((const unsigned*)((un).sc + wid * 64 + lane), (LAS unsigned*)(lds + XL_OFF + (buf) * 4096 + wid * 256), 4, 0, 0); \
                                 __builtin_amdgcn_global_load_lds((const unsigned*)((un).sc2 + wid * 64 + lane), (LAS unsigned*)(lds + XL_OFF + (buf) * 4096 + 1024 + wid * 256), 4, 0, 0); } \
        else __builtin_amdgcn_global_load_lds((const unsigned*)((un).sc + (wid * 64 + lane) * 4), (LAS unsigned*)(lds + XL_OFF + (buf) * 4096 + wid * 1024), 16, 0, 0); } } while (0)
    PG8_SCALES(cur, 0);
    PG8_STAGE(PG8_SB(0, 0), cB, voffB); PG8_STAGE(PG8_SB(0, 1), cB + hstep, voffB); PG8_STAGE(PG8_SA(0, 0), cA, voffA); PG8_STAGE(PG8_SA(0, 1), cA + hstep, voffA);
    if (wr == 1) PG8_BAR;
    PG8_WAIT_V(2); PG8_BAR;
    PG8_STAGE(PG8_SB(1, 0), cB + kstep, voffB); PG8_STAGE(PG8_SA(1, 0), cA + kstep, voffA); PG8_STAGE(PG8_SB(1, 1), cB + hstep + kstep, voffB);
    PG8_WAIT_V(6); PG8_BAR;
    for (;;) {
        const bool has_next = S.next(ui + 1, nxt);
        const char* nA = has_next ? nxt.a : cA; const char* nB = has_next ? nxt.b : cB;
#define PG8_ITER(Z) do { \
            const bool last = (t == nt - 2); \
            const char* a1 = cA + (size_t)(t + 1) * kstep; \
            const char* a2 = last ? nA : cA + (size_t)(t + 2) * kstep; const char* b2 = last ? nB : cB + (size_t)(t + 2) * kstep; \
            const char* a3 = a2 + kstep; const char* b3 = b2 + kstep; \
            PG8_LDB(B0, 0, 0); PG8_LDB(B1, 0, 1); PG8_SCHED; PG8_LDA(At, 0, 0); PG8_STAGE(PG8_SA(1, 1), a1 + hstep, voffA); \
            PG8_WAIT_V(8); PG8_WAIT_L(0); PG8_BAR; PG8_MMA(0, 0, At, B0, Z); PG8_MMA(0, 1, At, B1, Z); PG8_BAR; PG8_SCHED; \
            PG8_LDA(At, 0, 1); PG8_STAGE(PG8_SB(0, 0), b2, voffB); PG8_STAGE(PG8_SB(0, 1), b2 + hstep, voffB); PG8_STAGE(PG8_SA(0, 0), a2, voffA); \
            PG8_WAIT_V(8); PG8_WAIT_L(0); PG8_BAR; PG8_MMA(1, 0, At, B0, Z); PG8_MMA(1, 1, At, B1, Z); PG8_BAR; PG8_SCHED; \
            PG8_LDB(B0, 1, 0); PG8_LDB(B1, 1, 1); PG8_SCHED; PG8_LDA(At, 1, 0); PG8_STAGE(PG8_SA(0, 1), a2 + hstep, voffA); \
            PG8_WAIT_V(8); PG8_WAIT_L(0); PG8_BAR; PG8_MMA(0, 0, At, B0, 0); PG8_MMA(0, 1, At, B1, 0); PG8_BAR; PG8_SCHED; \
            PG8_LDA(At, 1, 1); PG8_STAGE(PG8_SB(1, 0), b3, voffB); PG8_STAGE(PG8_SB(1, 1), b3 + hstep, voffB); PG8_STAGE(PG8_SA(1, 0), a3, voffA); \
            PG8_WAIT_V(8); PG8_WAIT_L(0); PG8_BAR; PG8_MMA(1, 0, At, B0, 0); PG8_MMA(1, 1, At, B1, 0); PG8_BAR; PG8_SCHED; } while (0)
        if constexpr (Epi::MODE == 0) { for (int t = 0; t < nt; t += 2) PG8_ITER(0); }
        else { { const int t = 0; PG8_ITER(1); }
               for (int t = 2; t < nt; t += 2) PG8_ITER(0); }
#undef PG8_ITER
        if (has_next) PG8_SCALES(nxt, (ui + 1) & 1);
        if (wr == 0) PG8_BAR;
        if constexpr (Epi::MODE == 2) asm volatile("s_nop 15\n\ts_nop 15\n\ts_nop 15" ::: "memory");
        { Out eo; S.out(cur, eo); unsigned le_; asm volatile("v_mbcnt_lo_u32_b32 %0, -1, 0\n\tv_mbcnt_hi_u32_b32 %0, -1, %0" : "=v"(le_));
          E(acc, eo, wr, wc, (int)(le_ & 15u), (int)(le_ >> 4), (LAS float*)(lds + XL_OFF + (ui & 1) * 4096), (LAS float*)(lds + XL_OFF + 8192)); }
        if (!has_next) break;
        PG8_ZERO_ACC;
        cur = nxt; cA = nA; cB = nB; ++ui;
        if (wr == 1) PG8_BAR;
    }
    PG8_WAIT_V(0);
    PG8_BAR;
#undef PG8_SCALES
#undef PG8_SA
#undef PG8_SB
#undef PG8_STAGE
#undef PG8_LDA
#undef PG8_LDB
#undef PG8_MMA
#undef PG8_WAIT_V
#undef PG8_WAIT_L
#undef PG8_BAR
#undef PG8_SCHED
}
}

#define XB_TMO      128
#define XB_XCNT(j)  (256  + 64 * (j))
#define XB_XSUB(j)  (1280 + 64 * (j))
#define XB_XGEN(j)  (2304 + 64 * (j))
#define XB_TOP      3328
#define XB_TOPGEN   3392
#define XCD_BAR_WORDS 3456
#define XB_SPIN_CAP (1u << 18)
__device__ __forceinline__ unsigned xb_ld(unsigned* p)              { return __hip_atomic_load(p, __ATOMIC_RELAXED, __HIP_MEMORY_SCOPE_AGENT); }
__device__ __forceinline__ unsigned xb_add(unsigned* p, unsigned v) { return __hip_atomic_fetch_add(p, v, __ATOMIC_RELAXED, __HIP_MEMORY_SCOPE_AGENT); }
__device__ __forceinline__ unsigned xb_xcc_id() { return (unsigned)__builtin_amdgcn_s_getreg((3 << 11) | 20) & 0xFu; }
#define XB_SPIN(cond, bar) do { unsigned _sp = 0; while (cond) { __builtin_amdgcn_s_sleep(1); \
    if ((++_sp & 255u) == 0u) { if (xb_ld(&(bar)[XB_TMO])) break; if (_sp > XB_SPIN_CAP) { atomicAdd(&(bar)[XB_TMO], 1u); break; } } } } while (0)
struct XcdBarrier { unsigned* bar; unsigned x; volatile LAS unsigned* st; };
__device__ __forceinline__ XcdBarrier xcd_barrier_post(unsigned* bar, volatile LAS unsigned* st) {
    XcdBarrier b; b.bar = bar; b.x = xb_xcc_id(); b.st = st;
    if (threadIdx.x == 0) (void)xb_add(&bar[XB_XCNT(b.x)], 1u);
    return b;
}
__device__ __forceinline__ void xcd_barrier_complete(unsigned* bar, unsigned x, unsigned& nloc, unsigned& nx) {
    const unsigned G = gridDim.x * gridDim.y * gridDim.z;
    unsigned sum, cnt, mine, sp = 0u;
    for (;;) {
        sum = 0u; cnt = 0u; mine = 0u;
#pragma unroll
        for (unsigned j = 0; j < 16; ++j) { const unsigned c = xb_ld(&bar[XB_XCNT(j)]); sum += c; cnt += (c > 0u) ? 1u : 0u; mine = (j == x) ? c : mine; }
        if (sum == G) break;
        __builtin_amdgcn_s_sleep(1);
        if ((++sp & 255u) == 0u) { if (xb_ld(&bar[XB_TMO])) break; if (sp > XB_SPIN_CAP) { atomicAdd(&bar[XB_TMO], 1u); break; } }
    }
    nloc = mine > 0u ? mine : 1u; nx = cnt > 0u ? cnt : 1u;
}
__device__ __forceinline__ void xcd_barrier(const XcdBarrier& b) {
    asm volatile("s_waitcnt vmcnt(0)" ::: "memory");
    __syncthreads();
    if (threadIdx.x == 0) {
        unsigned* bar = b.bar; asm volatile("" : "+s"(bar)); unsigned bx_ = b.x; asm volatile("" : "+s"(bx_));
        __builtin_amdgcn_s_waitcnt(0);
        unsigned nloc = b.st[0], nx = b.st[1];
        if (nloc == 0u) { xcd_barrier_complete(bar, bx_, nloc, nx); b.st[0] = nloc; b.st[1] = nx; }
        const unsigned old = xb_add(&bar[XB_XSUB(bx_)], 1u);
        const unsigned gen = old / nloc;
        if (old + 1u == (gen + 1u) * nloc) {
            __builtin_amdgcn_fence(__ATOMIC_RELEASE, "agent");
            asm volatile("s_waitcnt vmcnt(0)" ::: "memory");
            const unsigned og = xb_add(&bar[XB_TOP], 1u);
            const unsigned tg = og / nx;
            if (og + 1u == (tg + 1u) * nx) xb_add(&bar[XB_TOPGEN], 1u);
            else XB_SPIN(xb_ld(&bar[XB_TOPGEN]) == tg, bar);
            __builtin_amdgcn_fence(__ATOMIC_ACQUIRE, "agent");
            xb_add(&bar[XB_XGEN(bx_)], 1u);
            asm volatile("s_waitcnt vmcnt(0)" ::: "memory");
        } else {
            XB_SPIN(xb_ld(&bar[XB_XGEN(bx_)]) == gen, bar);
            __builtin_amdgcn_fence(__ATOMIC_ACQUIRE, "agent");
            asm volatile("s_waitcnt vmcnt(0)" ::: "memory");
        }
    }
    __syncthreads();
}

constexpr int RING_BYTES = 131072;
constexpr int MISC_OFF = RING_BYTES + 12288;
constexpr int LDS_BYTES = RING_BYTES + 4096 + 12288;

struct Params {
    const float* in[27];
    float* out;
    unsigned char* ws;
    int ph_lo, ph_hi;
};
enum { I_X = 0, I_MEM, I_NORM_MIX, I_W_IN, I_SB_OUT_GAIN, I_SWA_Q_GAIN, I_SWA_K_GAIN, I_SWA_SINKS, I_SWA_OUT_GAIN, I_REL_BIAS, I_W_OUT, I_NORM_XATTN, I_NORM_MEM,
       I_XWQ, I_XWKV, I_XQ_GAIN, I_XK_GAIN, I_XWO, I_NORM_FFN, I_DGATE, I_DUP, I_DDOWN, I_ROUTER_W, I_ROUTER_B, I_EGATE, I_EUP, I_EDOWN };

struct Frame {
    LAS unsigned char* lds;
    int tid, lane, wave;
    int G, bx;
};

template <class RowMap>
__device__ __forceinline__ void transpose_item(const float* W, int K, int N, bf16_t* WT, const RowMap& rm, LAS float* scr, int item, int lane) {
    const int nblk = N / 32, kb = item / nblk, nb = item % nblk, k0 = 64 * kb, n0 = 32 * nb;
    { f32x4 wv[8]; const int n4 = (lane & 7) * 4;
#pragma unroll
      for (int i = 0; i < 8; ++i) wv[i] = *(const f32x4*)(W + (size_t)(k0 + 8 * i + (lane >> 3)) * N + n0 + n4);
#pragma unroll
      for (int i = 0; i < 8; ++i) { const int kk = 8 * i + (lane >> 3); const float gk = rm.gain ? rm.gain[k0 + kk] : 1.0f; LAS float* d = scr + kk * 33 + n4; d[0] = wv[i].x * gk; d[1] = wv[i].y * gk; d[2] = wv[i].z * gk; d[3] = wv[i].w * gk; } }
    LDS_WAIT(); asm volatile("" ::: "memory");
    const int c = lane & 7; const int r0 = rm(n0);
#pragma unroll
    for (int j = 0; j < 4; ++j) { const int n = (lane >> 3) + 8 * j; const LAS float* s = scr + (8 * c) * 33 + n;
        u32x4 o; o.x = cvt_pk_bf16(s[0 * 33], s[1 * 33]); o.y = cvt_pk_bf16(s[2 * 33], s[3 * 33]); o.z = cvt_pk_bf16(s[4 * 33], s[5 * 33]); o.w = cvt_pk_bf16(s[6 * 33], s[7 * 33]);
        *(u32x4*)(WT + (size_t)(r0 + n) * K + k0 + 8 * c) = o; }
    LDS_WAIT(); asm volatile("" ::: "memory");
}
template <class RowMap>
__device__ __forceinline__ void transpose_item_f8(const float* W, int K, int N, unsigned char* WT, const RowMap& rm, LAS float* scr, int item, int lane) {
    const int nblk = N / 32, kb = item / nblk, nb = item % nblk, k0 = 64 * kb, n0 = 32 * nb;
    { f32x4 wv[8]; const int n4 = (lane & 7) * 4;
#pragma unroll
      for (int i = 0; i < 8; ++i) wv[i] = *(const f32x4*)(W + (size_t)(k0 + 8 * i + (lane >> 3)) * N + n0 + n4);
#pragma unroll
      for (int i = 0; i < 8; ++i) { LAS float* d = scr + (8 * i + (lane >> 3)) * 33 + n4; d[0] = wv[i].x * WDN_SCALE; d[1] = wv[i].y * WDN_SCALE; d[2] = wv[i].z * WDN_SCALE; d[3] = wv[i].w * WDN_SCALE; } }
    LDS_WAIT(); asm volatile("" ::: "memory");
    const int c = lane & 7; const int r0 = rm(n0);
#pragma unroll
    for (int j = 0; j < 4; ++j) { const int n = (lane >> 3) + 8 * j; const LAS float* sp = scr + (8 * c) * 33 + n;
        u32x2 o; o.x = pk4_fp8(sp[0 * 33], sp[1 * 33], sp[2 * 33], sp[3 * 33]); o.y = pk4_fp8(sp[4 * 33], sp[5 * 33], sp[6 * 33], sp[7 * 33]);
        *(u32x2*)(WT + (size_t)(r0 + n) * K + k0 + 8 * c) = o; }
    LDS_WAIT(); asm volatile("" ::: "memory");
}
struct RowIdent { const float* gain = nullptr; __device__ __forceinline__ int operator()(int n0) const { return n0; } };
struct RowGate { const float* gain = nullptr; __device__ __forceinline__ int operator()(int n0) const { return (n0 >> 7) * 256 + (n0 & 127); } };
struct RowUp { const float* gain = nullptr; __device__ __forceinline__ int operator()(int n0) const { return (n0 >> 7) * 256 + 128 + (n0 & 127); } };

__device__ __forceinline__ void norm_row(const float* xrow, bf16_t* orow, const f32x4 (&g)[4], f32x4 (&v)[4], int lane) {
    const f32x4* xr = (const f32x4*)xrow + lane; float s = 0.f;
#pragma unroll
    for (int j = 0; j < 4; ++j) { v[j] = xr[64 * j]; s += (v[j].x * v[j].x + v[j].y * v[j].y) + (v[j].z * v[j].z + v[j].w * v[j].w); }
    const float rs = 1.0f / sqrtf(wave_sum(s) * (1.f / D) + EPS);
    u32x2* o8 = (u32x2*)orow + lane;
#pragma unroll
    for (int j = 0; j < 4; ++j) { v[j] = v[j] * rs * g[j]; u32x2 w; w.x = cvt_pk_bf16(v[j].x, v[j].y); w.y = cvt_pk_bf16(v[j].z, v[j].w); o8[64 * j] = w; }
}

__device__ __forceinline__ int pi32(int i) { return 16 * ((i >> 2) & 1) + 4 * (i >> 3) + (i & 3); }
__device__ __forceinline__ bf16x8 pack8(const float* p) {
    u32x4 w; w.x = cvt_pk_bf16(p[0], p[1]); w.y = cvt_pk_bf16(p[2], p[3]); w.z = cvt_pk_bf16(p[4], p[5]); w.w = cvt_pk_bf16(p[6], p[7]);
    return __builtin_bit_cast(bf16x8, w);
}
__device__ __forceinline__ void unpack8(bf16x8 v, float* f) {
    const u32x4 w = __builtin_bit_cast(u32x4, v);
    f[0] = bf_lo(w.x); f[1] = bf_hi(w.x); f[2] = bf_lo(w.y); f[3] = bf_hi(w.y); f[4] = bf_lo(w.z); f[5] = bf_hi(w.z); f[6] = bf_lo(w.w); f[7] = bf_hi(w.w);
}
#define MFMA32(a, b, c) __builtin_amdgcn_mfma_f32_32x32x16_bf16((a), (b), (c), 0, 0, 0)
__device__ __forceinline__ u32x4 pair_halves(u32x2 even, u32x2 odd) {
    const auto x = __builtin_amdgcn_permlane32_swap(even.x, odd.x, false, false), y = __builtin_amdgcn_permlane32_swap(even.y, odd.y, false, false);
    return (u32x4){x[0], y[0], x[1], y[1]};
}

__device__ __forceinline__ void group_norm_store(const f32x16 (&o)[2], int h, int r32, int hi, const LAS float* gain, bf16_t* outrow0, LAS float* part  ) {
    float a = 0.f;
#pragma unroll
    for (int dd = 0; dd < 2; ++dd)
#pragma unroll
        for (int r = 0; r < 16; ++r) a += o[dd][r] * o[dd][r];
    a = xor32_add(a);
    if (hi == 0) part[h * 32 + r32] = a;
    __syncthreads();
    float tot = 0.f;
#pragma unroll
    for (int hh = 0; hh < 8; ++hh) tot += part[hh * 32 + r32];
    const float rs = 1.0f / sqrtf(tot * (1.f / 512.f) + EPS);
    bf16_t* orow = outrow0 + (size_t)r32 * 1024 + h * 64 + 8 * hi;
#pragma unroll
    for (int dd = 0; dd < 2; ++dd)
#pragma unroll
        for (int k = 0; k < 2; ++k) { u32x2 w[2];
#pragma unroll
            for (int e = 0; e < 2; ++e) { const int gq = 2 * k + e; const f32x4 gv = *(const LAS f32x4*)(gain + h * 64 + 32 * dd + 8 * gq + 4 * hi);
                w[e].x = cvt_pk_bf16(o[dd][4 * gq] * rs * gv.x, o[dd][4 * gq + 1] * rs * gv.y); w[e].y = cvt_pk_bf16(o[dd][4 * gq + 2] * rs * gv.z, o[dd][4 * gq + 3] * rs * gv.w); }
            *(u32x4*)(orow + 32 * dd + 16 * k) = pair_halves(w[0], w[1]); }
}

constexpr float SB_THR = -40.f * 1.4426950408889634f;
__device__ __forceinline__ void sb_block(const bf16x8 (&kf)[4], const bf16x8 (&vf)[2][2], const LAS bf16x8* qp  , f32x16 (&o)[2], float& C, int key0, int tq0  , int r32, int hi) {
    f32x16 s;
#pragma unroll
    for (int r = 0; r < 16; ++r) s[r] = 0.f;
#pragma unroll
    for (int d0 = 0; d0 < 4; ++d0) s = MFMA32(kf[d0], qp[64 * d0], s);
    const int tqr = tq0 + r32, kk0 = key0 + 16 * hi;
    float pre[16]; float run = 0.f; float p[16];
    if (key0 + 31 >= tq0) {
#pragma unroll
        for (int r = 15; r >= 0; --r) {
            const float z = s[r] * (0.125f * 1.4426950408889634f);
            const float sp = fmaxf(z, 0.f) + __builtin_amdgcn_logf(1.0f + __builtin_amdgcn_exp2f(-fabsf(z)));
            pre[r] = (z - sp) + run;
            run += ((kk0 + r) < tqr) ? -sp : 0.f;
        }
        const float other = xor32_get(run, hi);
        const float base = C + (hi == 0 ? other : 0.f);
#pragma unroll
        for (int r = 0; r < 16; ++r) p[r] = ((kk0 + r) < tqr) ? __builtin_amdgcn_exp2f(pre[r] + base) : 0.f;
        C += run + other;
    } else {
#pragma unroll
        for (int r = 15; r >= 0; --r) {
            const float z = s[r] * (0.125f * 1.4426950408889634f);
            const float sp = fmaxf(z, 0.f) + __builtin_amdgcn_logf(1.0f + __builtin_amdgcn_exp2f(-fabsf(z)));
            pre[r] = (z - sp) + run;
            run -= sp;
        }
        const float other = xor32_get(run, hi);
        const float base = C + (hi == 0 ? other : 0.f);
#pragma unroll
        for (int r = 0; r < 16; ++r) p[r] = __builtin_amdgcn_exp2f(pre[r] + base);
        C += run + other;
    }
    const bf16x8 pa0 = pack8(p), pa1 = pack8(p + 8);
#pragma unroll
    for (int dd = 0; dd < 2; ++dd) { o[dd] = MFMA32(vf[dd][0], pa0, o[dd]); o[dd] = MFMA32(vf[dd][1], pa1, o[dd]); }
}
__device__ __forceinline__ void sb_unit(const Frame& F, int b, int tq, const bf16_t* sbq, const bf16_t* sbk, const bf16_t* sbvT, const LAS float* gain, bf16_t* mixed, LAS float* part, LAS unsigned char* lds) {
    int lane = F.lane; asm volatile("" : "+v"(lane));
    const int r32 = lane & 31, hi = lane >> 5, h = F.wave;
    const size_t rowbase = (size_t)b * SEQ; const int t0 = tq * 64;
    LAS bf16x8* qlds = (LAS bf16x8*)(lds + h * 8192) + lane;
    { bf16x8 qt[8];
#pragma unroll
      for (int i = 0; i < 8; ++i) qt[i] = *(const bf16x8*)(sbq + (rowbase + t0 + 32 * (i >> 2) + r32) * 512 + h * 64 + 16 * (i & 3) + 8 * hi);
#pragma unroll
      for (int i = 0; i < 8; ++i) qlds[64 * i] = qt[i]; }
    f32x16 o[2][2];
#pragma unroll
    for (int g = 0; g < 2; ++g)
#pragma unroll
        for (int dd = 0; dd < 2; ++dd)
#pragma unroll
            for (int r = 0; r < 16; ++r) o[g][dd][r] = 0.f;
    float C[2] = {0.f, 0.f};
    const bf16_t* kbase = sbk + (rowbase + pi32(r32)) * 512 + h * 64 + 8 * hi;
    const bf16_t* vbase = sbvT + ((size_t)(b * 8 + h) * 64 + r32) * SEQ + 16 * hi;
#define SB_LOAD(KF, VF, kb_) do { const int k0_ = (kb_) * 32; \
        _Pragma("unroll") for (int d0 = 0; d0 < 4; ++d0) KF[d0] = *(const bf16x8*)(kbase + (size_t)k0_ * 512 + 16 * d0); \
        _Pragma("unroll") for (int dd = 0; dd < 2; ++dd) _Pragma("unroll") for (int s_ = 0; s_ < 2; ++s_) VF[dd][s_] = *(const bf16x8*)(vbase + (size_t)(32 * dd) * SEQ + k0_ + 8 * s_); } while (0)
#define SB_STEP(KF, VF, kb_) do { const int k0_ = (kb_) * 32; \
        _Pragma("unroll") for (int g = 0; g < 2; ++g) { if (k0_ > t0 + 32 * g + 31) continue; if (__all(C[g] < SB_THR)) continue; sb_block(KF, VF, qlds + 256 * g, o[g], C[g], k0_, t0 + 32 * g, r32, hi); } } while (0)
    bf16x8 kfA[4], vfA[2][2], kfB[4], vfB[2][2];
    int kb = 2 * tq + 1;
    SB_LOAD(kfA, vfA, kb);
    for (;;) {
        SB_LOAD(kfB, vfB, kb >= 1 ? kb - 1 : 0);
        SB_STEP(kfA, vfA, kb);
        if (kb == 0 || __all(C[0] < SB_THR && C[1] < SB_THR)) break;
        SB_LOAD(kfA, vfA, kb >= 2 ? kb - 2 : 0);
        SB_STEP(kfB, vfB, kb - 1);
        if (kb == 1 || __all(C[0] < SB_THR && C[1] < SB_THR)) break;
        kb -= 2;
    }
#undef SB_LOAD
#undef SB_STEP
    group_norm_store(o[0], h, r32, hi, gain, mixed + (rowbase + t0) * 1024, part);
    group_norm_store(o[1], h, r32, hi, gain, mixed + (rowbase + t0 + 32) * 1024, part + 256);
}

constexpr int SW_KROW = 144, SW_VROW = 400;
constexpr int SW_KS = 0, SW_VT = 2 * 192 * SW_KROW, SW_END = SW_VT + 2 * 64 * SW_VROW;
template <bool INTERIOR>
__device__ __forceinline__ void swa_groups(const bf16x8 (&qraw0)[4], const bf16x8 (&qraw1)[4], int h, int kvh, int r32, int hi, int kstart, size_t rowbase, int t0, const LAS float* qgain, float sink, const LAS float* ogain,
                                           bf16_t* mixed, LAS unsigned char* lds, const LAS float* bias, LAS float* part) {
#pragma nounroll
    for (int g = 0; g < 2; ++g) {
        f32x16 o[2];
        bf16x8 qf[4];
        { float qv[4][8]; float ss = 0.f;
#pragma unroll
          for (int d0 = 0; d0 < 4; ++d0) { unpack8(g ? qraw1[d0] : qraw0[d0], qv[d0]);
#pragma unroll
              for (int jj = 0; jj < 8; ++jj) ss += qv[d0][jj] * qv[d0][jj]; }
          ss = xor32_add(ss);
          const float rs = (0.125f * 1.4426950408889634f) / sqrtf(ss * (1.f / 64.f) + EPS);
#pragma unroll
          for (int d0 = 0; d0 < 4; ++d0) { const f32x4 g0 = *(const LAS f32x4*)(qgain + 16 * d0 + 8 * hi), g1 = *(const LAS f32x4*)(qgain + 16 * d0 + 8 * hi + 4);
              float qn[8] = {qv[d0][0] * rs * g0.x, qv[d0][1] * rs * g0.y, qv[d0][2] * rs * g0.z, qv[d0][3] * rs * g0.w, qv[d0][4] * rs * g1.x, qv[d0][5] * rs * g1.y, qv[d0][6] * rs * g1.z, qv[d0][7] * rs * g1.w};
              qf[d0] = pack8(qn); } }
        f32x16 sc[5];
        const int qw = 128 + 32 * g + r32;
#pragma unroll
        for (int jb = 0; jb < 5; ++jb) {
            const LAS unsigned char* kp = lds + SW_KS + (kvh * 192 + 32 * (g + jb) + pi32(r32)) * SW_KROW + 16 * hi;
#pragma unroll
            for (int r = 0; r < 16; ++r) sc[jb][r] = 0.f;
#pragma unroll
            for (int d0 = 0; d0 < 4; ++d0) sc[jb] = MFMA32(*(const LAS bf16x8*)(kp + 32 * d0), qf[d0], sc[jb]);
        }
        float m = sink;
#pragma unroll
        for (int jb = 0; jb < 5; ++jb) {
            const int kb = g + jb;
            const LAS float* bt = bias + h * 128 + (qw - 32 * kb - 16 * hi - 15);
            float bv[16];
#pragma unroll
            for (int r = 0; r < 16; ++r) bv[r] = bt[15 - r];
            const int d0_ = qw - 32 * kb - 16 * hi;
            if constexpr (INTERIOR) {
#pragma unroll
                for (int r = 0; r < 16; ++r) { const bool valid = (jb == 0) ? (d0_ - r < 128) : (jb == 4) ? (d0_ - r >= 0) : true;
                    const float v = valid ? sc[jb][r] + bv[r] : -INFINITY; sc[jb][r] = v; m = fmaxf(m, v); }
            } else {
#pragma unroll
                for (int r = 0; r < 16; ++r) { const int kw = 32 * kb + 16 * hi + r, dist = d0_ - r; const bool valid = (dist >= 0) && (dist < 128) && (kstart + kw >= 0);
                    const float v = valid ? sc[jb][r] + bv[r] : -INFINITY; sc[jb][r] = v; m = fmaxf(m, v); }
            }
        }
        m = xor32_max(m);
        float l = 0.f;
#pragma unroll
        for (int jb = 0; jb < 5; ++jb)
#pragma unroll
            for (int r = 0; r < 16; ++r) { const float p = __builtin_amdgcn_exp2f(sc[jb][r] - m); sc[jb][r] = p; l += p; }
        l = xor32_add(l); l += __builtin_amdgcn_exp2f(sink - m);
#pragma unroll
        for (int dd = 0; dd < 2; ++dd)
#pragma unroll
            for (int r = 0; r < 16; ++r) o[dd][r] = 0.f;
#pragma unroll
        for (int jb = 0; jb < 5; ++jb) {
            const int kb = g + jb;
            float p[16];
#pragma unroll
            for (int r = 0; r < 16; ++r) p[r] = sc[jb][r];
            const bf16x8 pa0 = pack8(p), pa1 = pack8(p + 8);
#pragma unroll
            for (int dd = 0; dd < 2; ++dd) { const LAS unsigned char* vp = lds + SW_VT + (kvh * 64 + 32 * dd + r32) * SW_VROW; const int vsw = (4 * dd + (r32 >> 3)) & 7, vc = 4 * kb + 2 * hi;
                o[dd] = MFMA32(*(const LAS bf16x8*)(vp + ((vc ^ vsw) << 4)), pa0, o[dd]); o[dd] = MFMA32(*(const LAS bf16x8*)(vp + (((vc + 1) ^ vsw) << 4)), pa1, o[dd]); }
        }
        const float inv = 1.0f / l;
#pragma unroll
        for (int dd = 0; dd < 2; ++dd)
#pragma unroll
            for (int r = 0; r < 16; ++r) o[dd][r] *= inv;
        group_norm_store(o, h, r32, hi, ogain, mixed + (rowbase + t0 + 32 * g) * 1024 + 512, part + 256 * g);
    }
}
__device__ __forceinline__ void swa_unit(const Frame& F, int b, int tq, const bf16_t* swq, const bf16_t* swkv, const LAS float* qgain, const LAS float* kgain, const LAS float* sinks, const LAS float* ogain,
                                         bf16_t* mixed, LAS unsigned char* lds, const LAS float* bias, LAS float* part) {
    int tid = F.tid; asm volatile("" : "+v"(tid));
    const int lane = tid & 63, r32 = lane & 31, hi = lane >> 5, h = F.wave, kvh = h >> 2;
    const size_t rowbase = (size_t)b * SEQ; const int t0 = tq * 64, kstart = t0 - 128;
    bf16x8 qraw0[4], qraw1[4];
#pragma unroll
    for (int d0 = 0; d0 < 4; ++d0) { qraw0[d0] = *(const bf16x8*)(swq + (rowbase + t0 + r32) * 512 + h * 64 + 16 * d0 + 8 * hi); qraw1[d0] = *(const bf16x8*)(swq + (rowbase + t0 + 32 + r32) * 512 + h * 64 + 16 * d0 + 8 * hi); }
    bf16x8 kraw[6], vraw[6];
#pragma unroll
    for (int i = 0; i < 6; ++i) {
        const int c = tid + 512 * i, row = c >> 3, p8 = c & 7, kv = row / 192, j = row - kv * 192, spos = kstart + j;
        const bf16_t* src = swkv + (rowbase + (spos > 0 ? spos : 0)) * 256 + kv * 64 + 8 * p8; kraw[i] = *(const bf16x8*)src; vraw[i] = *(const bf16x8*)(src + 128);
    }
#pragma unroll
    for (int i = 0; i < 6; ++i) {
        const int c = tid + 512 * i, row = c >> 3, p8 = c & 7, kv = row / 192, j = row - kv * 192, spos = kstart + j;
        float kfv[8]; unpack8(kraw[i], kfv); bf16x8 vr = vraw[i];
        if (spos < 0) {
#pragma unroll
            for (int jj = 0; jj < 8; ++jj) { kfv[jj] = 0.f; vr[jj] = 0; } }
        float ss = 0.f;
#pragma unroll
        for (int jj = 0; jj < 8; ++jj) ss += kfv[jj] * kfv[jj];
        ss += lane_xor<1>(ss); ss += lane_xor<2>(ss); ss += lane_xor<4>(ss);
        const float rs = 1.0f / sqrtf(ss * (1.f / 64.f) + EPS);
        const f32x4 g0 = *(const LAS f32x4*)(kgain + 8 * p8), g1 = *(const LAS f32x4*)(kgain + 8 * p8 + 4);
        float kn[8] = {kfv[0] * rs * g0.x, kfv[1] * rs * g0.y, kfv[2] * rs * g0.z, kfv[3] * rs * g0.w, kfv[4] * rs * g1.x, kfv[5] * rs * g1.y, kfv[6] * rs * g1.z, kfv[7] * rs * g1.w};
        *(LAS bf16x8*)(lds + SW_KS + (kv * 192 + j) * SW_KROW + 16 * p8) = pack8(kn);
#pragma unroll
        for (int jj = 0; jj < 8; ++jj) *(LAS short*)(lds + SW_VT + (kv * 64 + 8 * p8 + jj) * SW_VROW + ((((j >> 3) ^ p8) << 4) + 2 * (j & 7))) = vr[jj];
    }
    __syncthreads();
    const float sink = sinks[h] * 1.4426950408889634f;
    if (kstart >= 0) swa_groups<true>(qraw0, qraw1, h, kvh, r32, hi, kstart, rowbase, t0, qgain, sink, ogain, mixed, lds, bias, part);
    else             swa_groups<false>(qraw0, qraw1, h, kvh, r32, hi, kstart, rowbase, t0, qgain, sink, ogain, mixed, lds, bias, part);
}

__device__ __forceinline__ void xattn_stage(const Frame& F, int b, int hx, const bf16_t* kn, const bf16_t* vt, LAS unsigned char* lds) {
    int tid = F.tid; asm volatile("" : "+v"(tid));
    { const bf16_t* ksrc = kn + (size_t)(b * NMEM) * 512 + hx * 128; const bf16_t* vsrc = vt + (size_t)((b * 4 + hx) * 128) * NMEM;
#pragma unroll
      for (int half = 0; half < 2; ++half) { u32x4 kv[4], vv[4];
#pragma unroll
          for (int i = 0; i < 4; ++i) { const int c = tid + 512 * (half * 4 + i);
              const int krow = c >> 4, kch = c & 15; kv[i] = *(const u32x4*)(ksrc + (size_t)krow * 512 + kch * 8);
              const int vrow = c >> 5, vch = c & 31; vv[i] = *(const u32x4*)(vsrc + (size_t)vrow * NMEM + vch * 8); }
#pragma unroll
          for (int i = 0; i < 4; ++i) { const int c = tid + 512 * (half * 4 + i);
              const int krow = c >> 4, kch = c & 15; *(LAS u32x4*)(lds + krow * 256 + ((kch ^ (krow & 15)) << 4)) = kv[i];
              const int vrow = c >> 5, vch = c & 31; *(LAS u32x4*)(lds + 65536 + vrow * 512 + ((vch ^ (vrow & 31)) << 4)) = vv[i]; } } }
}
__device__ __forceinline__ void xattn_tile(const Frame& F, int b, int hx, int qt, const bf16_t* xq, const LAS float* qgain  , bf16_t* xo, LAS unsigned char* lds) {
    int tid = F.tid; asm volatile("" : "+v"(tid));
    const int lane = tid & 63, r32 = lane & 31, hi = lane >> 5, w = F.wave;
    const size_t row = (size_t)b * SEQ + qt * 256 + 32 * w + r32;
    bf16x8 qf[8];
    { float ss = 0.f; float qv[8][8];
#pragma unroll
      for (int d0 = 0; d0 < 8; ++d0) { unpack8(*(const bf16x8*)(xq + row * 512 + hx * 128 + 16 * d0 + 8 * hi), qv[d0]);
#pragma unroll
          for (int jj = 0; jj < 8; ++jj) ss += qv[d0][jj] * qv[d0][jj]; }
      ss = xor32_add(ss);
      const float rs = (0.08838834764831845f * 1.4426950408889634f) / sqrtf(ss * (1.f / 128.f) + EPS);
#pragma unroll
      for (int d0 = 0; d0 < 8; ++d0) { const f32x4 g0 = *(const LAS f32x4*)(qgain + 16 * d0 + 8 * hi), g1 = *(const LAS f32x4*)(qgain + 16 * d0 + 8 * hi + 4);
          float qn[8] = {qv[d0][0] * rs * g0.x, qv[d0][1] * rs * g0.y, qv[d0][2] * rs * g0.z, qv[d0][3] * rs * g0.w, qv[d0][4] * rs * g1.x, qv[d0][5] * rs * g1.y, qv[d0][6] * rs * g1.z, qv[d0][7] * rs * g1.w};
          qf[d0] = pack8(qn); } }
    f32x16 o[4];
#pragma unroll
    for (int dd = 0; dd < 4; ++dd)
#pragma unroll
        for (int r = 0; r < 16; ++r) o[dd][r] = 0.f;
    float m = -INFINITY, l = 0.f;
    const int pk = pi32(r32);
#pragma nounroll
    for (int kb = 0; kb < 8; ++kb) {
        const int krow = 32 * kb + pk; const LAS unsigned char* kp = lds + krow * 256; const int ksw = krow & 15;
        f32x16 s;
#pragma unroll
        for (int r = 0; r < 16; ++r) s[r] = 0.f;
#pragma unroll
        for (int d0 = 0; d0 < 8; ++d0) s = MFMA32(*(const LAS bf16x8*)(kp + (((2 * d0 + hi) ^ ksw) << 4)), qf[d0], s);
        float rm = s[0];
#pragma unroll
        for (int r = 1; r < 16; ++r) rm = fmaxf(rm, s[r]);
        rm = xor32_max(rm);
        const bool resc = __any(rm > m + 8.0f);
        float f = 1.0f;
        if (resc) { const float mn = fmaxf(m, rm); f = __builtin_amdgcn_exp2f(m - mn); m = mn; l *= f; }
        float p[16]; float ls = 0.f;
#pragma unroll
        for (int r = 0; r < 16; ++r) { p[r] = __builtin_amdgcn_exp2f(s[r] - m); ls += p[r]; }
        l += ls;
        const bf16x8 pa0 = pack8(p), pa1 = pack8(p + 8);
#pragma unroll
        for (int dd = 0; dd < 4; ++dd) {
            if (resc) {
#pragma unroll
                for (int r = 0; r < 16; ++r) o[dd][r] *= f; }
            const int vrow = 32 * dd + r32; const LAS unsigned char* vp = lds + 65536 + vrow * 512; const int vsw = vrow & 31, vc = 4 * kb + 2 * hi;
            o[dd] = MFMA32(*(const LAS bf16x8*)(vp + ((vc ^ vsw) << 4)), pa0, o[dd]); o[dd] = MFMA32(*(const LAS bf16x8*)(vp + (((vc + 1) ^ vsw) << 4)), pa1, o[dd]); }
    }
    l = xor32_add(l);
    const float inv = 1.0f / l;
    bf16_t* orow = xo + row * 512 + hx * 128 + 8 * hi;
#pragma unroll
    for (int dd = 0; dd < 4; ++dd)
#pragma unroll
        for (int k = 0; k < 2; ++k) { u32x2 w[2];
#pragma unroll
            for (int e = 0; e < 2; ++e) { const int gq = 2 * k + e; w[e].x = cvt_pk_bf16(o[dd][4 * gq] * inv, o[dd][4 * gq + 1] * inv); w[e].y = cvt_pk_bf16(o[dd][4 * gq + 2] * inv, o[dd][4 * gq + 3] * inv); }
            *(u32x4*)(orow + 32 * dd + 16 * k) = pair_halves(w[0], w[1]); }
}

using pg8::Unit; using pg8::Out;
__device__ __forceinline__ float* ssq_slot(unsigned char* ws, int s) { return (float*)(ws + WS_SSQ) + (size_t)s * T * 4; }
struct SchedWin {
    int G, c, l; unsigned char* ws;
    __device__ __forceinline__ bool next(int i, Unit& u) const {
        const int L = i * G + c; if (L >= 256 * 9) return false; int pm, pn; pg8::tile_of(L, 256, 9, pm, pn); u.pm = pm; u.pn = pn;
        const char* arow = (const char*)(ws + WS_XQW) + (size_t)pm * 256 * 1024; const char* brow = (const char*)(ws + WS_WIN) + ((size_t)l * 2304 + pn * 256) * 1024;
        const float* asc = (const float*)(ws + WS_WSC + SC_ROWW) + (size_t)pm * 256; const float* bsc = (const float*)(ws + WS_WSC + SC_WIN) + (size_t)l * 2304 + pn * 256;
        if ((pn >> 1) == 2) { u.a = brow; u.b = arow; u.sc = bsc; u.sc2 = asc; } else { u.a = arow; u.b = brow; u.sc = asc; u.sc2 = bsc; }
        return true;
    }
    __device__ __forceinline__ void out(const Unit& u, Out& e) const {
        const int pm = u.pm, pn = u.pn; char* proj = (char*)(ws + WS_PROJ); e.r = nullptr; e.xb = nullptr; e.ssq = nullptr; e.scmode = 1;
        if (pn == 4 || pn == 5) { const int b = pm >> 3, t0 = (pm & 7) * 256; e.o = proj + PJ_SBVT + ((size_t)((b * 8 + 4 * (pn - 4)) * 64) * SEQ + t0) * 2; e.ldo = SEQ; }
        else if (pn < 2) { e.o = proj + PJ_SBQ + ((size_t)pm * 256 * 512 + pn * 256) * 2; e.ldo = 512; }
        else if (pn < 4) { e.o = proj + PJ_SBK + ((size_t)pm * 256 * 512 + (pn - 2) * 256) * 2; e.ldo = 512; }
        else if (pn < 8) { e.o = proj + PJ_SWQ + ((size_t)pm * 256 * 512 + (pn - 6) * 256) * 2; e.ldo = 512; }
        else             { e.o = proj + PJ_SWKV + ((size_t)pm * 256 * 256) * 2; e.ldo = 256; }
    }
};
struct SchedRes {
    int G, c, l, which; unsigned char* ws;
    __device__ __forceinline__ bool next(int i, Unit& u) const {
        const int L = i * G + c; if (L >= 1024) return false; int pm, pn; pg8::tile_of(L, 256, 4, pm, pn); u.pm = pm; u.pn = pn; u.sc = nullptr; u.sc2 = nullptr;
        if (which == 0) { u.a = (const char*)(ws + WS_YS) + (size_t)pm * 256 * 1024 * 2; u.b = (const char*)(ws + WS_WOUT) + ((size_t)l * 1024 + pn * 256) * 1024 * 2; }
        else            { u.a = (const char*)(ws + WS_PROJ + PJ_XO) + (size_t)pm * 256 * 512 * 2; u.b = (const char*)(ws + WS_WO) + ((size_t)l * 1024 + pn * 256) * 512 * 2; }
        return true;
    }
    __device__ __forceinline__ void out(const Unit& u, Out& e) const {
        const size_t eoff = (size_t)u.pm * 256 * 1024 + u.pn * 256; e.o = nullptr; e.r = nullptr; e.ldo = 1024; e.scmode = 0;
        e.xb = (bf16_t*)(ws + WS_XB) + eoff; e.ssq = ssq_slot(ws, 3 * l + 1 + which) + (size_t)u.pm * 256 * 4 + u.pn;
    }
};
struct SchedWq {
    int G, c, l; unsigned char* ws;
    __device__ __forceinline__ bool next(int i, Unit& u) const {
        const int L = i * G + c; if (L >= 512) return false; int pm, pn; pg8::tile_of(L, 256, 2, pm, pn); u.pm = pm; u.pn = pn;
        u.a = (const char*)(ws + WS_XB) + (size_t)pm * 256 * 1024 * 2; u.b = (const char*)(ws + WS_WQ) + ((size_t)l * 512 + pn * 256) * 1024 * 2; u.sc = ssq_slot(ws, 3 * l + 1) + (size_t)pm * 256 * 4; u.sc2 = nullptr; return true;
    }
    __device__ __forceinline__ void out(const Unit& u, Out& e) const { e.o = (char*)(ws + WS_PROJ + PJ_XQ) + ((size_t)u.pm * 256 * 512 + u.pn * 256) * 2; e.r = nullptr; e.ldo = 512; e.xb = nullptr; e.ssq = nullptr; e.scmode = 1; }
};
struct SchedKV {
    int G, c; unsigned char* ws;
    __device__ __forceinline__ bool next(int i, Unit& u) const {
        const int L = i * G + c; if (L >= 512) return false; const int l = L >> 7, rem = L & 127; u.pm = L; u.pn = 0; u.sc = nullptr; u.sc2 = nullptr;
        const char* hml = (const char*)(ws + WS_PROJ + PJ_HM) + (size_t)l * 8192 * 1024 * 2; const char* wl = (const char*)(ws + WS_WKV) + (size_t)l * 1024 * 1024 * 2;
        if (rem < 64) { const int pm = rem >> 1, pn = rem & 1; u.a = hml + (size_t)pm * 256 * 1024 * 2; u.b = wl + (size_t)pn * 256 * 1024 * 2; }
        else { const int r2 = rem - 64, bb = r2 >> 1, dt = r2 & 1; u.a = wl + (size_t)(512 + dt * 256) * 1024 * 2; u.b = hml + (size_t)bb * 256 * 1024 * 2; }
        return true;
    }
    __device__ __forceinline__ void out(const Unit& u, Out& e) const {
        const int L = u.pm, l = L >> 7, rem = L & 127; e.r = nullptr; e.xb = nullptr; e.ssq = nullptr; e.scmode = 0;
        if (rem < 64) { const int pm = rem >> 1, pn = rem & 1; e.o = (char*)(ws + WS_YS) + (size_t)l * 8192 * 512 * 2 + ((size_t)pm * 256 * 512 + pn * 256) * 2; e.ldo = 512; }
        else { const int r2 = rem - 64, bb = r2 >> 1, dt = r2 & 1; e.o = (char*)(ws + WS_VT) + (size_t)l * 8192 * 512 * 2 + ((size_t)(bb * 4 + 2 * dt) * 128 * 256) * 2; e.ldo = 256; }
    }
};
struct SchedGU {
    int G, c, nM, ch, l; unsigned char* ws; const LAS int* pblk;
    __device__ __forceinline__ bool next(int i, Unit& u) const {
        const int L = i * G + c; if (L >= nM * 28) return false; int pm, pn; pg8::tile_of(L, nM, 28, pm, pn); u.pm = pm; u.pn = pn;
        if (pblk) { const int blk = ch * CHUNK_BLK + pm; int e = 0;
#pragma unroll
            for (int k = 1; k < 8; ++k) e += (pblk[k] <= blk) ? 1 : 0;
            e = __builtin_amdgcn_readfirstlane(e);
            u.a = (const char*)(ws + WS_PROJ + PJ_GB) + (size_t)(ch & 1) * GB_BUF + (size_t)pm * 256 * 1024; u.b = (const char*)(ws + WS_EGU) + ((size_t)e * 7168 + pn * 256) * 1024;
            u.sc = (const float*)(ws + WS_WSC + SC_SROW) + ((size_t)ch * CHUNK_BLK + pm) * 256; u.sc2 = (const float*)(ws + WS_WSC + SC_WE) + (size_t)e * 7168 + pn * 256; }
        else { const size_t row0 = ((size_t)ch * CHUNK_BLK + pm) * 256;
            u.a = (const char*)(ws + WS_PROJ + PJ_XQ8) + row0 * 1024; u.b = (const char*)(ws + WS_WGU) + ((size_t)(l >> 1) * 7168 + pn * 256) * 1024;
            u.sc = (const float*)(ws + WS_WSC + SC_ROW) + row0; u.sc2 = (const float*)(ws + WS_WSC + SC_WD) + (size_t)(l >> 1) * 7168 + pn * 256; }
        return true;
    }
    __device__ __forceinline__ void out(const Unit& u, Out& e) const { e.o = (char*)(ws + WS_PROJ + PJ_H) + (size_t)(ch & 1) * H_BUF + ((size_t)u.pm * 256 * FF + u.pn * 128); e.r = nullptr; e.ldo = FF; e.xb = nullptr; e.ssq = nullptr; e.scmode = 1; }
};
struct SchedDown {
    int G, c, nM, ch, l; unsigned char* ws; const LAS int* pblk;
    __device__ __forceinline__ bool next(int i, Unit& u) const {
        const int L = i * G + c; if (L >= nM * 4) return false; int pm, pn; pg8::tile_of(L, nM, 4, pm, pn); u.pm = pm; u.pn = pn; u.sc = nullptr; u.sc2 = nullptr;
        int e = 0; if (pblk) { const int blk = ch * CHUNK_BLK + pm;
#pragma unroll
            for (int k = 1; k < 8; ++k) e += (pblk[k] <= blk) ? 1 : 0;
            e = __builtin_amdgcn_readfirstlane(e); }
        u.a = (const char*)(ws + WS_PROJ + PJ_H) + (size_t)(ch & 1) * H_BUF + (size_t)pm * 256 * FF;
        u.b = (pblk ? (const char*)(ws + WS_EDN) + (size_t)e * 1024 * FF : (const char*)(ws + WS_WDN) + (size_t)(l >> 1) * 1024 * FF) + (size_t)pn * 256 * FF; return true;
    }
    __device__ __forceinline__ void out(const Unit& u, Out& e) const {
        const size_t eoff = ((size_t)ch * CHUNK_BLK + u.pm) * 256 * 1024 + u.pn * 256; e.ldo = 1024; e.scmode = 0;
        if (pblk) { e.o = (char*)((bf16_t*)(ws + WS_YS) + eoff); e.r = nullptr; e.xb = nullptr; e.ssq = nullptr; }
        else { e.o = nullptr; e.r = nullptr; e.xb = (bf16_t*)(ws + WS_XB) + eoff; e.ssq = ssq_slot(ws, 3 * l + 3) + ((size_t)ch * CHUNK_BLK + u.pm) * 256 * 4 + u.pn; }
    }
};

__constant__ unsigned char T5B[128] = {0,1,2,3,4,5,6,7,8,9,10,11,12,13,14,15,16,16,16,17,17,18,18,18,19,19,19,20,20,20,20,21,21,21,21,22,22,22,22,22,23,23,23,23,23,23,24,24,24,24,24,24,25,25,25,25,25,25,25,26,26,26,26,26,26,26,26,27,27,27,27,27,27,27,27,27,27,28,28,28,28,28,28,28,28,28,28,29,29,29,29,29,29,29,29,29,29,29,29,30,30,30,30,30,30,30,30,30,30,30,30,30,30,31,31,31,31,31,31,31,31,31,31,31,31,31,31,31};

__device__ __forceinline__ void moe_meta(const Frame& F, unsigned* gcnt, LAS int* meta) {
    __syncthreads();
    if (F.tid < 8) meta[F.tid] = (int)__hip_atomic_load(gcnt + 64 * F.tid, __ATOMIC_RELAXED, __HIP_MEMORY_SCOPE_AGENT);
    __syncthreads();
    if (F.tid == 0) { int pre = 0;
        for (int e = 0; e < 8; ++e) { meta[8 + e] = pre; pre += (meta[e] + 255) >> 8; }
        meta[16] = pre; }
    __syncthreads();
}
__device__ __forceinline__ int expert_of_blk(const LAS int* pblk, int blk) { int e = 0;
#pragma unroll
    for (int k = 1; k < 8; ++k) e += (pblk[k] <= blk) ? 1 : 0;
    return e; }

__device__ __forceinline__ float lane_max16(float v) { v = fmaxf(v, lane_xor<1>(v)); v = fmaxf(v, lane_xor<2>(v)); v = fmaxf(v, lane_xor<4>(v)); return fmaxf(v, lane_xor<8>(v)); }
__device__ __forceinline__ float wave_max(float v) { v = lane_max16(v); v = fmaxf(v, lane_xor<16>(v)); return xor32_max(v); }
__device__ __forceinline__ unsigned q4(float a, float b, float c, float d, float inv) {
    const int qa = (int)rintf(a * inv), qb = (int)rintf(b * inv), qc = (int)rintf(c * inv), qd = (int)rintf(d * inv);
    return (unsigned)(qa & 255) | ((unsigned)(qb & 255) << 8) | ((unsigned)(qc & 255) << 16) | ((unsigned)(qd & 255) << 24);
}
struct StripDesc { const float* src; const float* gain; signed char* W8; float* wscale; int N, dr0; };
__device__ __forceinline__ void strip_issue(const Frame& F, const StripDesc& d, f32x4 (&wv)[16], float (&gk)[16]) {
    const int kk = F.tid >> 3, n4 = (F.tid & 7) * 4;
#pragma unroll
    for (int p = 0; p < 16; ++p) wv[p] = *(const f32x4*)(d.src + (size_t)(p * 64 + kk) * d.N + n4);
#pragma unroll
    for (int p = 0; p < 16; ++p) gk[p] = d.gain[p * 64 + kk];
}
__device__ __forceinline__ void strip_to_lds(const Frame& F, const f32x4 (&wv)[16], const float (&gk)[16]) {
    constexpr int SP = 1028; LAS float* st = (LAS float*)F.lds; const int kk = F.tid >> 3, n4 = (F.tid & 7) * 4;
#pragma unroll
    for (int p = 0; p < 16; ++p) { const int k = p * 64 + kk; const float g = gk[p];
        st[(n4 + 0) * SP + k] = wv[p].x * g; st[(n4 + 1) * SP + k] = wv[p].y * g; st[(n4 + 2) * SP + k] = wv[p].z * g; st[(n4 + 3) * SP + k] = wv[p].w * g; }
}
__device__ __forceinline__ void strip_quant(const Frame& F, const StripDesc& d) {
    constexpr int SP = 1028; LAS float* st = (LAS float*)F.lds;
    const int n = F.tid >> 4, cch = F.tid & 15; const LAS f32x4* row = (const LAS f32x4*)(st + n * SP + cch * 64);
    f32x4 v[16]; float mx = 0.f;
#pragma unroll
    for (int j = 0; j < 16; ++j) { v[j] = row[j]; mx = fmaxf(mx, fmaxf(fmaxf(fabsf(v[j].x), fabsf(v[j].y)), fmaxf(fabsf(v[j].z), fabsf(v[j].w)))); }
    mx = lane_max16(mx);
    const float sc = mx > 0.f ? mx * (1.f / 127.f) : 1.f, inv = 1.0f / sc; const int dr = d.dr0 + n;
    u32x4* dst = (u32x4*)(d.W8 + (size_t)dr * 1024 + cch * 64);
#pragma unroll
    for (int j = 0; j < 4; ++j) { u32x4 w; w.x = q4(v[4 * j].x, v[4 * j].y, v[4 * j].z, v[4 * j].w, inv); w.y = q4(v[4 * j + 1].x, v[4 * j + 1].y, v[4 * j + 1].z, v[4 * j + 1].w, inv);
        w.z = q4(v[4 * j + 2].x, v[4 * j + 2].y, v[4 * j + 2].z, v[4 * j + 2].w, inv); w.w = q4(v[4 * j + 3].x, v[4 * j + 3].y, v[4 * j + 3].z, v[4 * j + 3].w, inv); dst[j] = w; }
    if (cch == 0) d.wscale[dr] = sc;
}
template <class DescFn>
__device__ __forceinline__ void convert_strip_list(const Frame& F, int nstrips, DescFn desc) {
    int fs = F.bx; if (fs >= nstrips) return;
    StripDesc d = desc(fs); f32x4 wv[16]; float gk[16]; strip_issue(F, d, wv, gk);
#pragma nounroll
    for (;;) {
        strip_to_lds(F, wv, gk);
        __syncthreads();
        const int nx = fs + F.G; const bool more = nx < nstrips; StripDesc dn = d;
        if (more) { dn = desc(nx); strip_issue(F, dn, wv, gk); }
        strip_quant(F, d);
        __syncthreads();
        if (!more) break;
        d = dn; fs = nx;
    }
}
__device__ __forceinline__ float quant_regs_i8(const u32x2 (&xw)[4], signed char* qrow, int lane) {
    f32x4 v[4]; float mx = 0.f;
#pragma unroll
    for (int j = 0; j < 4; ++j) { const u32x2 w = xw[j]; v[j] = (f32x4){bf_lo(w.x), bf_hi(w.x), bf_lo(w.y), bf_hi(w.y)}; mx = fmaxf(mx, fmaxf(fmaxf(fabsf(v[j].x), fabsf(v[j].y)), fmaxf(fabsf(v[j].z), fabsf(v[j].w)))); }
    mx = wave_max(mx);
    const float sc = mx > 0.f ? mx * (1.f / 127.f) : 1.f, inv = 1.0f / sc;
    unsigned* q = (unsigned*)qrow + lane;
#pragma unroll
    for (int j = 0; j < 4; ++j) q[64 * j] = q4(v[j].x, v[j].y, v[j].z, v[j].w, inv);
    return sc;
}
__device__ __forceinline__ void load_row4(u32x2 (&xw)[4], const bf16_t* xrow, int lane) { const u32x2* xr = (const u32x2*)xrow + lane;
#pragma unroll
    for (int j = 0; j < 4; ++j) xw[j] = xr[64 * j]; }
__device__ __forceinline__ void quant_pass(const Frame& F, const bf16_t* xb, const float* sq, signed char* xq, float* rowsc) {
    const int gw = F.bx * NWAVES + F.wave, NGW = F.G * NWAVES;
    if (gw >= T) return;
#define QP_LOAD(XW, SP, m0_) do { _Pragma("unroll") for (int i = 0; i < 4; ++i) { const int m_ = (m0_) + i * NGW, mm_ = m_ < T ? m_ : gw; load_row4(XW[i], xb + (size_t)mm_ * D, F.lane); SP[i] = *(const f32x4*)(sq + (size_t)mm_ * 4); } } while (0)
#define QP_DO(XW, SP, m0_) do { _Pragma("unroll") for (int i = 0; i < 4; ++i) { const int m_ = (m0_) + i * NGW; if (m_ < T) { const float sc_ = quant_regs_i8(XW[i], xq + (size_t)m_ * D, F.lane); \
            if (F.lane == 0) rowsc[m_] = sc_ / sqrtf(((SP[i].x + SP[i].y) + (SP[i].z + SP[i].w)) * (1.f / 1024.f) + EPS); } } } while (0)
    u32x2 xa[4][4], xb2[4][4]; f32x4 spa[4], spb[4];
    int m0 = gw; const int step = 4 * NGW;
    QP_LOAD(xa, spa, m0);
    for (;;) {
        QP_LOAD(xb2, spb, m0 + step);
        QP_DO(xa, spa, m0);
        m0 += step; if (m0 >= T) break;
        QP_LOAD(xa, spa, m0 + step);
        QP_DO(xb2, spb, m0);
        m0 += step; if (m0 >= T) break;
    }
#undef QP_LOAD
#undef QP_DO
}
__device__ __forceinline__ void moe_gather(const Frame& F0, int c, int nbtot, const LAS int* meta, const int* mlist, const bf16_t* xb, const float* ssq, float* srow, char* proj) {
    const LAS int* pblk = meta + 8; const int gw = F0.bx * NWAVES + F0.wave, NGW = F0.G * NWAVES;
    const int r0 = c * CHUNK_BLK * 256, r1 = min((c + 1) * CHUNK_BLK * 256, nbtot * 256); signed char* dst0 = (signed char*)(proj + PJ_GB + (size_t)(c & 1) * GB_BUF);
    for (int rb = r0 + gw; rb < r1; rb += 8 * NGW) {
        int tokj = -1; int ln_ = F0.lane; asm volatile("" : "+v"(ln_)); Frame F = F0; F.lane = ln_;
        { const int r = rb + (F.lane & 7) * NGW; if (F.lane < 8 && r < r1) { const int blk = r >> 8, e = expert_of_blk(pblk, blk), pos = r - pblk[e] * 256; if (pos < meta[e]) tokj = mlist[(size_t)e * T + pos]; } }
#pragma unroll
        for (int h4 = 0; h4 < 2; ++h4) {
            u32x2 xw[4][4]; int tk[4]; f32x4 sp[4];
#pragma unroll
            for (int i = 0; i < 4; ++i) { tk[i] = __builtin_amdgcn_readlane(tokj, h4 * 4 + i); if (tk[i] >= 0) { load_row4(xw[i], xb + (size_t)tk[i] * D, F.lane); sp[i] = *(const f32x4*)(ssq + (size_t)tk[i] * 4); } }
#pragma unroll
            for (int i = 0; i < 4; ++i) { const int j = h4 * 4 + i, r = rb + j * NGW; if (r < r1) { signed char* d = dst0 + (size_t)(r - r0) * D;
                if (tk[i] >= 0) { const float sc = quant_regs_i8(xw[i], d, F.lane); if (F.lane == 0) srow[r] = sc / sqrtf(((sp[i].x + sp[i].y) + (sp[i].z + sp[i].w)) * (1.f / 1024.f) + EPS); }
                else { unsigned* q = (unsigned*)d + F.lane;
#pragma unroll
                    for (int jj = 0; jj < 4; ++jj) q[64 * jj] = 0u;
                    if (F.lane == 0) srow[r] = 0.f; } } }
        }
    }
}

template <class RowMap>
__device__ __forceinline__ void convert_job_f8(const Frame& F, const float* W, int K, int N, unsigned char* WT, const RowMap& rm) {
    LAS float* scr = (LAS float*)(F.lds + F.wave * 8448);
    const int gw = F.bx * NWAVES + F.wave, NGW = F.G * NWAVES, nitems = (K / 64) * (N / 32);
    int ln = F.lane; asm volatile("" : "+v"(ln));
#pragma nounroll
    for (int it = gw; it < nitems; it += NGW) transpose_item_f8(W, K, N, WT, rm, scr, it, ln);
}
template <class RowMap>
__device__ __forceinline__ void convert_job(const Frame& F, const float* W, int K, int N, bf16_t* WT, const RowMap& rm) {
    LAS float* scr = (LAS float*)(F.lds + F.wave * 8448);
    const int gw = F.bx * NWAVES + F.wave, NGW = F.G * NWAVES, nitems = (K / 64) * (N / 32);
    int ln = F.lane; asm volatile("" : "+v"(ln));
#pragma nounroll
    for (int it = gw; it < nitems; it += NGW) transpose_item(W, K, N, WT, rm, scr, it, ln);
}

constexpr int PH_PRO0 = 0, PH_PRO1 = 1, PH_L0 = 2, NPL = 9, N_PHASES = PH_L0 + DEPTH * NPL;
#ifndef PROBE_DUP
#define PROBE_DUP 0
#endif
typedef const Params __attribute__((address_space(4))) CParams;
__device__ __forceinline__ CParams* get_params() { CParams* p = (CParams*)__builtin_amdgcn_kernarg_segment_ptr(); asm volatile("" : "+s"(p)); return p; }
#define PIN(i) ((const float*)pp->in[i])

__global__ void __launch_bounds__(NTHR, 2) fwd_kernel(Params P_unused) {
    extern __shared__ __attribute__((aligned(16))) unsigned char lds_raw[];
    Frame F; F.lds = (LAS unsigned char*)lds_raw; F.tid = threadIdx.x; F.lane = F.tid & 63; F.wave = __builtin_amdgcn_readfirstlane(F.tid >> 6); F.G = gridDim.x; F.bx = blockIdx.x;
#define PHASE_FRAME Frame F; { int t_ = threadIdx.x; asm volatile("" : "+v"(t_)); F.lds = (LAS unsigned char*)lds_raw; F.tid = t_; F.lane = t_ & 63; F.wave = __builtin_amdgcn_readfirstlane(t_ >> 6); F.G = gridDim.x; int b_ = blockIdx.x; asm volatile("" : "+s"(b_)); F.bx = b_; }
    volatile LAS unsigned* MISC = (volatile LAS unsigned*)(F.lds + MISC_OFF);
    LAS int* meta = (LAS int*)(F.lds + MISC_OFF + 64);
    LAS int* lcnt = (LAS int*)(F.lds + MISC_OFF + 256);
    for (int u = F.tid; u < 1024; u += NTHR) ((LAS unsigned*)(F.lds + MISC_OFF))[u] = 0u;
    __syncthreads();
    XcdBarrier bar;
    { CParams* pp = get_params(); bar = xcd_barrier_post((unsigned*)(pp->ws + WS_CTL) + CW_BAR, MISC); }
#define IN(k) true
#define SEAM(k) do { if ((k) + 1 < N_PHASES) xcd_barrier(bar); } while (0)
#define GWS const int gw = F.bx * NWAVES + F.wave, NGW = F.G * NWAVES

    if (IN(PH_PRO0)) {
        PHASE_FRAME; CParams* pp = get_params(); unsigned char* ws = pp->ws; GWS;
#pragma nounroll
        for (int rep = 0; rep < ((PROBE_DUP >> 8) & 1) + 1; ++rep) {
        convert_strip_list(F, 4 * 72 + 4 * 112, [&](int fs) -> StripDesc {
            if (fs < 288) { const int l = fs / 72, st = fs - l * 72;
                return StripDesc{PIN(I_W_IN) + (size_t)l * D * 2304 + st * 32, PIN(I_NORM_MIX) + l * D, (signed char*)(ws + WS_WIN) + (size_t)l * 2304 * D, (float*)(ws + WS_WSC + SC_WIN) + l * 2304, 2304, st * 32}; }
            const int r = fs - 288, up = r / 224, r2 = r - up * 224, i = r2 / 112, st = r2 - i * 112, n0 = st * 32;
            return StripDesc{(up ? PIN(I_DUP) : PIN(I_DGATE)) + (size_t)i * D * FF + n0, PIN(I_NORM_FFN) + (2 * i) * D, (signed char*)(ws + WS_WGU) + (size_t)i * 7168 * D, (float*)(ws + WS_WSC + SC_WD) + i * 7168, FF,
                             (n0 >> 7) * 256 + 128 * up + (n0 & 127)}; });
        __syncthreads();
#pragma nounroll
        for (int l = 0; l < DEPTH; ++l) {
            convert_job(F, PIN(I_W_OUT) + (size_t)l * D * D, D, D, (bf16_t*)(ws + WS_WOUT) + (size_t)l * D * D, RowIdent{});
            convert_job(F, PIN(I_XWQ) + (size_t)l * D * 512, D, 512, (bf16_t*)(ws + WS_WQ) + (size_t)l * 512 * D, RowIdent{PIN(I_NORM_XATTN) + l * D});
            convert_job(F, PIN(I_XWKV) + (size_t)l * D * 1024, D, 1024, (bf16_t*)(ws + WS_WKV) + (size_t)l * 1024 * D, RowIdent{});
            convert_job(F, PIN(I_XWO) + (size_t)l * 512 * D, 512, D, (bf16_t*)(ws + WS_WO) + (size_t)l * D * 512, RowIdent{});
        }
#pragma nounroll
        for (int i = 0; i < 2; ++i) convert_job_f8(F, PIN(I_DDOWN) + (size_t)i * FF * D, FF, D, (unsigned char*)(ws + WS_WDN) + (size_t)i * D * FF, RowIdent{});
#pragma nounroll
        for (int l = 0; l < DEPTH; ++l) {
            f32x4 g[4], v[4];
#pragma unroll
            for (int j = 0; j < 4; ++j) g[j] = ((const f32x4*)(PIN(I_NORM_MEM) + l * D))[64 * j + F.lane];
            for (int m = gw; m < NB * NMEM; m += NGW) norm_row(PIN(I_MEM) + (size_t)m * D, (bf16_t*)(ws + WS_PROJ + PJ_HM) + ((size_t)l * 8192 + m) * D, g, v, F.lane);
        }
        { const float* x = PIN(I_X); bf16_t* xb = (bf16_t*)(ws + WS_XB); float* sq = ssq_slot(ws, 0); signed char* xq = (signed char*)(ws + WS_XQW); float* roww = (float*)(ws + WS_WSC + SC_ROWW);
          for (int m = gw; m < T; m += NGW) { const f32x4* xr = (const f32x4*)(x + (size_t)m * D) + F.lane; u32x2* o8 = (u32x2*)(xb + (size_t)m * D) + F.lane; float q = 0.f, mx = 0.f; f32x4 xv[4];
#pragma unroll
              for (int j = 0; j < 4; ++j) { xv[j] = xr[64 * j]; q += (xv[j].x * xv[j].x + xv[j].y * xv[j].y) + (xv[j].z * xv[j].z + xv[j].w * xv[j].w); mx = fmaxf(mx, fmaxf(fmaxf(fabsf(xv[j].x), fabsf(xv[j].y)), fmaxf(fabsf(xv[j].z), fabsf(xv[j].w))));
                  u32x2 w; w.x = cvt_pk_bf16(xv[j].x, xv[j].y); w.y = cvt_pk_bf16(xv[j].z, xv[j].w); o8[64 * j] = w; }
              q = wave_sum(q); mx = wave_max(mx); const float sc = mx > 0.f ? mx * (1.f / 127.f) : 1.f, inv = 1.0f / sc; unsigned* q8 = (unsigned*)(xq + (size_t)m * D) + F.lane;
#pragma unroll
              for (int j = 0; j < 4; ++j) q8[64 * j] = q4(xv[j].x, xv[j].y, xv[j].z, xv[j].w, inv);
              if (F.lane == 0) { *(f32x4*)(sq + (size_t)m * 4) = (f32x4){q, 0.f, 0.f, 0.f}; roww[m] = sc / sqrtf(q * (1.f / 1024.f) + EPS); } } }
        }
        SEAM(PH_PRO0);
    }
    if (IN(PH_PRO1)) {
        PHASE_FRAME; CParams* pp = get_params(); unsigned char* ws = pp->ws;
        SchedKV S{F.G, F.bx, ws};
        pg8::gemm_phase(F.lds, 2048, S, pg8::EpiStoreBf16{});
        SEAM(PH_PRO1);
    }

#pragma nounroll
    for (int l = 0; l < DEPTH; ++l) {
        const int pb = PH_L0 + l * NPL;
        const bool moe = (l & 1) != 0; const int fi = l >> 1;
        if (IN(pb + 0)) {
            if (l == 0) {
                PHASE_FRAME; CParams* pp = get_params(); unsigned char* ws = pp->ws; GWS;
                for (int rr = gw; rr < DEPTH * 8192; rr += NGW) { const int ll = rr >> 13;
                    float kv[8]; unpack8(*(const bf16x8*)((const bf16_t*)(ws + WS_YS) + (size_t)rr * 512 + 8 * F.lane), kv);
                    float ss = 0.f;
#pragma unroll
                    for (int j = 0; j < 8; ++j) ss += kv[j] * kv[j];
                    ss += lane_xor<1>(ss); ss += lane_xor<2>(ss); ss += lane_xor<4>(ss); ss += lane_xor<8>(ss);
                    const float rs = 1.0f / sqrtf(ss * (1.f / 128.f) + EPS);
                    const float* kg = PIN(I_XK_GAIN) + ll * 128 + 8 * (F.lane & 15);
#pragma unroll
                    for (int j = 0; j < 8; ++j) kv[j] = kv[j] * rs * kg[j];
                    *(bf16x8*)((bf16_t*)(ws + WS_KN) + (size_t)rr * 512 + 8 * F.lane) = pack8(kv); }
            }
            if (l & 1) {
                PHASE_FRAME; CParams* pp = get_params(); unsigned char* ws = pp->ws; GWS; const bf16_t* xb = (const bf16_t*)(ws + WS_XB); const float* sq = ssq_slot(ws, 3 * l);
                signed char* xq = (signed char*)(ws + WS_XQW); float* roww = (float*)(ws + WS_WSC + SC_ROWW);
                quant_pass(F, xb, sq, xq, roww);
                xcd_barrier(bar);
            }
            PHASE_FRAME; CParams* pp = get_params(); unsigned char* ws = pp->ws;
            SchedWin S{F.G, F.bx, l, ws};
            pg8::gemm_phase(F.lds, 1024, S, pg8::EpiStoreI8{});
            SEAM(pb + 0);
        }
        if (IN(pb + 1)) {
            PHASE_FRAME; CParams* pp = get_params(); unsigned char* ws = pp->ws; char* proj = (char*)(ws + WS_PROJ); bf16_t* mixed = (bf16_t*)(ws + WS_YS);
            if (F.wave >= 4) __builtin_amdgcn_s_setprio(1);
            LAS float* bias = (LAS float*)(F.lds + SW_END); LAS float* part = (LAS float*)(F.lds + SW_END + 4096);
            LAS float* cst = (LAS float*)(F.lds + SW_END + 4096 + 2048);
            for (int i = F.tid; i < 1024; i += NTHR) { const int h = i >> 7, d = i & 127; bias[i] = PIN(I_REL_BIAS)[T5B[d] * 8 + h] * 1.4426950408889634f; }
            for (int i = F.tid; i < 1160; i += NTHR) cst[i] = (i < 512) ? PIN(I_SB_OUT_GAIN)[l * 512 + i] : (i < 1024) ? PIN(I_SWA_OUT_GAIN)[l * 512 + i - 512] : (i < 1088) ? PIN(I_SWA_Q_GAIN)[l * 64 + i - 1024] : (i < 1152) ? PIN(I_SWA_K_GAIN)[l * 64 + i - 1088] : PIN(I_SWA_SINKS)[l * 8 + i - 1152];
            __syncthreads();
#pragma nounroll
            for (int rep = 0; rep < ((PROBE_DUP >> 1) & 3 ? 2 : 1); ++rep)
#pragma nounroll
            for (int u = F.bx + ((rep == 1 && ((PROBE_DUP >> 2) & 1)) ? 1024 : 0); u < ((rep == 1 && ((PROBE_DUP >> 1) & 3) == 1) ? 1024 : 2048); u += F.G) {
                const int uu = u & 1023, b = uu >> 5, tq = uu & 31;
                if (u < 1024) sb_unit(F, b, tq, (const bf16_t*)(proj + PJ_SBQ), (const bf16_t*)(proj + PJ_SBK), (const bf16_t*)(proj + PJ_SBVT), cst, mixed, part, F.lds);
                else swa_unit(F, b, tq, (const bf16_t*)(proj + PJ_SWQ), (const bf16_t*)(proj + PJ_SWKV), cst + 1024, cst + 1088, cst + 1152, cst + 512, mixed, F.lds, bias, part);
            }
            __builtin_amdgcn_s_setprio(0);
            SEAM(pb + 1);
        }
        if (IN(pb + 2)) {
            PHASE_FRAME; CParams* pp = get_params(); unsigned char* ws = pp->ws;
            SchedRes S{F.G, F.bx, l, 0, ws};
            pg8::gemm_phase(F.lds, 2048, S, pg8::EpiResid{});
            SEAM(pb + 2);
        }
        if (IN(pb + 3)) {
            PHASE_FRAME; CParams* pp = get_params(); unsigned char* ws = pp->ws;
            SchedWq S{F.G, F.bx, l, ws};
            pg8::gemm_phase(F.lds, 2048, S, pg8::EpiStoreBf16{});
            SEAM(pb + 3);
        }
        if (IN(pb + 4)) {
            PHASE_FRAME; CParams* pp = get_params(); unsigned char* ws = pp->ws;
            if (F.wave >= 4) __builtin_amdgcn_s_setprio(1);
            LAS float* qg = (LAS float*)(F.lds + pg8::XL_OFF);
            if (F.tid < 128) qg[F.tid] = PIN(I_XQ_GAIN)[l * 128 + F.tid];
            __syncthreads();
#pragma nounroll
            for (int rep = 0; rep < ((PROBE_DUP >> 4) & 1) + 1; ++rep)
#pragma nounroll
            for (int hu = F.bx; hu < 256; hu += F.G) {
                const int p = hu >> 1;
                __syncthreads();
                xattn_stage(F, p >> 2, p & 3, (const bf16_t*)(ws + WS_KN) + (size_t)l * 8192 * 512, (const bf16_t*)(ws + WS_VT) + (size_t)l * 8192 * 512, F.lds);
                __syncthreads();
#pragma nounroll
                for (int i = 0; i < 4; ++i) xattn_tile(F, p >> 2, p & 3, 4 * (hu & 1) + i, (const bf16_t*)(ws + WS_PROJ + PJ_XQ), qg, (bf16_t*)(ws + WS_PROJ + PJ_XO), F.lds);
            }
            __builtin_amdgcn_s_setprio(0);
            SEAM(pb + 4);
        }
        if (IN(pb + 5)) {
            PHASE_FRAME; CParams* pp = get_params(); unsigned char* ws = pp->ws;
            SchedRes S{F.G, F.bx, l, 1, ws};
            pg8::gemm_phase(F.lds, 1024, S, pg8::EpiResid{});
            SEAM(pb + 5);
        }
        if (IN(pb + 6) && moe) {
            PHASE_FRAME; CParams* pp = get_params(); unsigned char* ws = pp->ws; const bf16_t* xb = (const bf16_t*)(ws + WS_XB); const float* sq = ssq_slot(ws, 3 * l + 2);
            unsigned* gcnt = (unsigned*)(ws + WS_CTL) + CW_CNT + fi * 8 * 64;
            int* mlist = (int*)(ws + WS_MOE + MO_LIST); int4* minfo = (int4*)(ws + WS_MOE + MO_INFO); float2* mgate = (float2*)(ws + WS_MOE + MO_GATE);
            const float* rw = PIN(I_ROUTER_W) + (size_t)fi * D * NE; const float* rb = PIN(I_ROUTER_B) + fi * NE; const float* gn = PIN(I_NORM_FFN) + l * D;
            LAS float* rwl = (LAS float*)(F.lds + 70 * 1024);
            for (int i = F.tid; i < D * NE; i += NTHR) rwl[i] = rw[i] * gn[i >> 3];
            float rbv[8];
#pragma unroll
            for (int e = 0; e < 8; ++e) rbv[e] = rb[e];
#pragma nounroll
            for (int grp = F.bx; grp < T / 256; grp += F.G) {
                if (F.tid < 8) lcnt[F.tid] = 0;
                __syncthreads();
                int me1 = 0, me2 = 0; float mg1 = 0.f, mg2 = 0.f;
                u32x2 xnext[4]; f32x4 sqnext;
                { const int m0 = grp * 256 + F.wave * 32; load_row4(xnext, xb + (size_t)m0 * D, F.lane); sqnext = *(const f32x4*)(sq + (size_t)m0 * 4); }
#pragma nounroll
                for (int i = 0; i < 32; ++i) {
                    const int m = grp * 256 + F.wave * 32 + i;
                    const int ln = F.lane;
                    u32x2 xcur[4];
#pragma unroll
                    for (int j = 0; j < 4; ++j) xcur[j] = xnext[j];
                    const float rs = 1.0f / sqrtf(((sqnext.x + sqnext.y) + (sqnext.z + sqnext.w)) * (1.f / 1024.f) + EPS);
                    if (i < 31) { load_row4(xnext, xb + (size_t)(m + 1) * D, ln); sqnext = *(const f32x4*)(sq + (size_t)(m + 1) * 4); }
                    float lg[8]; typedef float f32x2_ __attribute__((ext_vector_type(2)));
                    f32x2_ l2[4] = {{0.f, 0.f}, {0.f, 0.f}, {0.f, 0.f}, {0.f, 0.f}};
#pragma unroll
                    for (int j = 0; j < 4; ++j) { const u32x2 xw = xcur[j]; const f32x4 xv = {bf_lo(xw.x), bf_hi(xw.x), bf_lo(xw.y), bf_hi(xw.y)};
#pragma unroll
                        for (int cc = 0; cc < 4; ++cc) { const LAS float* wr_ = rwl + (256 * j + 4 * ln + cc) * 8; const f32x4 w0 = *(const LAS f32x4*)wr_, w1 = *(const LAS f32x4*)(wr_ + 4); const f32x2_ hv = {xv[cc], xv[cc]};
                            l2[0] = hv * (f32x2_){w0.x, w0.y} + l2[0]; l2[1] = hv * (f32x2_){w0.z, w0.w} + l2[1]; l2[2] = hv * (f32x2_){w1.x, w1.y} + l2[2]; l2[3] = hv * (f32x2_){w1.z, w1.w} + l2[3]; } }
#pragma unroll
                    for (int e = 0; e < 4; ++e) { lg[2 * e] = l2[e].x; lg[2 * e + 1] = l2[e].y; }
#pragma unroll
                    for (int e = 0; e < 8; ++e) lg[e] = wave_sum(lg[e]) * rs + rbv[e];
                    int e1 = 0; float v1 = lg[0];
#pragma unroll
                    for (int e = 1; e < 8; ++e) if (lg[e] > v1) { v1 = lg[e]; e1 = e; }
                    int e2 = -1; float v2 = -INFINITY;
#pragma unroll
                    for (int e = 0; e < 8; ++e) if (e != e1 && lg[e] > v2) { v2 = lg[e]; e2 = e; }
                    const float ex = __expf(v2 - v1), den = 1.0f / (1.0f + ex);
                    if (F.lane == i) { me1 = e1; me2 = e2; mg1 = den; mg2 = ex * den; }
                }
                int p1 = 0, p2 = 0;
                if (F.lane < 32) { p1 = __hip_atomic_fetch_add(&lcnt[me1], 1, __ATOMIC_RELAXED, __HIP_MEMORY_SCOPE_WORKGROUP); p2 = __hip_atomic_fetch_add(&lcnt[me2], 1, __ATOMIC_RELAXED, __HIP_MEMORY_SCOPE_WORKGROUP); }
                __syncthreads();
                if (F.tid < 8) lcnt[8 + F.tid] = (int)__hip_atomic_fetch_add(gcnt + 64 * F.tid, (unsigned)lcnt[F.tid], __ATOMIC_RELAXED, __HIP_MEMORY_SCOPE_AGENT);
                __syncthreads();
                if (F.lane < 32) { const int tok = grp * 256 + F.wave * 32 + F.lane; const int q1 = lcnt[8 + me1] + p1, q2 = lcnt[8 + me2] + p2;
                    mlist[(size_t)me1 * T + q1] = tok; mlist[(size_t)me2 * T + q2] = tok; minfo[tok] = make_int4(me1 | (me2 << 8), q1, q2, 0); mgate[tok] = make_float2(mg1, mg2); }
                __syncthreads();
            }
            __syncthreads();
#pragma nounroll
            for (int rep = 0; rep < ((PROBE_DUP >> 5) & 1) + 1; ++rep) {
                convert_strip_list(F, NE * 224, [&](int fs) -> StripDesc {
                    const int e = fs / 224, r = fs - e * 224, up = r / 112, st = r - up * 112, n0 = st * 32; const size_t eo = ((size_t)fi * NE + e) * D * FF;
                    return StripDesc{(up ? PIN(I_EUP) : PIN(I_EGATE)) + eo + n0, gn, (signed char*)(ws + WS_EGU) + (size_t)e * 7168 * D, (float*)(ws + WS_WSC + SC_WE) + e * 7168, FF, (n0 >> 7) * 256 + 128 * up + (n0 & 127)}; });
                __syncthreads();
#pragma nounroll
                for (int e = 0; e < NE; ++e) convert_job_f8(F, PIN(I_EDOWN) + ((size_t)fi * NE + e) * D * FF, FF, D, (unsigned char*)(ws + WS_EDN) + (size_t)e * D * FF, RowIdent{});
            }
            SEAM(pb + 6);
        }
        if (IN(pb + 6) && !moe) {
            PHASE_FRAME; CParams* pp = get_params(); unsigned char* ws = pp->ws; GWS; const bf16_t* xb = (const bf16_t*)(ws + WS_XB); const float* sq = ssq_slot(ws, 3 * l + 2);
            signed char* xq = (signed char*)(ws + WS_PROJ + PJ_XQ8); float* rowsc = (float*)(ws + WS_WSC + SC_ROW);
            quant_pass(F, xb, sq, xq, rowsc);
            SEAM(pb + 6);
        }
        if (IN(pb + 7)) {
            if (!moe) {
                constexpr int NCH = 256 / CHUNK_BLK;
#pragma nounroll
                for (int c = 0; c <= NCH; ++c) {
                    if (c > 0) { PHASE_FRAME; CParams* pp = get_params(); unsigned char* ws = pp->ws;
                      SchedDown S{F.G, F.bx, CHUNK_BLK, c - 1, l, ws, nullptr};
                      pg8::gemm_phase(F.lds, FF, S, pg8::EpiResidT<2>{}); }
                    if (c < NCH) { PHASE_FRAME; CParams* pp = get_params(); unsigned char* ws = pp->ws;
                      SchedGU S{F.G, F.bx, CHUNK_BLK, c, l, ws, nullptr};
                      pg8::gemm_phase(F.lds, 1024, S, pg8::EpiSwiGLU8{});
                      xcd_barrier(bar); }
                }
            } else {
                { PHASE_FRAME; CParams* pp = get_params(); unsigned char* ws = pp->ws; moe_meta(F, (unsigned*)(ws + WS_CTL) + CW_CNT + fi * 8 * 64, meta);
                  moe_gather(F, 0, meta[16], meta, (const int*)(ws + WS_MOE + MO_LIST), (const bf16_t*)(ws + WS_XB), ssq_slot(ws, 3 * l + 2), (float*)(ws + WS_WSC + SC_SROW), (char*)(ws + WS_PROJ)); }
                const LAS int* pblk = meta + 8; const int nbtot = meta[16], nchunk = (nbtot + CHUNK_BLK - 1) / CHUNK_BLK;
                xcd_barrier(bar);
#pragma nounroll
                for (int c = 0; c <= nchunk; ++c) {
                    if (c > 0) { PHASE_FRAME; CParams* pp = get_params(); unsigned char* ws = pp->ws;
                      SchedDown S{F.G, F.bx, min(CHUNK_BLK, nbtot - CHUNK_BLK * (c - 1)), c - 1, l, ws, pblk};
                      pg8::gemm_phase(F.lds, FF, S, pg8::EpiStoreBf16T<2>{});
                      if ((PROBE_DUP >> 7) & 1) pg8::gemm_phase(F.lds, FF, S, pg8::EpiStoreBf16T<2>{}); }
                    if (c < nchunk) { PHASE_FRAME; CParams* pp = get_params(); unsigned char* ws = pp->ws;
                      SchedGU S{F.G, F.bx, min(CHUNK_BLK, nbtot - CHUNK_BLK * c), c, l, ws, pblk};
                      pg8::gemm_phase(F.lds, 1024, S, pg8::EpiSwiGLU8{});
                      if ((PROBE_DUP >> 6) & 1) pg8::gemm_phase(F.lds, 1024, S, pg8::EpiSwiGLU8{});
                      if (c + 1 < nchunk) moe_gather(F, c + 1, nbtot, meta, (const int*)(ws + WS_MOE + MO_LIST), (const bf16_t*)(ws + WS_XB), ssq_slot(ws, 3 * l + 2), (float*)(ws + WS_WSC + SC_SROW), (char*)(ws + WS_PROJ));
                      xcd_barrier(bar); }
                }
            }
            SEAM(pb + 7);
        }
        if (IN(pb + 8) && moe) {
            PHASE_FRAME; CParams* pp = get_params(); unsigned char* ws = pp->ws; GWS; float* xo = pp->out; bf16_t* xb = (bf16_t*)(ws + WS_XB); float* sq = ssq_slot(ws, 3 * l + 3); const bool lastl = (l == DEPTH - 1);
            const int4* minfo = (const int4*)(ws + WS_MOE + MO_INFO); const float2* mgate = (const float2*)(ws + WS_MOE + MO_GATE);
            moe_meta(F, (unsigned*)(ws + WS_CTL) + CW_CNT + fi * 8 * 64, meta);
            const LAS int* pblk = meta + 8; const bf16_t* ys = (const bf16_t*)(ws + WS_YS);
            struct Rec { unsigned r1, r2; float g1, g2; };
#define CB_REC(R, mb_) do { R.r1 = 0u; R.r2 = 0u; R.g1 = 0.f; R.g2 = 0.f; if (F.lane < 8) { int mj_ = (mb_) + F.lane * NGW; mj_ = mj_ < T ? mj_ : gw; const int4 inf = minfo[mj_]; const float2 gt = mgate[mj_]; const int e1 = inf.x & 255, e2 = inf.x >> 8; \
                R.r1 = (unsigned)(pblk[e1] * 256 + inf.y); R.r2 = (unsigned)(pblk[e2] * 256 + inf.z); R.g1 = gt.x; R.g2 = gt.y; } } while (0)
#define CB_LOAD(XW, YA, YB, GA, GB, R, mb_, sub_) do { _Pragma("unroll") for (int i = 0; i < 2; ++i) { const int j = (sub_) * 2 + i; int m_ = (mb_) + j * NGW; m_ = m_ < T ? m_ : gw; \
                const size_t r1 = (size_t)(unsigned)__builtin_amdgcn_readlane((int)R.r1, j), r2 = (size_t)(unsigned)__builtin_amdgcn_readlane((int)R.r2, j); \
                GA[i] = __builtin_bit_cast(float, __builtin_amdgcn_readlane(__builtin_bit_cast(int, R.g1), j)); GB[i] = __builtin_bit_cast(float, __builtin_amdgcn_readlane(__builtin_bit_cast(int, R.g2), j)); \
                load_row4(XW[i], xb + (size_t)m_ * D, F.lane); load_row4(YA[i], ys + r1 * D, F.lane); load_row4(YB[i], ys + r2 * D, F.lane); } } while (0)
#define CB_PROC(XW, YA, YB, GA, GB, mb_, sub_) do { _Pragma("unroll") for (int i = 0; i < 2; ++i) { const int j = (sub_) * 2 + i, m = (mb_) + j * NGW; if (m < T) { \
                u32x2* xr = (u32x2*)(xb + (size_t)m * D) + F.lane; f32x4* o4 = (f32x4*)(xo + (size_t)m * D) + F.lane; float q = 0.f, mx = 0.f; f32x4 xs[4]; \
                _Pragma("unroll") for (int jj = 0; jj < 4; ++jj) { const u32x2 xw_ = XW[i][jj], a = YA[i][jj], bq = YB[i][jj]; f32x4 xv; \
                    xv.x = bf_lo(xw_.x) + GA[i] * bf_lo(a.x) + GB[i] * bf_lo(bq.x); xv.y = bf_hi(xw_.x) + GA[i] * bf_hi(a.x) + GB[i] * bf_hi(bq.x); xv.z = bf_lo(xw_.y) + GA[i] * bf_lo(a.y) + GB[i] * bf_lo(bq.y); xv.w = bf_hi(xw_.y) + GA[i] * bf_hi(a.y) + GB[i] * bf_hi(bq.y); \
                    xs[jj] = xv; \
                    if (lastl) o4[64 * jj] = xv; \
                    else { q += (xv.x * xv.x + xv.y * xv.y) + (xv.z * xv.z + xv.w * xv.w); mx = fmaxf(mx, fmaxf(fmaxf(fabsf(xv.x), fabsf(xv.y)), fmaxf(fabsf(xv.z), fabsf(xv.w)))); \
                        u32x2 w; w.x = cvt_pk_bf16(xv.x, xv.y); w.y = cvt_pk_bf16(xv.z, xv.w); xr[64 * jj] = w; } } \
                if (!lastl) { q = wave_sum(q); mx = wave_max(mx); const float sc = mx > 0.f ? mx * (1.f / 127.f) : 1.f, inv = 1.0f / sc; unsigned* q8 = (unsigned*)((signed char*)(ws + WS_XQW) + (size_t)m * D) + F.lane; \
                    _Pragma("unroll") for (int jj = 0; jj < 4; ++jj) q8[64 * jj] = q4(xs[jj].x, xs[jj].y, xs[jj].z, xs[jj].w, inv); \
                    if (F.lane == 0) { *(f32x4*)(sq + (size_t)m * 4) = (f32x4){q, 0.f, 0.f, 0.f}; ((float*)(ws + WS_WSC + SC_ROWW))[m] = sc / sqrtf(q * (1.f / 1024.f) + EPS); } } } } } while (0)
            if (gw < T) {
                u32x2 xwA[2][4], yaA[2][4], ybA[2][4], xwB[2][4], yaB[2][4], ybB[2][4]; float gaA[2], gbA[2], gaB[2], gbB[2];
                Rec R, Rn; int mb = gw; const int bstep = 8 * NGW;
                CB_REC(R, mb);
                CB_LOAD(xwA, yaA, ybA, gaA, gbA, R, mb, 0);
#pragma nounroll
                for (;;) {
                    CB_REC(Rn, mb + bstep);
                    CB_LOAD(xwB, yaB, ybB, gaB, gbB, R, mb, 1); CB_PROC(xwA, yaA, ybA, gaA, gbA, mb, 0);
                    CB_LOAD(xwA, yaA, ybA, gaA, gbA, R, mb, 2); CB_PROC(xwB, yaB, ybB, gaB, gbB, mb, 1);
                    CB_LOAD(xwB, yaB, ybB, gaB, gbB, R, mb, 3); CB_PROC(xwA, yaA, ybA, gaA, gbA, mb, 2);
                    CB_LOAD(xwA, yaA, ybA, gaA, gbA, Rn, mb + bstep, 0); CB_PROC(xwB, yaB, ybB, gaB, gbB, mb, 3);
                    mb += bstep; if (mb >= T) break;
                    R = Rn;
                }
            }
#undef CB_REC
#undef CB_LOAD
#undef CB_PROC
            SEAM(pb + 8);
        }
    }
#undef IN
#undef SEAM
#undef GWS
#undef PHASE_FRAME
}

extern "C" void kernel_launch(void* const* d_in, const int* in_sizes, int n_in, void* d_out, int out_size, void* d_ws, size_t ws_size, hipStream_t stream) {
    static int grid = 0;
    if (grid == 0) {
        if (n_in != 27 || in_sizes[0] != T * D || out_size != T * D || ws_size < WS_END) { fprintf(stderr, "kernel_launch: unexpected shapes (n_in %d, in0 %d, out %d, ws %zu < %zu)\n", n_in, n_in > 0 ? in_sizes[0] : -1, out_size, ws_size, (size_t)WS_END); grid = -1; return; }
        int dev = 0, cus = 0, per_cu = 0;
        if (hipGetDevice(&dev) != hipSuccess || hipDeviceGetAttribute(&cus, hipDeviceAttributeMultiprocessorCount, dev) != hipSuccess) { grid = -1; return; }
        if (hipFuncSetAttribute((const void*)fwd_kernel, hipFuncAttributeMaxDynamicSharedMemorySize, LDS_BYTES) != hipSuccess) { fprintf(stderr, "kernel_launch: hipFuncSetAttribute failed\n"); grid = -1; return; }
        if (hipOccupancyMaxActiveBlocksPerMultiprocessor(&per_cu, (const void*)fwd_kernel, NTHR, LDS_BYTES) != hipSuccess || per_cu < 1) { fprintf(stderr, "kernel_launch: occupancy query says %d blocks per CU\n", per_cu); }
        (void)hipGetLastError();
        grid = cus;
    }
    if (grid < 0) return;
    if (hipMemsetAsync((char*)d_ws + WS_CTL, 0, CTL_BYTES, stream) != hipSuccess) return;
    Params p{};
    for (int i = 0; i < 27; ++i) p.in[i] = (const float*)d_in[i];
    p.out = (float*)d_out; p.ws = (unsigned char*)d_ws; p.ph_lo = 0; p.ph_hi = N_PHASES;
    hipLaunchKernelGGL(fwd_kernel, dim3(grid), dim3(NTHR), LDS_BYTES, stream, p);
}
```
